# Optimizing an MI355X kernel written in HIP

```python
import math
import jax
import jax.numpy as jnp
from jax import lax
import numpy as np

D_MODEL = 1024
BATCH = 2
SEQ = 8192
DEPTH = 2

CTX_LEN = 256
GRID_W = 64
CONV_W = 3
EPS = 1e-6
F32 = jnp.float32

HG_HEADS = 4
HG_DK = 64
HG_DV = 64
HG_WIDTH = HG_HEADS * HG_DV
HG_CHUNK = 32

HY_WIDTH = 256
HY_ORDER = 2
HY_EMB_BANDS = 16
HY_EMB_DIM = 1 + 2 * HY_EMB_BANDS
HY_FILTER_HIDDEN = 64
HY_DECAY_TARGET = 1e-2
HY_FAST_DECAY_PCT = 0.3
HY_SLOW_DECAY_PCT = 1.5
HY_MIN_DECAY = math.log(HY_DECAY_TARGET) / HY_SLOW_DECAY_PCT
HY_MAX_DECAY = math.log(HY_DECAY_TARGET) / HY_FAST_DECAY_PCT

SSD_HEADS = 8
SSD_HEAD_DIM = 64
SSD_WIDTH = SSD_HEADS * SSD_HEAD_DIM
SSD_GROUPS = 2
SSD_STATE = 128
SSD_XBC = SSD_WIDTH + 2 * SSD_GROUPS * SSD_STATE
SSD_CHUNK = 64

MIX_WIDTH = HG_WIDTH + HY_WIDTH + SSD_WIDTH
HG_COLS = 5 * HG_WIDTH
HY_COLS = (HY_ORDER + 1) * HY_WIDTH
SSD_COLS = SSD_WIDTH + SSD_XBC + 2 * SSD_HEADS
IN_COLS = HG_COLS + HY_COLS + SSD_COLS

D_FF = 2816

kernel_name = "parallel_hybrid_flow_backbone"


def rms_norm(x, g):
    xf = x.astype(F32)
    y = xf * lax.rsqrt(jnp.mean(xf * xf, axis=-1, keepdims=True) + EPS)
    return (y * g.astype(F32)).astype(x.dtype)


def group_rms_norm(x, g, groups):
    shp = x.shape
    xf = x.astype(F32).reshape(shp[:-1] + (groups, shp[-1] // groups))
    y = xf * lax.rsqrt(jnp.mean(xf * xf, axis=-1, keepdims=True) + EPS)
    return y.reshape(shp) * g.astype(F32)


def modulate(h, shift, scale):
    return h * (1.0 + scale) + shift


def heads(t, n):
    return t.reshape(t.shape[:-1] + (n, t.shape[-1] // n))


def to_chunks(t, size):
    return t.reshape((t.shape[0], t.shape[1] // size, size) + t.shape[2:])


def dwconv1d(u, w, b):
    out = lax.conv_general_dilated(u, w[:, None, :], window_strides=(1,), padding="SAME",
                                   dimension_numbers=("NWC", "WIO", "NWC"),
                                   feature_group_count=u.shape[-1])
    return out + b


def dwconv2d(u, w, b):
    out = lax.conv_general_dilated(u, w[:, :, None, :], window_strides=(1, 1), padding="SAME",
                                   dimension_numbers=("NHWC", "HWIO", "NHWC"),
                                   feature_group_count=u.shape[-1])
    return out + b


def chunk_scan(decay, update, s0):
    def step(s, inp):
        d, u = inp
        return d * s + u, s
    s_fin, s_prev = lax.scan(step, s0, (jnp.moveaxis(decay, 1, 0), jnp.moveaxis(update, 1, 0)))
    return jnp.moveaxis(s_prev, 0, 1), s_fin


def gla_direction(q, f_logit, v, lb, s0, reverse, with_output):
    if reverse:
        q, f_logit, v = jnp.flip(q, 1), jnp.flip(f_logit, 1), jnp.flip(v, 1)
    logf = jnp.logaddexp(jnp.log(lb), jnp.log1p(-lb) + jax.nn.log_sigmoid(f_logit.astype(F32)))
    k = 1.0 - jnp.exp(logf)
    b = jnp.cumsum(to_chunks(logf, HG_CHUNK), axis=2)
    kc = to_chunks(k, HG_CHUNK)
    vc = to_chunks(v.astype(F32), HG_CHUNK)
    b_end = b[:, :, -1:]
    upd = jnp.einsum("bcshk,bcshv->bchkv", kc * jnp.exp(b_end - b), vc)
    s_prev, s_fin = chunk_scan(jnp.exp(b_end[:, :, 0])[..., None], upd, s0)
    if not with_output:
        return None, s_fin
    qc = to_chunks(q.astype(F32), HG_CHUNK)
    b_mid = b[:, :, HG_CHUNK // 2 - 1:HG_CHUNK // 2]
    scores = jnp.einsum("bcthk,bcshk->bchts", qc * jnp.exp(b - b_mid), kc * jnp.exp(b_mid - b))
    lower_tri = jnp.tril(jnp.ones((HG_CHUNK, HG_CHUNK), dtype=bool))
    scores = jnp.where(lower_tri, scores, 0.0)
    o = (jnp.einsum("bchts,bcshv->bcthv", scores, vc)
         + jnp.einsum("bcthk,bchkv->bcthv", qc * jnp.exp(b), s_prev))
    o = o.reshape(v.shape)
    if reverse:
        o = jnp.flip(o, 1)
    return o, s_fin


def ssd_direction(x, dt, a, bm, cm, s0, reverse, with_output):
    if reverse:
        x, dt, bm, cm = jnp.flip(x, 1), jnp.flip(dt, 1), jnp.flip(bm, 1), jnp.flip(cm, 1)
    bsz, seq_len, n_heads, head_dim = x.shape
    groups = bm.shape[2]
    hpg = n_heads // groups
    xc = to_chunks(x.astype(F32).reshape(bsz, seq_len, groups, hpg, head_dim), SSD_CHUNK)
    dtc = to_chunks(dt.astype(F32).reshape(bsz, seq_len, groups, hpg), SSD_CHUNK)
    bc = to_chunks(bm.astype(F32), SSD_CHUNK)
    cc = to_chunks(cm.astype(F32), SSD_CHUNK)
    a_cs = jnp.cumsum(dtc * a.reshape(groups, hpg), axis=2)
    xdt = xc * dtc[..., None]
    a_end = a_cs[:, :, -1:]
    upd = jnp.einsum("bcsgn,bcsgh,bcsghp->bcghpn", bc, jnp.exp(a_end - a_cs), xdt)
    s_prev, s_fin = chunk_scan(jnp.exp(a_end[:, :, 0])[..., None, None], upd, s0)
    if not with_output:
        return None, s_fin
    lower_tri = jnp.tril(jnp.ones((SSD_CHUNK, SSD_CHUNK), dtype=bool))
    seg = a_cs[:, :, :, None] - a_cs[:, :, None]
    decay = jnp.exp(jnp.where(lower_tri[:, :, None, None], seg, -jnp.inf))
    cb = jnp.einsum("bctgn,bcsgn->bctsg", cc, bc)
    y = jnp.einsum("bctsgh,bcsghp->bctghp", cb[..., None] * decay, xdt)
    y = y + jnp.einsum("bctgn,bcghpn,bctgh->bctghp", cc, s_prev, jnp.exp(a_cs))
    y = y.reshape(bsz, seq_len, n_heads, head_dim)
    if reverse:
        y = jnp.flip(y, 1)
    return y, s_fin


def hgrn2_branch(u, lb, norm_g, s0_f, s0_b, with_output):
    q, f_fwd, f_bwd, v, g = jnp.split(u, 5, axis=-1)
    q = heads(q, HG_HEADS) * (HG_DK ** -0.5)
    v = heads(v, HG_HEADS)
    o_f, s_f = gla_direction(q, heads(f_fwd, HG_HEADS), v, lb, s0_f, False, with_output)
    o_b, s_b = gla_direction(q, heads(f_bwd, HG_HEADS), v, lb, s0_b, True, with_output)
    if not with_output:
        return None, s_f, s_b
    o = (o_f + o_b).reshape(u.shape[:-1] + (HG_WIDTH,))
    o = group_rms_norm(o, norm_g, HG_HEADS) * jax.nn.silu(g.astype(F32))
    return o.astype(u.dtype), s_f, s_b


def hyena_filter_spectrum(seq_len, w1, b1, freq1, w2, b2, freq2, w3):
    t = jnp.linspace(0.0, 1.0, seq_len, dtype=F32)[:, None]
    w = 2.0 * math.pi * jnp.arange(seq_len, dtype=F32)[:, None] / seq_len
    bands = jnp.linspace(1e-4, HY_EMB_BANDS - 1, HY_EMB_BANDS, dtype=F32)[None]
    z = jnp.concatenate([t, jnp.cos(bands * w), -jnp.sin(bands * w)], axis=-1)
    h = jnp.sin(freq1.astype(F32) * (z @ w1.astype(F32) + b1.astype(F32)))
    h = jnp.sin(freq2.astype(F32) * (h @ w2.astype(F32) + b2.astype(F32)))
    h = (h @ w3.astype(F32)).reshape(seq_len, 2, HY_ORDER, HY_WIDTH)
    deltas = jnp.abs(jnp.linspace(HY_MIN_DECAY, HY_MAX_DECAY, HY_WIDTH, dtype=F32))
    h = h * jnp.exp(-t[:, :, None, None] * deltas)
    buf = jnp.concatenate([h[:, 0], jnp.zeros((1, HY_ORDER, HY_WIDTH), F32), h[:0:-1, 1]], axis=0)
    buf = buf / jnp.sum(jnp.abs(buf), axis=0, keepdims=True)
    return jnp.fft.rfft(buf, axis=0)


def fft_long_conv(u, spec, bias):
    seq_len = u.shape[1]
    uf = u.astype(F32)
    y = jnp.fft.irfft(jnp.fft.rfft(uf, n=2 * seq_len, axis=1) * spec, n=2 * seq_len, axis=1)[:, :seq_len]
    return y + uf * bias.astype(F32)


def hyena_branch(u, p):
    zc = dwconv1d(u, p["hy_conv_w"], p["hy_conv_b"])
    v, x1, x2 = jnp.split(zc, 3, axis=-1)
    spec = hyena_filter_spectrum(u.shape[1], p["hy_w1"], p["hy_b1"], p["hy_freq1"],
                                 p["hy_w2"], p["hy_b2"], p["hy_freq2"], p["hy_w3"])
    y = v
    for n, gate in enumerate((x1, x2)):
        y = gate.astype(F32) * fft_long_conv(y, spec[:, n], p["hy_bias"][n])
    return y.astype(u.dtype)


def ssd_branch(u, p, s0_f, s0_b, with_output):
    z, xbc, dt_raw = jnp.split(u, [SSD_WIDTH, SSD_WIDTH + SSD_XBC], axis=-1)
    xbc = jax.nn.silu(dwconv1d(xbc, p["ssd_conv_w"], p["ssd_conv_b"]))
    xs, bm, cm = jnp.split(xbc, [SSD_WIDTH, SSD_WIDTH + SSD_GROUPS * SSD_STATE], axis=-1)
    xs = heads(xs, SSD_HEADS)
    bm = heads(bm, SSD_GROUPS)
    cm = heads(cm, SSD_GROUPS)
    dt = jax.nn.softplus(heads(dt_raw.astype(F32), 2) + p["ssd_dt_bias"].astype(F32))
    a = -jnp.exp(p["ssd_a_log"].astype(F32))
    y_f, s_f = ssd_direction(xs, dt[..., 0, :], a[0], bm, cm, s0_f, False, with_output)
    y_b, s_b = ssd_direction(xs, dt[..., 1, :], a[1], bm, cm, s0_b, True, with_output)
    if not with_output:
        return None, s_f, s_b
    y = y_f + y_b + p["ssd_d"].astype(F32)[:, None] * xs.astype(F32)
    y = y.reshape(u.shape[:-1] + (SSD_WIDTH,)) * jax.nn.silu(z.astype(F32))
    return group_rms_norm(y, p["ssd_norm_g"], SSD_GROUPS).astype(u.dtype), s_f, s_b


def token_mixers(hx, hc, p, lb, ctx_out):
    bsz = hx.shape[0]
    ux = hx @ p["w_in"]
    uc = hc @ p["w_in"]
    ux_hg, ux_hy, ux_ssd = jnp.split(ux, [HG_COLS, HG_COLS + HY_COLS], axis=-1)
    uc_hg, uc_hy, uc_ssd = jnp.split(uc, [HG_COLS, HG_COLS + HY_COLS], axis=-1)
    zero_hg = jnp.zeros((bsz, HG_HEADS, HG_DK, HG_DV), F32)
    o_hg_c, s_hf, s_hb = hgrn2_branch(uc_hg, lb, p["hg_norm_g"], zero_hg, zero_hg, ctx_out)
    o_hg_x, _, _ = hgrn2_branch(ux_hg, lb, p["hg_norm_g"], s_hf, s_hb, True)
    zero_ssd = jnp.zeros((bsz, SSD_GROUPS, SSD_HEADS // SSD_GROUPS, SSD_HEAD_DIM, SSD_STATE), F32)
    o_ssd_c, s_sf, s_sb = ssd_branch(uc_ssd, p, zero_ssd, zero_ssd, ctx_out)
    o_ssd_x, _, _ = ssd_branch(ux_ssd, p, s_sf, s_sb, True)
    o_hy_x = hyena_branch(ux_hy, p)
    yx = jnp.concatenate([o_hg_x, o_hy_x, o_ssd_x], axis=-1) @ p["w_out"]
    if not ctx_out:
        return yx, None
    o_hy_c = hyena_branch(uc_hy, p)
    yc = jnp.concatenate([o_hg_c, o_hy_c, o_ssd_c], axis=-1) @ p["w_out"]
    return yx, yc


def conv_ffn(h, p, rows):
    bsz, seq_len, _ = h.shape
    a = h @ p["ffn_w_gate"]
    a = dwconv2d(a.reshape(bsz, rows, seq_len // rows, D_FF), p["ffn_conv_w"], p["ffn_conv_b"])
    a = a.reshape(bsz, seq_len, D_FF)
    return (jax.nn.silu(a) * (h @ p["ffn_w_up"])) @ p["ffn_w_down"]


def setup_inputs(seed: int = 0) -> dict:
    key = jax.random.key(seed)
    ks = iter(jax.random.split(key, 48))

    def nrm(shape, scale):
        return scale * jax.random.normal(next(ks), shape, F32)

    dt0 = jnp.exp(jax.random.uniform(next(ks), (DEPTH, 2, SSD_HEADS), F32, math.log(1e-3), math.log(1e-1)))
    return {
        "x": nrm((BATCH, SEQ, D_MODEL), 1.0),
        "c": nrm((BATCH, D_MODEL), 1.0),
        "ctx": nrm((BATCH, CTX_LEN, D_MODEL), 1.0),
        "c_ctx": nrm((D_MODEL,), 1.0),
        "w_ada": nrm((DEPTH, D_MODEL, 6 * D_MODEL), 0.5 * D_MODEL ** -0.5),
        "b_ada": nrm((DEPTH, 6 * D_MODEL), 0.02),
        "norm1_g": 1.0 + nrm((DEPTH, D_MODEL), 0.05),
        "norm2_g": 1.0 + nrm((DEPTH, D_MODEL), 0.05),
        "w_in": nrm((DEPTH, D_MODEL, IN_COLS), D_MODEL ** -0.5),
        "w_out": nrm((DEPTH, MIX_WIDTH, D_MODEL), MIX_WIDTH ** -0.5),
        "hg_lb_logits": nrm((DEPTH, HG_HEADS * HG_DK), 1.0),
        "hg_norm_g": 1.0 + nrm((DEPTH, HG_WIDTH), 0.05),
        "hy_conv_w": nrm((DEPTH, CONV_W, HY_COLS), CONV_W ** -0.5),
        "hy_conv_b": nrm((DEPTH, HY_COLS), 0.02),
        "hy_w1": nrm((DEPTH, HY_EMB_DIM, HY_FILTER_HIDDEN), HY_EMB_DIM ** -0.5),
        "hy_b1": nrm((DEPTH, HY_FILTER_HIDDEN), 0.1),
        "hy_freq1": 1.0 + nrm((DEPTH, HY_FILTER_HIDDEN), 0.05),
        "hy_w2": nrm((DEPTH, HY_FILTER_HIDDEN, HY_FILTER_HIDDEN), HY_FILTER_HIDDEN ** -0.5),
        "hy_b2": nrm((DEPTH, HY_FILTER_HIDDEN), 0.1),
        "hy_freq2": 1.0 + nrm((DEPTH, HY_FILTER_HIDDEN), 0.05),
        "hy_w3": nrm((DEPTH, HY_FILTER_HIDDEN, 2 * HY_ORDER * HY_WIDTH), HY_FILTER_HIDDEN ** -0.5),
        "hy_bias": nrm((DEPTH, HY_ORDER, HY_WIDTH), 1.0),
        "ssd_conv_w": nrm((DEPTH, CONV_W, SSD_XBC), CONV_W ** -0.5),
        "ssd_conv_b": nrm((DEPTH, SSD_XBC), 0.02),
        "ssd_dt_bias": dt0 + jnp.log(-jnp.expm1(-dt0)),
        "ssd_a_log": jnp.log(jax.random.uniform(next(ks), (DEPTH, 2, SSD_HEADS), F32, 1.0, 16.0)),
        "ssd_d": 1.0 + nrm((DEPTH, SSD_HEADS), 0.1),
        "ssd_norm_g": 1.0 + nrm((DEPTH, SSD_WIDTH), 0.05),
        "ffn_w_gate": nrm((DEPTH, D_MODEL, D_FF), D_MODEL ** -0.5),
        "ffn_w_up": nrm((DEPTH, D_MODEL, D_FF), D_MODEL ** -0.5),
        "ffn_conv_w": nrm((DEPTH, 3, 3, D_FF), 1.0 / 3.0),
        "ffn_conv_b": nrm((DEPTH, D_FF), 0.02),
        "ffn_w_down": nrm((DEPTH, D_FF, D_MODEL), D_FF ** -0.5),
        "final_norm_g": 1.0 + nrm((D_MODEL,), 0.05),
    }


def reference(x, c, ctx, c_ctx, w_ada, b_ada, norm1_g, norm2_g, w_in, w_out,
              hg_lb_logits, hg_norm_g, hy_conv_w, hy_conv_b, hy_w1, hy_b1, hy_freq1,
              hy_w2, hy_b2, hy_freq2, hy_w3, hy_bias, ssd_conv_w, ssd_conv_b,
              ssd_dt_bias, ssd_a_log, ssd_d, ssd_norm_g, ffn_w_gate, ffn_w_up,
              ffn_conv_w, ffn_conv_b, ffn_w_down, final_norm_g):
    rows = x.shape[1] // GRID_W
    lb_all = jnp.cumsum(jax.nn.softmax(hg_lb_logits.astype(F32), axis=0), axis=0)
    lb_all = lb_all - lb_all[0]
    for l in range(DEPTH):
        last = l == DEPTH - 1
        p = {
            "w_in": w_in[l], "w_out": w_out[l], "hg_norm_g": hg_norm_g[l],
            "hy_conv_w": hy_conv_w[l], "hy_conv_b": hy_conv_b[l],
            "hy_w1": hy_w1[l], "hy_b1": hy_b1[l], "hy_freq1": hy_freq1[l],
            "hy_w2": hy_w2[l], "hy_b2": hy_b2[l], "hy_freq2": hy_freq2[l],
            "hy_w3": hy_w3[l], "hy_bias": hy_bias[l],
            "ssd_conv_w": ssd_conv_w[l], "ssd_conv_b": ssd_conv_b[l],
            "ssd_dt_bias": ssd_dt_bias[l], "ssd_a_log": ssd_a_log[l],
            "ssd_d": ssd_d[l], "ssd_norm_g": ssd_norm_g[l],
            "ffn_w_gate": ffn_w_gate[l], "ffn_w_up": ffn_w_up[l],
            "ffn_conv_w": ffn_conv_w[l], "ffn_conv_b": ffn_conv_b[l],
            "ffn_w_down": ffn_w_down[l],
        }
        mx = [m[:, None, :] for m in jnp.split(jax.nn.silu(c) @ w_ada[l] + b_ada[l], 6, axis=-1)]
        mc = jnp.split(jax.nn.silu(c_ctx) @ w_ada[l] + b_ada[l], 6, axis=-1)
        hx = modulate(rms_norm(x, norm1_g[l]), mx[0], mx[1])
        hc = modulate(rms_norm(ctx, norm1_g[l]), mc[0], mc[1])
        yx, yc = token_mixers(hx, hc, p, lb_all[l].reshape(HG_HEADS, HG_DK), not last)
        x = x + mx[2] * yx
        x = x + mx[5] * conv_ffn(modulate(rms_norm(x, norm2_g[l]), mx[3], mx[4]), p, rows)
        if not last:
            ctx = ctx + mc[2] * yc
            ctx = ctx + mc[5] * conv_ffn(modulate(rms_norm(ctx, norm2_g[l]), mc[3], mc[4]), p, 1)
    return rms_norm(x, final_norm_g)
```

```cpp
#include <hip/hip_runtime.h>
#include <cstdio>
#include <cstdint>
namespace pg8 {
#define PG8_LAS __attribute__((address_space(3)))
typedef unsigned short bf16_t;
typedef short bf16x8 __attribute__((ext_vector_type(8)));
typedef float f32x4 __attribute__((ext_vector_type(4)));
typedef unsigned u32x4 __attribute__((ext_vector_type(4)));
constexpr int BM = 256, BK = 64, HALF = 128, HTB = HALF * BK * 2  , STAGE_BYTES = 8 * HTB, NXCD = 8, WGM = 8;

__host__ __device__ __forceinline__ int lds_byte(int r, int c) { const int st = (r >> 4) * 2 + (c >> 5), rr = r & 15, cc = c & 31, ob = rr * 64 + cc * 2; return st * 1024 + (ob ^ (((ob >> 9) & 1) << 5)); }
__host__ __device__ __forceinline__ void stage_rc(int b, int& R, int& C) { const int st = b / 1024, sb = b % 1024, swz = sb ^ (((sb >> 9) & 1) << 5); R = (st >> 1) * 16 + swz / 64; C = (st & 1) * 32 + (swz % 64) / 2; }
__host__ __device__ __forceinline__ int perm32(int rho) { const int n = rho >> 4, i = rho & 15; return 8 * (i >> 2) + 4 * n + (i & 3); }

struct Unit { int pm, pn; };
struct Gemm { const bf16_t* A; const bf16_t* Bt; int M, N, K; };

struct StaticOrder {
    int nM, nN, nwg, G, c;
    __host__ __device__ void init(int M, int N, int G_, int c_) { nM = M / BM; nN = N / BM; nwg = nM * nN; G = G_; c = c_; }
    __host__ __device__ bool next(int i, Unit& u) const {
        const long L = (long)i * G + c; if (L >= nwg) return false;
        int wgid = (int)L; { const int q = nwg / NXCD, r = nwg % NXCD, xcd = wgid % NXCD, off = wgid / NXCD; wgid = (xcd < r ? xcd * (q + 1) : r * (q + 1) + (xcd - r) * q) + off; }
        const int nig = WGM * nN, gid = wgid / nig, fm = gid * WGM, gsz = (nM - fm) < WGM ? (nM - fm) : WGM;
        u.pm = fm + ((wgid % nig) % gsz); u.pn = (wgid % nig) / gsz; return true;
    }
    __device__ __forceinline__ void a_ready(const Unit&) const {}
    __device__ __forceinline__ void done(const Unit&) const {}
};

__device__ __forceinline__ unsigned cvt_pk_bf16(float lo, float hi) { unsigned r; asm volatile("v_cvt_pk_bf16_f32 %0, %1, %2" : "=v"(r) : "v"(lo), "v"(hi)); return r; }
typedef float f32x2 __attribute__((ext_vector_type(2)));

struct EpiInProj {
    static constexpr bool PERM = true, AFTER_DRAIN = false;
    bf16_t* uhg; bf16_t* uhyT; bf16_t* ussd; float* udt; int mrows;
    __device__ __forceinline__ void operator()(const f32x4 (&acc)[2][2][4][2], const Unit& u, int wr, int wc, int fr, int fq) const {
        const int row0 = u.pm * BM + wr * 64 + fr;
        const int colt = u.pn * BM + wc * 32 + 8 * fq;
#pragma unroll
        for (int ai = 0; ai < 2; ++ai)
#pragma unroll
            for (int m = 0; m < 4; ++m) {
                const int r = row0 + ai * HALF + m * 16;
#pragma unroll
                for (int bj = 0; bj < 2; ++bj) {
                    const f32x4 v0 = acc[ai][bj][m][0], v1 = acc[ai][bj][m][1];
                    const int c = colt + bj * HALF;
                    if (u.pn < 5) {
                        u32x4 w; w.x = cvt_pk_bf16(v0[0], v0[1]); w.y = cvt_pk_bf16(v0[2], v0[3]); w.z = cvt_pk_bf16(v1[0], v1[1]); w.w = cvt_pk_bf16(v1[2], v1[3]);
                        *(u32x4*)(uhg + (size_t)r * 1280 + c) = w;
                    } else if (u.pn < 8) {
                        const int cc = c - 1280;
                        const unsigned w0 = cvt_pk_bf16(v0[0], v0[1]), w1 = cvt_pk_bf16(v0[2], v0[3]), w2 = cvt_pk_bf16(v1[0], v1[1]), w3 = cvt_pk_bf16(v1[2], v1[3]);
                        bf16_t* d = uhyT + (size_t)cc * mrows + r;
                        d[0] = (bf16_t)(w0 & 0xffffu); d[(size_t)mrows] = (bf16_t)(w0 >> 16); d[(size_t)2 * mrows] = (bf16_t)(w1 & 0xffffu); d[(size_t)3 * mrows] = (bf16_t)(w1 >> 16);
                        d[(size_t)4 * mrows] = (bf16_t)(w2 & 0xffffu); d[(size_t)5 * mrows] = (bf16_t)(w2 >> 16); d[(size_t)6 * mrows] = (bf16_t)(w3 & 0xffffu); d[(size_t)7 * mrows] = (bf16_t)(w3 >> 16);
                    } else {
                        const int cc = c - 2048;
                        if (cc < 1536) {
                            u32x4 w; w.x = cvt_pk_bf16(v0[0], v0[1]); w.y = cvt_pk_bf16(v0[2], v0[3]); w.z = cvt_pk_bf16(v1[0], v1[1]); w.w = cvt_pk_bf16(v1[2], v1[3]);
                            *(u32x4*)(ussd + (size_t)r * 1536 + cc) = w;
                        } else if (cc < 1552) {
                            float* d = udt + (size_t)r * 16 + (cc - 1536);
                            *(f32x4*)d = v0; *(f32x4*)(d + 4) = v1;
                        }
                    }
                }
            }
    }
};
struct EpiGateUp {
    static constexpr bool PERM = true, AFTER_DRAIN = false;
    bf16_t* a; bf16_t* up;
    __device__ __forceinline__ void operator()(const f32x4 (&acc)[2][2][4][2], const Unit& u, int wr, int wc, int fr, int fq) const {
        const int row0 = u.pm * BM + wr * 64 + fr;
        int colt = u.pn * BM; bf16_t* base = a; if (u.pn >= 11) { base = up; colt -= 2816; }
        colt += wc * 32 + 8 * fq;
#pragma unroll
        for (int ai = 0; ai < 2; ++ai)
#pragma unroll
            for (int m = 0; m < 4; ++m) { bf16_t* rowp = base + (size_t)(row0 + ai * HALF + m * 16) * 2816 + colt;
#pragma unroll
                for (int bj = 0; bj < 2; ++bj) { const f32x4 v0 = acc[ai][bj][m][0], v1 = acc[ai][bj][m][1];
                    u32x4 w; w.x = cvt_pk_bf16(v0[0], v0[1]); w.y = cvt_pk_bf16(v0[2], v0[3]); w.z = cvt_pk_bf16(v1[0], v1[1]); w.w = cvt_pk_bf16(v1[2], v1[3]);
                    *(u32x4*)(rowp + bj * HALF) = w; } }
    }
};
struct EpiResid {
    static constexpr bool PERM = false, AFTER_DRAIN = false;
    const float* xbase; float* xout; float* cstream; const float* cbase; const float* gate_x; int gate_bstride; const float* gate_c;
    __device__ __forceinline__ void operator()(const f32x4 (&acc)[2][2][4][2], const Unit& u, int wr, int wc, int fr, int fq) const {
        const int row0 = u.pm * BM + wr * 64 + fr;
        const int col0 = u.pn * BM + wc * 32 + 4 * fq;
        const bool isctx = u.pm >= 64;
#pragma unroll
        for (int bj = 0; bj < 2; ++bj)
#pragma unroll
            for (int n = 0; n < 2; ++n) {
                const int c = col0 + bj * HALF + n * 16;
#pragma unroll
                for (int ai = 0; ai < 2; ++ai)
#pragma unroll
                    for (int m = 0; m < 4; ++m) {
                        const int r = row0 + ai * HALF + m * 16;
                        if (!isctx) {
                            const f32x4 g = *(const f32x4*)(gate_x + (size_t)(r >> 13) * gate_bstride + c);
                            const f32x4 b = *(const f32x4*)(xbase + (size_t)r * 1024 + c);
                            *(f32x4*)(xout + (size_t)r * 1024 + c) = b + g * acc[ai][bj][m][n];
                        } else {
                            const f32x4 g = *(const f32x4*)(gate_c + c);
                            const f32x4 b = *(const f32x4*)(cbase + (size_t)(r - 16384) * 1024 + c);
                            *(f32x4*)(cstream + (size_t)(r - 16384) * 1024 + c) = b + g * acc[ai][bj][m][n];
                        }
                    }
            }
    }
};
template <class Epi, class Sched, bool ALIGN_EPI = false, bool SP2 = false>
__device__ __forceinline__ void gemm_phase(PG8_LAS unsigned char* lds, const Gemm g, const Sched& S, const Epi& E) {
    const int tid = threadIdx.x, wid = __builtin_amdgcn_readfirstlane(tid >> 6), lane = tid & 63, wr = wid >> 2, wc = wid & 3, fr = lane & 15, fq = lane >> 4;
    const int K = g.K, nt = K / BK;
    unsigned voffA[2], voffB[2];
#pragma unroll
    for (int i = 0; i < 2; ++i) { int R, C; stage_rc(tid * 16 + i * 8192, R, C); const int Rb = Epi::PERM ? ((R & ~31) + perm32(R & 31)) : R;
        voffA[i] = (unsigned)(R * K + C) * 2u; voffB[i] = (unsigned)(Rb * K + C) * 2u; }
    const size_t kstep = (size_t)(BK * 2);
    const size_t hstep = (size_t)HALF * K * 2;
    const size_t tstep = 2 * hstep;
    const unsigned ldsw = (unsigned)wid * 1024u;
    const int aoff = lds_byte(wr * 64 + fr, fq * 8), boff = lds_byte(wc * 32 + fr, fq * 8);
#define PG8_SA(b, h) (((b) * 2 + (h)) * HTB)
#define PG8_SB(b, h) ((4 + (b) * 2 + (h)) * HTB)
#define PG8_STAGE(bufoff, gbase, voff) do { _Pragma("unroll") for (int _i = 0; _i < 2; ++_i) \
        __builtin_amdgcn_global_load_lds((const unsigned*)((const char*)(gbase) + (voff)[_i]), (PG8_LAS unsigned*)(lds + (bufoff) + ldsw + _i * 8192), 16, 0, 0); } while (0)
#define PG8_LDA(dst, b, h) do { _Pragma("unroll") for (int m = 0; m < 4; ++m) _Pragma("unroll") for (int k = 0; k < 2; ++k) dst[m][k] = *(const PG8_LAS bf16x8*)(lds + PG8_SA(b, h) + aoff + m * 2048 + k * 1024); } while (0)
#define PG8_LDB(dst, b, h) do { _Pragma("unroll") for (int n = 0; n < 2; ++n) _Pragma("unroll") for (int k = 0; k < 2; ++k) dst[n][k] = *(const PG8_LAS bf16x8*)(lds + PG8_SB(b, h) + boff + n * 2048 + k * 1024); } while (0)
#define PG8_MMA(ai, bj, At, Bt) do { __builtin_amdgcn_s_setprio(1); _Pragma("unroll") for (int m = 0; m < 4; ++m) _Pragma("unroll") for (int n = 0; n < 2; ++n) _Pragma("unroll") for (int k = 0; k < 2; ++k) \
        acc[ai][bj][m][n] = __builtin_amdgcn_mfma_f32_16x16x32_bf16(Bt[n][k], At[m][k], acc[ai][bj][m][n], 0, 0, 0); __builtin_amdgcn_s_setprio(0); } while (0)
#define PG8_WAIT_V(n) asm volatile("s_waitcnt vmcnt(" #n ")" ::: "memory")
#define PG8_WAIT_L(n) asm volatile("s_waitcnt lgkmcnt(" #n ")" ::: "memory")
#define PG8_BAR __builtin_amdgcn_s_barrier()
#define PG8_SCHED __builtin_amdgcn_sched_barrier(0)
    Unit cur, nxt; int ui = 0;
    if (!S.next(0, cur)) return;
    f32x4 acc[2][2][4][2];
#pragma unroll
    for (int a = 0; a < 2; ++a)
#pragma unroll
        for (int b = 0; b < 2; ++b)
#pragma unroll
            for (int m = 0; m < 4; ++m)
#pragma unroll
                for (int n = 0; n < 2; ++n) acc[a][b][m][n] = (f32x4){0.f, 0.f, 0.f, 0.f};
    bf16x8 At[4][2], B0[2][2], B1[2][2];
    const char* cA = (const char*)g.A + (size_t)cur.pm * tstep; const char* cB = (const char*)g.Bt + (size_t)cur.pn * tstep;
    S.a_ready(cur);
    if constexpr (SP2) {
        PG8_STAGE(PG8_SB(0, 0), cB, voffB); PG8_STAGE(PG8_SB(0, 1), cB + hstep, voffB); PG8_STAGE(PG8_SA(0, 0), cA, voffA); PG8_STAGE(PG8_SA(0, 1), cA + hstep, voffA);
        if (wr == 1) PG8_BAR;
        PG8_WAIT_V(2); PG8_BAR;
        PG8_STAGE(PG8_SB(1, 0), cB + kstep, voffB); PG8_STAGE(PG8_SA(1, 0), cA + kstep, voffA); PG8_STAGE(PG8_SB(1, 1), cB + hstep + kstep, voffB);
        PG8_WAIT_V(6); PG8_BAR;
    } else {
        PG8_STAGE(PG8_SB(0, 0), cB, voffB); PG8_STAGE(PG8_SA(0, 0), cA, voffA); PG8_STAGE(PG8_SB(0, 1), cB + hstep, voffB); PG8_STAGE(PG8_SA(0, 1), cA + hstep, voffA);
        if (wr == 1) PG8_BAR;
        PG8_WAIT_V(4); PG8_BAR;
        PG8_STAGE(PG8_SB(1, 0), cB + kstep, voffB); PG8_STAGE(PG8_SA(1, 0), cA + kstep, voffA); PG8_STAGE(PG8_SB(1, 1), cB + hstep + kstep, voffB);
        PG8_WAIT_V(6); PG8_BAR;
    }
    for (;;) {
        const bool has_next = S.next(ui + 1, nxt);
        const char* nA = has_next ? (const char*)g.A + (size_t)nxt.pm * tstep : cA; const char* nB = has_next ? (const char*)g.Bt + (size_t)nxt.pn * tstep : cB;
        for (int t = 0; t < nt; t += 2) {
            const bool last = (t == nt - 2);
            const char* a1 = cA + (size_t)(t + 1) * kstep;
            const char* a2 = last ? nA : cA + (size_t)(t + 2) * kstep; const char* b2 = last ? nB : cB + (size_t)(t + 2) * kstep;
            const char* a3 = a2 + kstep; const char* b3 = b2 + kstep;
            if (last && has_next) S.a_ready(nxt);
            if constexpr (SP2) {
            PG8_LDB(B0, 0, 0); PG8_LDB(B1, 0, 1); PG8_SCHED; PG8_LDA(At, 0, 0); PG8_STAGE(PG8_SA(1, 1), a1 + hstep, voffA);
            PG8_WAIT_V(8); PG8_WAIT_L(0); PG8_BAR; PG8_MMA(0, 0, At, B0); PG8_MMA(0, 1, At, B1); PG8_BAR; PG8_SCHED;
            PG8_LDA(At, 0, 1); PG8_STAGE(PG8_SB(0, 0), b2, voffB); PG8_STAGE(PG8_SB(0, 1), b2 + hstep, voffB); PG8_STAGE(PG8_SA(0, 0), a2, voffA);
            PG8_WAIT_V(8); PG8_WAIT_L(0); PG8_BAR; PG8_MMA(1, 0, At, B0); PG8_MMA(1, 1, At, B1); PG8_BAR; PG8_SCHED;
            PG8_LDB(B0, 1, 0); PG8_LDB(B1, 1, 1); PG8_SCHED; PG8_LDA(At, 1, 0); PG8_STAGE(PG8_SA(0, 1), a2 + hstep, voffA);
            PG8_WAIT_V(8); PG8_WAIT_L(0); PG8_BAR; PG8_MMA(0, 0, At, B0); PG8_MMA(0, 1, At, B1); PG8_BAR; PG8_SCHED;
            PG8_LDA(At, 1, 1); PG8_STAGE(PG8_SB(1, 0), b3, voffB); PG8_STAGE(PG8_SB(1, 1), b3 + hstep, voffB); PG8_STAGE(PG8_SA(1, 0), a3, voffA);
            PG8_WAIT_V(8); PG8_WAIT_L(0); PG8_BAR; PG8_MMA(1, 0, At, B0); PG8_MMA(1, 1, At, B1); PG8_BAR; PG8_SCHED;
            } else {
            PG8_LDB(B0, 0, 0); PG8_SCHED; PG8_LDA(At, 0, 0); PG8_STAGE(PG8_SA(1, 1), a1 + hstep, voffA);
            PG8_WAIT_L(8); PG8_BAR; PG8_WAIT_L(0); PG8_MMA(0, 0, At, B0); PG8_BAR; PG8_SCHED;
            PG8_LDB(B1, 0, 1); PG8_STAGE(PG8_SB(0, 0), b2, voffB);
            PG8_BAR; PG8_WAIT_L(0); PG8_MMA(0, 1, At, B1); PG8_BAR;
            PG8_LDA(At, 0, 1); PG8_STAGE(PG8_SA(0, 0), a2, voffA);
            PG8_BAR; PG8_WAIT_L(0); PG8_MMA(1, 0, At, B0); PG8_BAR; PG8_SCHED;
            PG8_STAGE(PG8_SB(0, 1), b2 + hstep, voffB);
            PG8_WAIT_V(6); PG8_BAR; PG8_MMA(1, 1, At, B1); PG8_BAR;
            PG8_LDB(B0, 1, 0); PG8_SCHED; PG8_LDA(At, 1, 0); PG8_STAGE(PG8_SA(0, 1), a2 + hstep, voffA);
            PG8_WAIT_L(8); PG8_BAR; PG8_WAIT_L(0); PG8_MMA(0, 0, At, B0); PG8_BAR; PG8_SCHED;
            PG8_LDB(B1, 1, 1); PG8_STAGE(PG8_SB(1, 0), b3, voffB);
            PG8_BAR; PG8_WAIT_L(0); PG8_MMA(0, 1, At, B1); PG8_BAR;
            PG8_LDA(At, 1, 1); PG8_STAGE(PG8_SA(1, 0), a3, voffA);
            PG8_BAR; PG8_WAIT_L(0); PG8_MMA(1, 0, At, B0); PG8_BAR; PG8_SCHED;
            PG8_STAGE(PG8_SB(1, 1), b3 + hstep, voffB);
            PG8_WAIT_V(6); PG8_BAR; PG8_MMA(1, 1, At, B1); PG8_BAR;
            }
        }
        if constexpr (ALIGN_EPI) { if (wr == 0) PG8_BAR; }
        if constexpr (!Epi::AFTER_DRAIN) { E(acc, cur, wr, wc, fr, fq); S.done(cur); }
        if (!has_next) break;
#pragma unroll
        for (int a = 0; a < 2; ++a)
#pragma unroll
            for (int b = 0; b < 2; ++b)
#pragma unroll
                for (int m = 0; m < 4; ++m)
#pragma unroll
                    for (int n = 0; n < 2; ++n) acc[a][b][m][n] = (f32x4){0.f, 0.f, 0.f, 0.f};
        cur = nxt; cA = nA; cB = nB; ++ui;
        if constexpr (ALIGN_EPI) { if (wr == 1) PG8_BAR; }
    }
    PG8_WAIT_V(0);
    if constexpr (!ALIGN_EPI) { if (wr == 0) PG8_BAR; }
    PG8_BAR;
    if constexpr (Epi::AFTER_DRAIN) { E.fused(acc, cur, wr, wc, fr, fq, lds, wid, lane); S.done(cur); }
#undef PG8_SA
#undef PG8_SB
#undef PG8_STAGE
#undef PG8_LDA
#undef PG8_LDB
#undef PG8_MMA
#undef PG8_WAIT_V
#undef PG8_WAIT_L
#undef PG8_BAR
#undef PG8_SCHED
}
}
#define GAS __attribute__((address_space(1)))
#define LAS __attribute__((address_space(3)))
typedef unsigned short bf16;
typedef unsigned v4u __attribute__((ext_vector_type(4)));
typedef float f32x4 __attribute__((ext_vector_type(4)));
typedef short bf16x8 __attribute__((ext_vector_type(8)));
typedef GAS unsigned gu32;
typedef GAS unsigned long long gu64;
#define RLX_AGENT __ATOMIC_RELAXED, __HIP_MEMORY_SCOPE_AGENT
#define LDS_WAIT() asm volatile("s_waitcnt lgkmcnt(0)" ::: "memory")
#define VM_WAIT() asm volatile("s_waitcnt vmcnt(0)" ::: "memory")
__device__ __forceinline__ unsigned long long rt() { return __builtin_amdgcn_s_memrealtime(); }
__device__ __forceinline__ unsigned f2bf(float f) { unsigned u = __builtin_bit_cast(unsigned, f); return (u + 0x7fffu + ((u >> 16) & 1u)) >> 16; }
__device__ __forceinline__ unsigned pk2(float lo, float hi) { return f2bf(lo) | (f2bf(hi) << 16); }

#define XB_TMO      128
#define XB_XCNT(j)  (256  + 64 * (j))
#define XB_XSUB(j)  (1280 + 64 * (j))
#define XB_XGEN(j)  (2304 + 64 * (j))
#define XB_TOP      3328
#define XB_TOPGEN   3392
#define XCD_BAR_WORDS 3456
#define XB_SPIN_CAP (1u << 18)

__device__ __forceinline__ unsigned xb_ld(unsigned* p)              { return __hip_atomic_load(p, __ATOMIC_RELAXED, __HIP_MEMORY_SCOPE_AGENT); }
__device__ __forceinline__ unsigned xb_add(unsigned* p, unsigned v) { return __hip_atomic_fetch_add(p, v, __ATOMIC_RELAXED, __HIP_MEMORY_SCOPE_AGENT); }
__device__ __forceinline__ unsigned xb_xcc_id() { return (unsigned)__builtin_amdgcn_s_getreg((3 << 11) | 20) & 0xFu; }
#define XB_SPIN(cond, bar) do { unsigned _sp = 0; while (cond) { __builtin_amdgcn_s_sleep(1); \
    if ((++_sp & 255u) == 0u) { if (xb_ld(&(bar)[XB_TMO])) break; if (_sp > XB_SPIN_CAP) { atomicAdd(&(bar)[XB_TMO], 1u); break; } } } } while (0)

struct XcdBarrier {
    unsigned* bar; unsigned x;
    volatile LAS unsigned* st;
};

__device__ __forceinline__ XcdBarrier xcd_barrier_post(unsigned* bar, volatile LAS unsigned* st) {
    XcdBarrier b; b.bar = bar; b.x = xb_xcc_id(); b.st = st;
    if (threadIdx.x == 0) (void)xb_add(&bar[XB_XCNT(b.x)], 1u);
    return b;
}
__device__ __forceinline__ void xcd_barrier_complete(unsigned* bar, unsigned x, unsigned& nloc, unsigned& nx) {
    const unsigned G = gridDim.x * gridDim.y * gridDim.z;
    unsigned sum, cnt, mine, sp = 0u;
    for (;;) {
        sum = 0u; cnt = 0u; mine = 0u;
#pragma unroll
        for (unsigned j = 0; j < 16; ++j) { const unsigned c = xb_ld(&bar[XB_XCNT(j)]); sum += c; cnt += (c > 0u) ? 1u : 0u; mine = (j == x) ? c : mine; }
        if (sum == G) break;
        __builtin_amdgcn_s_sleep(1);
        if ((++sp & 255u) == 0u) { if (xb_ld(&bar[XB_TMO])) break; if (sp > XB_SPIN_CAP) { atomicAdd(&bar[XB_TMO], 1u); break; } }
    }
    nloc = mine > 0u ? mine : 1u; nx = cnt > 0u ? cnt : 1u;
}

__device__ __forceinline__ void xcd_barrier(const XcdBarrier& b) {
    asm volatile("s_waitcnt vmcnt(0)" ::: "memory");
    __syncthreads();
    if (threadIdx.x == 0) {
        unsigned* bar = b.bar;
        __builtin_amdgcn_s_waitcnt(0);
        unsigned nloc = b.st[0], nx = b.st[1];
        if (nloc == 0u) { xcd_barrier_complete(bar, b.x, nloc, nx); b.st[0] = nloc; b.st[1] = nx; }
        const unsigned old = xb_add(&bar[XB_XSUB(b.x)], 1u);
        const unsigned gen = old / nloc;
        if (old + 1u == (gen + 1u) * nloc) {
            __builtin_amdgcn_fence(__ATOMIC_RELEASE, "agent");
            asm volatile("s_waitcnt vmcnt(0)" ::: "memory");
            const unsigned og = xb_add(&bar[XB_TOP], 1u);
            const unsigned tg = og / nx;
            if (og + 1u == (tg + 1u) * nx) xb_add(&bar[XB_TOPGEN], 1u);
            else XB_SPIN(xb_ld(&bar[XB_TOPGEN]) == tg, bar);
            __builtin_amdgcn_fence(__ATOMIC_ACQUIRE, "agent");
            xb_add(&bar[XB_XGEN(b.x)], 1u);
            asm volatile("s_waitcnt vmcnt(0)" ::: "memory");
        } else {
            XB_SPIN(xb_ld(&bar[XB_XGEN(b.x)]) == gen, bar);
            __builtin_amdgcn_fence(__ATOMIC_ACQUIRE, "agent");
            asm volatile("s_waitcnt vmcnt(0)" ::: "memory");
        }
    }
    __syncthreads();
}
constexpr int NWAVES = 8, NTHR = 512;
constexpr int LX = 8192, LC = 256, DM = 1024, MXR = 16384, MROWS = 16896, NINP = 3840, DFF = 2816;
constexpr float EPS = 1e-6f;
constexpr size_t MiB = 1u << 20, KiB = 1u << 10;
constexpr size_t WS_CTL = 0, CTL_ZERO_BYTES = 64 * KiB;
constexpr size_t WS_MODS = 1 * MiB;
constexpr size_t WS_TW = 1 * MiB + 512 * KiB;
constexpr size_t WS_CTXS = 2 * MiB;
constexpr size_t WS_H2 = 4 * MiB;
constexpr size_t WS_H2C = 8 * MiB;
constexpr size_t WS_SSQ = 8 * MiB + 64 * KiB;
constexpr size_t WS_DTS = 8 * MiB + 640 * KiB;
constexpr size_t WS_DTH = 8 * MiB + 704 * KiB;
constexpr size_t WS_UDT = 9 * MiB;
constexpr size_t WS_WIN = 11 * MiB;
constexpr size_t WS_WOUT = 18 * MiB + 512 * KiB;
constexpr size_t WS_HN = 21 * MiB;
constexpr size_t WS_UHG = 54 * MiB;
constexpr size_t WS_UHY = 96 * MiB;
constexpr size_t WS_USSD = 121 * MiB;
constexpr size_t WS_SST = 171 * MiB;
constexpr size_t WS_HST = 204 * MiB;
constexpr size_t WS_MIX = 213 * MiB;
constexpr size_t WS_HYO = 246 * MiB;
constexpr size_t WS_A = 54 * MiB;
constexpr size_t WS_UP = 145 * MiB;
constexpr size_t WS_WGU = 236 * MiB;
constexpr size_t WS_WD = 247 * MiB;
constexpr size_t WS_END = 256 * MiB;
constexpr int HSP = 8200;
constexpr int CW_BAR = 1024;
constexpr int RING_BYTES = 131072, SCR_OFF = 131072, LDS_BYTES = 147456, MISC_OFF = LDS_BYTES - 128;

typedef float f32x2 __attribute__((ext_vector_type(2)));
typedef unsigned u32x2 __attribute__((ext_vector_type(2)));
typedef unsigned u32x4 __attribute__((ext_vector_type(4)));
#define MFMA4(a, b, c) __builtin_amdgcn_mfma_f32_16x16x4f32((a), (b), (c), 0, 0, 0)

__device__ __forceinline__ float bflo(unsigned w) { return __builtin_bit_cast(float, w << 16); }
__device__ __forceinline__ float bfhi(unsigned w) { return __builtin_bit_cast(float, w & 0xffff0000u); }
__device__ __forceinline__ float bf2f(bf16 h) { return __builtin_bit_cast(float, (unsigned)h << 16); }
__device__ __forceinline__ float siluf(float x) { return x / (1.0f + __expf(-x)); }
__device__ __forceinline__ float sigmf(float x) { return 1.0f / (1.0f + __expf(-x)); }
__device__ __forceinline__ float wave_sum(float v) {
#pragma unroll
    for (int o = 1; o < 64; o <<= 1) v += __shfl_xor(v, o);
    return v;
}
__device__ __forceinline__ void block_sum2(float& a, float& b, LAS float* red, int wave, int lane) {
    a = wave_sum(a); b = wave_sum(b);
    __syncthreads();
    if (lane == 0) { red[wave] = a; red[8 + wave] = b; }
    __syncthreads();
    float sa = 0.f, sb = 0.f;
#pragma unroll
    for (int w = 0; w < 8; ++w) { sa += red[w]; sb += red[8 + w]; }
    a = sa; b = sb;
    __syncthreads();
}

__device__ __forceinline__ void p0_mods_item(const float* c, const float* cctx, const float* w_ada, const float* b_ada, float* mods, LAS float* sm, int item, int tid, int wave, int lane) {
    for (int k = tid; k < 1024; k += NTHR) { sm[k] = siluf(c[k]); sm[1024 + k] = siluf(c[1024 + k]); sm[2048 + k] = siluf(cctx[k]); }
    __syncthreads();
    const int l = item / 96, n0 = (item % 96) * 64;
    const float* W = w_ada + (size_t)l * 1024 * 6144 + n0 + lane;
    float a0 = 0.f, a1 = 0.f, a2 = 0.f;
#pragma unroll 8
    for (int kk = 0; kk < 128; ++kk) { const int k = wave * 128 + kk; const float w = W[(size_t)k * 6144]; a0 += sm[k] * w; a1 += sm[1024 + k] * w; a2 += sm[2048 + k] * w; }
    LAS float* red = sm + 3072;
    red[(wave * 3 + 0) * 64 + lane] = a0; red[(wave * 3 + 1) * 64 + lane] = a1; red[(wave * 3 + 2) * 64 + lane] = a2;
    __syncthreads();
    if (tid < 192) { const int v = tid >> 6, ln = tid & 63; float s = 0.f;
#pragma unroll
        for (int w = 0; w < 8; ++w) s += red[(w * 3 + v) * 64 + ln];
        mods[(size_t)(l * 3 + v) * 6144 + n0 + ln] = s + b_ada[(size_t)l * 6144 + n0 + ln]; }
    __syncthreads();
}
__device__ __forceinline__ void p0_h2_rows(const float* w1, const float* b1, const float* f1, const float* w2, const float* b2, const float* f2, float* out, int slen, int first, int step, int lane) {
    float w1c[33], w2c[64];
#pragma unroll
    for (int i = 0; i < 33; ++i) w1c[i] = w1[i * 64 + lane];
#pragma unroll
    for (int i = 0; i < 64; ++i) w2c[i] = w2[i * 64 + lane];
    const float bb1 = b1[lane], ff1 = f1[lane], bb2 = b2[lane], ff2 = f2[lane];
#pragma unroll 1
    for (int t = first; t < slen; t += step) {
        const float tl = (float)t / (float)(slen - 1);
        const float w = (6.283185307179586f * (float)t) / (float)slen;
        float z = 0.f;
        if (lane == 0) z = tl;
        else if (lane <= 16) { const float band = 1e-4f + (float)(lane - 1) * ((15.0f - 1e-4f) / 15.0f); z = __cosf(band * w); }
        else if (lane <= 32) { const float band = 1e-4f + (float)(lane - 17) * ((15.0f - 1e-4f) / 15.0f); z = -__sinf(band * w); }
        float pre = bb1;
#pragma unroll
        for (int i = 0; i < 33; ++i) pre += __builtin_bit_cast(float, __builtin_amdgcn_readlane(__builtin_bit_cast(int, z), i)) * w1c[i];
        const float h1 = __sinf(ff1 * pre);
        float pre2 = bb2;
#pragma unroll
        for (int i = 0; i < 64; ++i) pre2 += __builtin_bit_cast(float, __builtin_amdgcn_readlane(__builtin_bit_cast(int, h1), i)) * w2c[i];
        out[(size_t)t * 64 + lane] = __sinf(ff2 * pre2);
    }
}
__device__ __forceinline__ void transpose_item(const float* W, int K, int N, int Nvalid, bf16* WT, LAS float* scr, int item, int lane) {
    const int nblk = N / 32, kb = item / nblk, nb = item % nblk, k0 = 64 * kb, n0 = 32 * nb;
    const int nn = n0 + (lane & 31);
#pragma unroll 8
    for (int i = 0; i < 32; ++i) { const int kk = 2 * i + (lane >> 5); scr[kk * 33 + (lane & 31)] = nn < Nvalid ? W[(size_t)(k0 + kk) * Nvalid + nn] : 0.f; }
    LDS_WAIT(); asm volatile("" ::: "memory");
    const int c = lane & 7;
#pragma unroll
    for (int j = 0; j < 4; ++j) { const int n = (lane >> 3) + 8 * j; const LAS float* s = scr + (8 * c) * 33 + n;
        v4u o; o.x = pk2(s[0 * 33], s[1 * 33]); o.y = pk2(s[2 * 33], s[3 * 33]); o.z = pk2(s[4 * 33], s[5 * 33]); o.w = pk2(s[6 * 33], s[7 * 33]);
        *(GAS v4u*)(WT + (size_t)(n0 + n) * K + k0 + 8 * c) = o; }
    LDS_WAIT(); asm volatile("" ::: "memory");
}
__device__ __forceinline__ void convert_weight(const float* W, int K, int N, int Nvalid, bf16* WT, LAS float* scr, int gw, int ngw, int lane) {
    const int nitems = (K / 64) * (N / 32);
#pragma unroll 1
    for (int it = gw; it < nitems; it += ngw) transpose_item(W, K, N, Nvalid, WT, scr, it, lane);
}

__device__ __forceinline__ void norm_rows(const float* xsrc, const float* csrc, int nrows, const float* g, const float* mods_l, int kshift, int kscale, bf16* hn, int gw, int ngw, int lane) {
    f32x4 gv[4];
#pragma unroll
    for (int j = 0; j < 4; ++j) gv[j] = *(const f32x4*)(g + 4 * lane + 256 * j);
#pragma unroll 1
    for (int m = gw; m < nrows; m += ngw) {
        const float* src = m < MXR ? xsrc + (size_t)m * DM : csrc + (size_t)(m - MXR) * DM;
        const int v = m < MXR ? (m >> 13) : 2;
        const float* sh = mods_l + (size_t)v * 6144 + kshift * 1024; const float* sc = mods_l + (size_t)v * 6144 + kscale * 1024;
        f32x4 x[4]; float ss = 0.f;
#pragma unroll
        for (int j = 0; j < 4; ++j) { x[j] = *(const f32x4*)(src + 4 * lane + 256 * j); ss += (x[j].x * x[j].x + x[j].y * x[j].y) + (x[j].z * x[j].z + x[j].w * x[j].w); }
        const float rstd = 1.0f / sqrtf(wave_sum(ss) * (1.0f / DM) + EPS);
#pragma unroll
        for (int j = 0; j < 4; ++j) {
            const f32x4 s4 = *(const f32x4*)(sc + 4 * lane + 256 * j), h4 = *(const f32x4*)(sh + 4 * lane + 256 * j);
            const f32x4 y = x[j] * rstd * gv[j] * (s4 + 1.0f) + h4;
            u32x2 o; o.x = pk2(y.x, y.y); o.y = pk2(y.z, y.w);
            *(u32x2*)(hn + (size_t)m * DM + 4 * lane + 256 * j) = o;
        }
    }
}
__device__ __forceinline__ void final_norm_rows(float* x, const float* g, int gw, int ngw, int lane) {
    f32x4 gv[4];
#pragma unroll
    for (int j = 0; j < 4; ++j) gv[j] = *(const f32x4*)(g + 4 * lane + 256 * j);
#pragma unroll 1
    for (int m = gw; m < MXR; m += ngw) {
        float* src = x + (size_t)m * DM;
        f32x4 v[4]; float ss = 0.f;
#pragma unroll
        for (int j = 0; j < 4; ++j) { v[j] = *(const f32x4*)(src + 4 * lane + 256 * j); ss += (v[j].x * v[j].x + v[j].y * v[j].y) + (v[j].z * v[j].z + v[j].w * v[j].w); }
        const float rstd = 1.0f / sqrtf(wave_sum(ss) * (1.0f / DM) + EPS);
#pragma unroll
        for (int j = 0; j < 4; ++j) *(f32x4*)(src + 4 * lane + 256 * j) = v[j] * rstd * gv[j];
    }
}

__device__ __forceinline__ void ffn_conv_phase(const bf16* a, bf16* up, const float* cw  , const float* cb, int nrows, int gtid, int ngt) {
    const int ncg = DFF / 8;
#pragma unroll 1
    for (int idx = gtid; idx < nrows * ncg; idx += ngt) {
        const int row = idx / ncg, c = (idx % ncg) * 8;
        float acc[8];
        { const f32x4 b0 = *(const f32x4*)(cb + c), b1 = *(const f32x4*)(cb + c + 4); acc[0] = b0.x; acc[1] = b0.y; acc[2] = b0.z; acc[3] = b0.w; acc[4] = b1.x; acc[5] = b1.y; acc[6] = b1.z; acc[7] = b1.w; }
        int rr, ww, nr, nw;
        if (row < MXR) { const int t = row & 8191; rr = t >> 6; ww = t & 63; nr = 128; nw = 64; } else { const int t = (row - MXR) & 255; rr = 0; ww = t; nr = 1; nw = 256; }
#pragma unroll
        for (int ky = 0; ky < 3; ++ky)
#pragma unroll
            for (int kx = 0; kx < 3; ++kx) {
                const int r2 = rr + ky - 1, w2 = ww + kx - 1;
                if (r2 >= 0 && r2 < nr && w2 >= 0 && w2 < nw) {
                    const int nrow = row + (ky - 1) * nw + (kx - 1);
                    const u32x4 av = *(const u32x4*)(a + (size_t)nrow * DFF + c);
                    const float* wp = cw + (size_t)(ky * 3 + kx) * DFF + c;
                    const f32x4 w0 = *(const f32x4*)wp, w1 = *(const f32x4*)(wp + 4);
                    acc[0] += w0.x * bflo(av.x); acc[1] += w0.y * bfhi(av.x); acc[2] += w0.z * bflo(av.y); acc[3] += w0.w * bfhi(av.y);
                    acc[4] += w1.x * bflo(av.z); acc[5] += w1.y * bfhi(av.z); acc[6] += w1.z * bflo(av.w); acc[7] += w1.w * bfhi(av.w);
                }
            }
        const u32x4 uv = *(const u32x4*)(up + (size_t)row * DFF + c);
        u32x4 o;
        o.x = pk2(siluf(acc[0]) * bflo(uv.x), siluf(acc[1]) * bfhi(uv.x)); o.y = pk2(siluf(acc[2]) * bflo(uv.y), siluf(acc[3]) * bfhi(uv.y));
        o.z = pk2(siluf(acc[4]) * bflo(uv.z), siluf(acc[5]) * bfhi(uv.z)); o.w = pk2(siluf(acc[6]) * bflo(uv.w), siluf(acc[7]) * bfhi(uv.w));
        *(u32x4*)(up + (size_t)row * DFF + c) = o;
    }
}
constexpr int FN = 16384;
__device__ __forceinline__ f32x2 cmul(f32x2 a, f32x2 b) { return (f32x2){a.x * b.x - a.y * b.y, a.x * b.y + a.y * b.x}; }
__device__ __forceinline__ f32x2 cmulc(f32x2 a, f32x2 b) { return (f32x2){a.x * b.x + a.y * b.y, a.y * b.x - a.x * b.y}; }
__device__ __forceinline__ int rev4(int p) {
    unsigned r = __brev((unsigned)p) >> 18;
    return (int)(((r & 0x1555u) << 1) | ((r >> 1) & 0x1555u));
}
template <bool INV> __device__ __forceinline__ void fft_pass(LAS f32x2* D, const f32x2* tw, int lgq, int tid) {
    const int q = 1 << lgq, tsh = 12 - lgq;
#pragma unroll 2
    for (int it = 0; it < 8; ++it) {
        const int bf = tid + NTHR * it, j = bf & (q - 1), blk = bf >> lgq, i0 = (blk << (lgq + 2)) + j;
        f32x2 x0 = D[i0], x1 = D[i0 + q], x2 = D[i0 + 2 * q], x3 = D[i0 + 3 * q];
        const f32x2 w1 = tw[j << tsh], w2 = cmul(w1, w1), w3 = cmul(w2, w1);
        if (!INV) {
            const f32x2 a = x0 + x2, b = x0 - x2, c = x1 + x3, d = x1 - x3;
            const f32x2 X0 = a + c, X2 = a - c, X1 = (f32x2){b.x + d.y, b.y - d.x}, X3 = (f32x2){b.x - d.y, b.y + d.x};
            D[i0] = X0; D[i0 + q] = cmul(X1, w1); D[i0 + 2 * q] = cmul(X2, w2); D[i0 + 3 * q] = cmul(X3, w3);
        } else {
            x1 = cmulc(x1, w1); x2 = cmulc(x2, w2); x3 = cmulc(x3, w3);
            const f32x2 a = x0 + x2, b = x0 - x2, c = x1 + x3, d = x1 - x3;
            D[i0] = a + c; D[i0 + 2 * q] = a - c; D[i0 + q] = (f32x2){b.x - d.y, b.y + d.x}; D[i0 + 3 * q] = (f32x2){b.x + d.y, b.y - d.x};
        }
    }
    __syncthreads();
}
__device__ __forceinline__ void fft_fwd(LAS f32x2* D, const f32x2* tw, int tid) {
#pragma unroll 1
    for (int lgq = 12; lgq >= 0; lgq -= 2) fft_pass<false>(D, tw, lgq, tid);
}
__device__ __forceinline__ void fft_inv(LAS f32x2* D, const f32x2* tw, int tid) {
#pragma unroll 1
    for (int lgq = 0; lgq <= 12; lgq += 2) fft_pass<true>(D, tw, lgq, tid);
}
__device__ __forceinline__ void spec_mul(LAS f32x2* D, const f32x2* H, int tid) {
#pragma unroll 4
    for (int i = 0; i < 32; ++i) {
        const int p = tid + NTHR * i, k = rev4(p);
        f32x2 h;
        if (k <= 8192) h = H[k]; else { h = H[FN - k]; h.y = -h.y; }
        D[p] = cmul(D[p], h);
    }
    __syncthreads();
}

__device__ __forceinline__ void hy_spectrum_item(LAS unsigned char* lds, const float* h2l  , const float* w3l  , const float* hbias  , f32x2* Hs, const f32x2* tw, int c, int tid, int wave, int lane) {
    LAS f32x2* D = (LAS f32x2*)lds;
    LAS f32x4* W3 = (LAS f32x4*)(lds + SCR_OFF);
    LAS float* red = (LAS float*)(lds + SCR_OFF + 2048);
    __syncthreads();
    if (tid < 64) { const float* wr = w3l + (size_t)tid * 1024 + c; W3[tid] = (f32x4){wr[0], wr[256], wr[512], wr[768]}; }
    __syncthreads();
    const float delta = fabsf(-3.0701134573253946f + (float)c * ((-15.350567286626973f + 3.0701134573253946f) / 255.0f));
    float s0 = 0.f, s1 = 0.f;
#pragma unroll 1
    for (int i = 0; i < 16; ++i) {
        const int t = tid + NTHR * i;
        asm volatile("" ::: "memory");
        const f32x4* hr = (const f32x4*)(h2l + (size_t)t * 64);
        float a0 = 0.f, a1 = 0.f, a2 = 0.f, a3 = 0.f;
#pragma unroll 4
        for (int j4 = 0; j4 < 16; ++j4) { const f32x4 hv = hr[j4];
            const f32x4 wa = W3[4 * j4 + 0], wb = W3[4 * j4 + 1], wc = W3[4 * j4 + 2], wd = W3[4 * j4 + 3];
            a0 += wa.x * hv.x + wb.x * hv.y + wc.x * hv.z + wd.x * hv.w; a1 += wa.y * hv.x + wb.y * hv.y + wc.y * hv.z + wd.y * hv.w;
            a2 += wa.z * hv.x + wb.z * hv.y + wc.z * hv.z + wd.z * hv.w; a3 += wa.w * hv.x + wb.w * hv.y + wc.w * hv.z + wd.w * hv.w; }
        f32x4 acc = (f32x4){a0, a1, a2, a3};
        const float dec = expf(-((float)t / 8191.0f) * delta);
        acc *= dec;
        D[t] = (f32x2){acc.x, acc.y};
        s0 += fabsf(acc.x); s1 += fabsf(acc.y);
        if (t >= 1) { D[FN - t] = (f32x2){acc.z, acc.w}; s0 += fabsf(acc.z); s1 += fabsf(acc.w); }
        if (t == 0) D[8192] = (f32x2){0.f, 0.f};
    }
    block_sum2(s0, s1, red, wave, lane);
    fft_fwd(D, tw, tid);
    const float i0 = 0.5f / s0, i1 = 0.5f / s1, bias0 = hbias[c], bias1 = hbias[256 + c];
#pragma unroll 1
    for (int i = 0; i < 17; ++i) {
        const int k = tid + NTHR * i;
        if (k <= 8192) {
            const f32x2 zk = D[rev4(k)], zn = D[rev4((FN - k) & (FN - 1))];
            Hs[(size_t)(c * 2 + 0) * HSP + k] = (f32x2){(zk.x + zn.x) * i0 + bias0, (zk.y - zn.y) * i0};
            Hs[(size_t)(c * 2 + 1) * HSP + k] = (f32x2){(zk.y + zn.y) * i1 + bias1, -(zk.x - zn.x) * i1};
        }
    }
    __syncthreads();
}

__device__ __forceinline__ float hy_conv3(const bf16* row, int t, int len, float w0, float w1, float w2, float bias) {
    const float um = t > 0 ? bf2f(row[t - 1]) : 0.f, u0 = bf2f(row[t]), up = t < len - 1 ? bf2f(row[t + 1]) : 0.f;
    return w0 * um + w1 * u0 + w2 * up + bias;
}
__device__ __forceinline__ void hy_fft_item(LAS unsigned char* lds, const bf16* uhyT, const float* cw  , const float* cb  , const f32x2* Hs, const f32x2* tw, bf16* hyoT, int c, int tid) {
    LAS f32x2* D = (LAS f32x2*)lds;
    const bf16* rv = uhyT + (size_t)c * MROWS; const bf16* r1 = uhyT + (size_t)(256 + c) * MROWS; const bf16* r2 = uhyT + (size_t)(512 + c) * MROWS;
    const float vw0 = cw[c], vw1 = cw[768 + c], vw2 = cw[1536 + c], vb = cb[c];
    const float aw0 = cw[256 + c], aw1 = cw[768 + 256 + c], aw2 = cw[1536 + 256 + c], ab = cb[256 + c];
    const float bw0 = cw[512 + c], bw1 = cw[768 + 512 + c], bw2 = cw[1536 + 512 + c], bb = cb[512 + c];
    const float inv = 1.0f / (float)FN;
    __syncthreads();
#pragma unroll 4
    for (int i = 0; i < 16; ++i) { const int t = tid + NTHR * i;
        D[t] = (f32x2){hy_conv3(rv, t, LX, vw0, vw1, vw2, vb), hy_conv3(rv + LX, t, LX, vw0, vw1, vw2, vb)}; D[t + LX] = (f32x2){0.f, 0.f}; }
    __syncthreads();
    fft_fwd(D, tw, tid); spec_mul(D, Hs + (size_t)(c * 2 + 0) * HSP, tid); fft_inv(D, tw, tid);
#pragma unroll 4
    for (int i = 0; i < 16; ++i) { const int t = tid + NTHR * i;
        const f32x2 cv = D[t];
        const float g0 = hy_conv3(r1, t, LX, aw0, aw1, aw2, ab), g1 = hy_conv3(r1 + LX, t, LX, aw0, aw1, aw2, ab);
        D[t] = (f32x2){g0 * cv.x * inv, g1 * cv.y * inv}; D[t + LX] = (f32x2){0.f, 0.f}; }
    __syncthreads();
    fft_fwd(D, tw, tid); spec_mul(D, Hs + (size_t)(c * 2 + 1) * HSP, tid); fft_inv(D, tw, tid);
#pragma unroll 4
    for (int i = 0; i < 16; ++i) { const int t = tid + NTHR * i;
        const f32x2 cv = D[t];
        const float g0 = hy_conv3(r2, t, LX, bw0, bw1, bw2, bb), g1 = hy_conv3(r2 + LX, t, LX, bw0, bw1, bw2, bb);
        hyoT[(size_t)c * MXR + t] = (bf16)f2bf(g0 * cv.x * inv);
        hyoT[(size_t)c * MXR + LX + t] = (bf16)f2bf(g1 * cv.y * inv); }
    __syncthreads();
}

__device__ __forceinline__ void hy_ctx_item(LAS unsigned char* lds, const bf16* uhyT, const float* cw, const float* cb, const float* hbias, const float* h2c  , const float* w3l, bf16* mix, int c, int tid, int wave, int lane) {
    LAS float* F = (LAS float*)lds;
    LAS float* Y = F + 1024;
    LAS f32x4* W3 = (LAS f32x4*)(F + 1536);
    LAS float* red = F + 1536 + 256;
    __syncthreads();
    if (tid < 64) { const float* wr = w3l + (size_t)tid * 1024 + c; W3[tid] = (f32x4){wr[0], wr[256], wr[512], wr[768]}; }
    __syncthreads();
    const float delta = fabsf(-3.0701134573253946f + (float)c * ((-15.350567286626973f + 3.0701134573253946f) / 255.0f));
    float s0 = 0.f, s1 = 0.f;
    if (tid < 256) {
        const f32x4* hr = (const f32x4*)(h2c + (size_t)tid * 64);
        float a0 = 0.f, a1 = 0.f, a2 = 0.f, a3 = 0.f;
#pragma unroll 4
        for (int j4 = 0; j4 < 16; ++j4) { const f32x4 hv = hr[j4];
            const f32x4 wa = W3[4 * j4 + 0], wb = W3[4 * j4 + 1], wc = W3[4 * j4 + 2], wd = W3[4 * j4 + 3];
            a0 += wa.x * hv.x + wb.x * hv.y + wc.x * hv.z + wd.x * hv.w; a1 += wa.y * hv.x + wb.y * hv.y + wc.y * hv.z + wd.y * hv.w;
            a2 += wa.z * hv.x + wb.z * hv.y + wc.z * hv.z + wd.z * hv.w; a3 += wa.w * hv.x + wb.w * hv.y + wc.w * hv.z + wd.w * hv.w; }
        f32x4 acc = (f32x4){a0, a1, a2, a3};
        acc *= expf(-((float)tid / 255.0f) * delta);
        F[tid] = acc.x; F[256 + tid] = acc.y; F[512 + tid] = acc.z; F[768 + tid] = acc.w;
        s0 = fabsf(acc.x) + (tid >= 1 ? fabsf(acc.z) : 0.f); s1 = fabsf(acc.y) + (tid >= 1 ? fabsf(acc.w) : 0.f);
    }
    block_sum2(s0, s1, red, wave, lane);
    const float n0 = 1.0f / s0, n1 = 1.0f / s1;
    const int b = tid >> 8, t = tid & 255;
    const bf16* rv = uhyT + (size_t)c * MROWS + MXR + b * LC; const bf16* r1 = uhyT + (size_t)(256 + c) * MROWS + MXR + b * LC; const bf16* r2 = uhyT + (size_t)(512 + c) * MROWS + MXR + b * LC;
    const float v = hy_conv3(rv, t, LC, cw[c], cw[768 + c], cw[1536 + c], cb[c]);
    const float g1 = hy_conv3(r1, t, LC, cw[256 + c], cw[768 + 256 + c], cw[1536 + 256 + c], cb[256 + c]);
    const float g2 = hy_conv3(r2, t, LC, cw[512 + c], cw[768 + 512 + c], cw[1536 + 512 + c], cb[512 + c]);
    Y[b * 256 + t] = v;
    __syncthreads();
    float acc = 0.f;
    for (int s = 0; s < 256; ++s) { const float f = s <= t ? F[t - s] : F[512 + s - t]; acc += Y[b * 256 + s] * f; }
    const float y1 = g1 * (acc * n0 + v * hbias[c]);
    __syncthreads();
    Y[b * 256 + t] = y1;
    __syncthreads();
    acc = 0.f;
    for (int s = 0; s < 256; ++s) { const float f = s <= t ? F[256 + t - s] : F[768 + s - t]; acc += Y[b * 256 + s] * f; }
    const float o = g2 * (acc * n1 + y1 * hbias[256 + c]);
    mix[(size_t)(MXR + b * LC + t) * DM + 256 + c] = (bf16)f2bf(o);
    __syncthreads();
}
struct SsdArgs {
    const bf16* ussd; const float* udt; const float* cw; const float* cb; const float* dtb; const float* alog; const float* dvec;
    float* sst; float* dts; bf16* mix; float* ssq;
};
constexpr int SX_P = 66, SB_P = 130;
template <int MODE>
__device__ __forceinline__ void ssd_item(LAS unsigned char* lds, const SsdArgs& A, int b, int sc, int h, int dir, int tid, int wave, int lane) {
    LAS float* Xs = (LAS float*)lds;
    LAS float* Bm = Xs + 64 * SX_P;
    LAS float* Cm = Bm + 64 * SB_P;
    LAS float* Mt = Cm + 64 * SB_P;
    LAS f32x4* RB = (LAS f32x4*)(Mt + 64 * SX_P);
    LAS float* dtv = (LAS float*)(RB + 1024);
    LAS float* acs = dtv + 64, *wv = dtv + 128, *eacs = dtv + 192, *misc = dtv + 256;
    LAS float* SQ = dtv + 272;
    const int g = h >> 2;
    const int row0 = sc == 32 ? MXR + b * LC : b * LX, len = sc == 32 ? LC : LX, tok0 = sc == 32 ? 0 : sc * 256;
    const int pt = wave & 3, half = wave >> 2, l15 = lane & 15, l4 = lane >> 4;
    float* slot = A.sst + ((size_t)(((b * 2 + dir) * 33 + sc) * 8 + h)) * 8192;
    f32x4 ST[4];
#pragma unroll
    for (int nt = 0; nt < 4; ++nt) {
        if (MODE == 0 || sc == 32) ST[nt] = (f32x4){0.f, 0.f, 0.f, 0.f};
        else ST[nt] = *(const f32x4*)(slot + (size_t)(16 * pt + l15) * 128 + 16 * (4 * half + nt) + 4 * l4);
    }
    const float a_h = -__expf(A.alog[dir * 8 + h]), dtb_h = A.dtb[dir * 8 + h], d_h = A.dvec[h];
    float sum_aend = 0.f;
    __syncthreads();
#pragma unroll 1
    for (int i = 0; i < 4; ++i) {
        constexpr int NCG = (MODE == 0) ? 24 : 40, NIT = NCG * 64 / NTHR;
#pragma unroll 1
        for (int it = 0; it < NIT; ++it) {
            const int id = it * NTHR + tid, tau = id / NCG, cg = id % NCG;
            const int s = 64 * i + tau, t = dir ? tok0 + 255 - s : tok0 + s;
            const int xcol = cg < 8 ? h * 64 + 8 * cg : (cg < 24 ? 512 + g * 128 + 8 * (cg - 8) : 768 + g * 128 + 8 * (cg - 24));
            const bf16* up = A.ussd + (size_t)(row0 + t) * 1536 + 512 + xcol;
            const u32x4 u0 = *(const u32x4*)up;
            u32x4 um = (u32x4){0u, 0u, 0u, 0u}, un = (u32x4){0u, 0u, 0u, 0u};
            if (t > 0) um = *(const u32x4*)(up - 1536);
            if (t < len - 1) un = *(const u32x4*)(up + 1536);
            const float* wp = A.cw + xcol;
            const f32x4 wa0 = *(const f32x4*)wp, wa1 = *(const f32x4*)(wp + 4), wb0 = *(const f32x4*)(wp + 1024), wb1 = *(const f32x4*)(wp + 1028), wc0 = *(const f32x4*)(wp + 2048), wc1 = *(const f32x4*)(wp + 2052);
            const f32x4 bb0 = *(const f32x4*)(A.cb + xcol), bb1 = *(const f32x4*)(A.cb + xcol + 4);
            float o[8];
            o[0] = wa0.x * bflo(um.x) + wb0.x * bflo(u0.x) + wc0.x * bflo(un.x) + bb0.x; o[1] = wa0.y * bfhi(um.x) + wb0.y * bfhi(u0.x) + wc0.y * bfhi(un.x) + bb0.y;
            o[2] = wa0.z * bflo(um.y) + wb0.z * bflo(u0.y) + wc0.z * bflo(un.y) + bb0.z; o[3] = wa0.w * bfhi(um.y) + wb0.w * bfhi(u0.y) + wc0.w * bfhi(un.y) + bb0.w;
            o[4] = wa1.x * bflo(um.z) + wb1.x * bflo(u0.z) + wc1.x * bflo(un.z) + bb1.x; o[5] = wa1.y * bfhi(um.z) + wb1.y * bfhi(u0.z) + wc1.y * bfhi(un.z) + bb1.y;
            o[6] = wa1.z * bflo(um.w) + wb1.z * bflo(u0.w) + wc1.z * bflo(un.w) + bb1.z; o[7] = wa1.w * bfhi(um.w) + wb1.w * bfhi(u0.w) + wc1.w * bfhi(un.w) + bb1.w;
#pragma unroll
            for (int j = 0; j < 8; ++j) o[j] = siluf(o[j]);
            LAS float* dst = cg < 8 ? Xs + tau * SX_P + 8 * cg : (cg < 24 ? Bm + tau * SB_P + 8 * (cg - 8) : Cm + tau * SB_P + 8 * (cg - 24));
            *(LAS f32x2*)(dst) = (f32x2){o[0], o[1]}; *(LAS f32x2*)(dst + 2) = (f32x2){o[2], o[3]}; *(LAS f32x2*)(dst + 4) = (f32x2){o[4], o[5]}; *(LAS f32x2*)(dst + 6) = (f32x2){o[6], o[7]};
        }
        if (wave == 0) {
            const int s = 64 * i + lane, t = dir ? tok0 + 255 - s : tok0 + s;
            const float raw = A.udt[(size_t)(row0 + t) * 16 + dir * 8 + h] + dtb_h;
            const float dt = raw > 20.f ? raw : log1pf(__expf(raw));
            float x = dt * a_h;
#pragma unroll
            for (int off = 1; off < 64; off <<= 1) { const float y = __shfl_up(x, off); if (lane >= off) x += y; }
            const float aend = __shfl(x, 63);
            dtv[lane] = dt; acs[lane] = x; wv[lane] = dt * __expf(aend - x); eacs[lane] = __expf(x);
            if (lane == 0) misc[0] = __expf(aend);
            sum_aend += aend;
        }
        __syncthreads();
        if (MODE != 0) {
            const int tt = wave >> 1;
#pragma unroll
            for (int j = 0; j < 2; ++j) {
                const int st = 2 * (wave & 1) + j;
                f32x4 acc = (f32x4){0.f, 0.f, 0.f, 0.f};
                if (st <= tt) {
                    const LAS float* pa = Cm + (16 * tt + l15) * SB_P + l4; const LAS float* pb = Bm + (16 * st + l15) * SB_P + l4;
#pragma unroll 8
                    for (int kk = 0; kk < 32; ++kk) acc = MFMA4(pa[4 * kk], pb[4 * kk], acc);
                }
                const int sI = 16 * st + l15; const float as = acs[sI], ds = dtv[sI];
#pragma unroll
                for (int r = 0; r < 4; ++r) { const int tI = 16 * tt + 4 * l4 + r;
                    Mt[tI * SX_P + sI] = (st <= tt && sI <= tI) ? acc[r] * __expf(acs[tI] - as) * ds : 0.f; }
            }
            __syncthreads();
            f32x4 yacc[4];
#pragma unroll
            for (int tt2 = 0; tt2 < 4; ++tt2) {
                f32x4 acc = (f32x4){0.f, 0.f, 0.f, 0.f};
                const int tI = 16 * tt2 + l15; const float et = eacs[tI];
#pragma unroll
                for (int nt = 0; nt < 4; ++nt) {
                    const LAS float* pc = Cm + tI * SB_P + 16 * (4 * half + nt) + 4 * l4;
#pragma unroll
                    for (int r = 0; r < 4; ++r) acc = MFMA4(pc[r] * et, ST[nt][r], acc);
                }
#pragma unroll
                for (int j = 0; j < 2; ++j) { const int st = 2 * half + j;
                    if (st <= tt2) {
                        const LAS float* pa = Mt + tI * SX_P + 16 * st + l4; const LAS float* pb = Xs + (16 * st + l4) * SX_P + 16 * pt + l15;
#pragma unroll
                        for (int kk = 0; kk < 4; ++kk) acc = MFMA4(pa[4 * kk], pb[4 * kk * SX_P], acc);
                    } }
                yacc[tt2] = acc;
            }
            if (half == 1) {
#pragma unroll
                for (int tt2 = 0; tt2 < 4; ++tt2) RB[(pt * 4 + tt2) * 64 + lane] = yacc[tt2];
            }
            __syncthreads();
            if (half == 0) {
#pragma unroll
                for (int tt2 = 0; tt2 < 4; ++tt2) {
                    const f32x4 yv = yacc[tt2] + RB[(pt * 4 + tt2) * 64 + lane];
                    float q = 0.f;
#pragma unroll
                    for (int r = 0; r < 4; ++r) {
                        const int tI = 16 * tt2 + 4 * l4 + r, p = 16 * pt + l15;
                        const int s = 64 * i + tI, t = dir ? tok0 + 255 - s : tok0 + s;
                        bf16* mp = A.mix + (size_t)(row0 + t) * DM + 512 + h * 64 + p;
                        if (MODE == 1) *mp = (bf16)f2bf(yv[r]);
                        else {
                            float v = yv[r] + bf2f(*mp) + d_h * Xs[tI * SX_P + p];
                            const float z = bf2f(A.ussd[(size_t)(row0 + t) * 1536 + h * 64 + p]);
                            v *= siluf(z);
                            *mp = (bf16)f2bf(v);
                            float qq = v * v;
                            qq += __shfl_xor(qq, 1); qq += __shfl_xor(qq, 2); qq += __shfl_xor(qq, 4); qq += __shfl_xor(qq, 8);
                            if (l15 == 0) SQ[pt * 64 + tI] = qq;
                        }
                    }
                    (void)q;
                }
            }
        }
        {
            const float ea = misc[0];
#pragma unroll
            for (int nt = 0; nt < 4; ++nt) {
                f32x4 acc = ST[nt] * ea;
                const LAS float* pa = Bm + l4 * SB_P + 16 * (4 * half + nt) + l15; const LAS float* pb = Xs + l4 * SX_P + 16 * pt + l15; const LAS float* pw = wv + l4;
#pragma unroll 8
                for (int kk = 0; kk < 16; ++kk) acc = MFMA4(pa[4 * kk * SB_P], pb[4 * kk * SX_P] * pw[4 * kk], acc);
                ST[nt] = acc;
            }
        }
        __syncthreads();
        if (MODE == 2 && tid < 64) {
            const int s = 64 * i + tid, t = dir ? tok0 + 255 - s : tok0 + s;
            A.ssq[(size_t)(row0 + t) * 8 + h] = SQ[tid] + SQ[64 + tid] + SQ[128 + tid] + SQ[192 + tid];
        }
    }
    if (MODE == 0) {
#pragma unroll
        for (int nt = 0; nt < 4; ++nt) *(f32x4*)(slot + (size_t)(16 * pt + l15) * 128 + 16 * (4 * half + nt) + 4 * l4) = ST[nt];
        if (tid == 0) A.dts[((b * 2 + dir) * 33 + sc) * 8 + h] = __expf(sum_aend);
    }
    __syncthreads();
}

struct HgArgs {
    const bf16* uhg; const float* lb0; const float* lb1; const float* normg; int layer;
    float* hst; float* dth; bf16* mix;
};
constexpr int HP = 66, PP = 34, HG_LDS_FLOATS = 5 * 32 * HP + 32 * PP + 256 + 64 + 128 + 32 + 64;
template <int MODE>
__device__ __forceinline__ void hg_item(LAS unsigned char* lds, const HgArgs& A, int b, int sc, int hp, int dir, int tid, int lane) {
    const int hgp = tid >> 8, tg = tid & 255, hw = (tid >> 6) & 3, h = 2 * hp + hgp;
    LAS float* base = (LAS float*)lds + hgp * HG_LDS_FLOATS;
    LAS float* Qt = base, *Kt = Qt + 32 * HP, *Qh = Kt + 32 * HP, *Kh = Qh + 32 * HP, *Vt = Kh + 32 * HP, *Pm = Vt + 32 * HP;
    LAS float* tot = Pm + 32 * PP;
    LAS float* ebend = tot + 256;
    LAS float* SQ = ebend + 64;
    LAS float* rstd = SQ + 128;
    const int row0 = sc == 32 ? MXR + b * LC : b * LX, tok0 = sc == 32 ? 0 : sc * 256;
    const int l15 = lane & 15, l4 = lane >> 4, vt = hw;
    float* slot = A.hst + ((size_t)(((b * 2 + dir) * 33 + sc) * 4 + h)) * 4096;
    f32x4 S[4];
#pragma unroll
    for (int kt = 0; kt < 4; ++kt) {
        if (MODE == 0 || sc == 32) S[kt] = (f32x4){0.f, 0.f, 0.f, 0.f};
        else S[kt] = *(const f32x4*)(slot + (size_t)(16 * vt + l15) * 64 + 16 * kt + 4 * l4);
    }
    const int tau = tg >> 3, kg = tg & 7;
    float lbv[8], sumb[8];
#pragma unroll
    for (int j = 0; j < 8; ++j) { const int k = h * 64 + 8 * kg + j; lbv[j] = A.layer == 0 ? 0.f : sigmf(A.lb1[k] - A.lb0[k]); sumb[j] = 0.f; }
    __syncthreads();
#pragma unroll 1
    for (int i = 0; i < 8; ++i) {
        const int s = 32 * i + tau, t = dir ? tok0 + 255 - s : tok0 + s;
        const bf16* up = A.uhg + (size_t)(row0 + t) * 1280 + h * 64 + 8 * kg;
        const u32x4 qv = *(const u32x4*)up, fv = *(const u32x4*)(up + 256 + dir * 256), vv = *(const u32x4*)(up + 768);
        float q[8], f[8], v[8], kk[8], bb[8];
        q[0] = bflo(qv.x); q[1] = bfhi(qv.x); q[2] = bflo(qv.y); q[3] = bfhi(qv.y); q[4] = bflo(qv.z); q[5] = bfhi(qv.z); q[6] = bflo(qv.w); q[7] = bfhi(qv.w);
        f[0] = bflo(fv.x); f[1] = bfhi(fv.x); f[2] = bflo(fv.y); f[3] = bfhi(fv.y); f[4] = bflo(fv.z); f[5] = bfhi(fv.z); f[6] = bflo(fv.w); f[7] = bfhi(fv.w);
        v[0] = bflo(vv.x); v[1] = bfhi(vv.x); v[2] = bflo(vv.y); v[3] = bfhi(vv.y); v[4] = bflo(vv.z); v[5] = bfhi(vv.z); v[6] = bflo(vv.w); v[7] = bfhi(vv.w);
#pragma unroll
        for (int j = 0; j < 8; ++j) {
            const float sg = sigmf(f[j]);
            const float fj = lbv[j] + (1.0f - lbv[j]) * sg;
            kk[j] = (1.0f - lbv[j]) * (1.0f - sg);
            float x = lbv[j] == 0.f ? fminf(f[j], 0.f) - log1pf(__expf(-fabsf(f[j]))) : __logf(fj);
#pragma unroll
            for (int off = 8; off < 64; off <<= 1) { const float y = __shfl_up(x, off); if (lane >= off) x += y; }
            bb[j] = x;
        }
        if (lane >= 56) {
#pragma unroll
            for (int j = 0; j < 8; ++j) tot[hw * 64 + 8 * kg + j] = bb[j];
        }
        __syncthreads();
#pragma unroll
        for (int j = 0; j < 8; ++j) {
            const int k = 8 * kg + j;
            const float t0 = tot[k], t1 = tot[64 + k], t2 = tot[128 + k], t3 = tot[192 + k];
            const float off = hw == 0 ? 0.f : (hw == 1 ? t0 : (hw == 2 ? t0 + t1 : t0 + t1 + t2));
            const float bj = bb[j] + off, bmid = t0 + t1, bend = (t0 + t1) + (t2 + t3);
            if (MODE != 0) {
                Qt[tau * HP + k] = q[j] * 0.125f * __expf(bj - bmid); Kt[tau * HP + k] = kk[j] * __expf(bmid - bj); Qh[tau * HP + k] = q[j] * 0.125f * __expf(bj);
            }
            Kh[tau * HP + k] = kk[j] * __expf(bend - bj); Vt[tau * HP + k] = v[j];
            if (tau == 0) { ebend[k] = __expf(bend); sumb[j] += bend; }
        }
        __syncthreads();
        if (MODE != 0) {
            {
                const int tt = hw >> 1, st = hw & 1;
                f32x4 acc = (f32x4){0.f, 0.f, 0.f, 0.f};
                if (st <= tt) {
                    const LAS float* pa = Qt + (16 * tt + l15) * HP + l4; const LAS float* pb = Kt + (16 * st + l15) * HP + l4;
#pragma unroll
                    for (int k4 = 0; k4 < 16; ++k4) acc = MFMA4(pa[4 * k4], pb[4 * k4], acc);
                }
#pragma unroll
                for (int r = 0; r < 4; ++r) { const int tI = 16 * tt + 4 * l4 + r, sI = 16 * st + l15; Pm[tI * PP + sI] = (st <= tt && sI <= tI) ? acc[r] : 0.f; }
            }
            __syncthreads();
            f32x4 oacc[2];
#pragma unroll
            for (int tt = 0; tt < 2; ++tt) {
                f32x4 acc = (f32x4){0.f, 0.f, 0.f, 0.f};
                const LAS float* pa = Pm + (16 * tt + l15) * PP + l4; const LAS float* pb = Vt + l4 * HP + 16 * vt + l15;
#pragma unroll
                for (int k4 = 0; k4 < 8; ++k4) if (k4 < 4 * (tt + 1)) acc = MFMA4(pa[4 * k4], pb[4 * k4 * HP], acc);
                const LAS float* pq = Qh + (16 * tt + l15) * HP + 4 * l4;
#pragma unroll
                for (int kt = 0; kt < 4; ++kt)
#pragma unroll
                    for (int r = 0; r < 4; ++r) acc = MFMA4(pq[16 * kt + r], S[kt][r], acc);
                oacc[tt] = acc;
            }
            if (MODE == 1) {
#pragma unroll
                for (int tt = 0; tt < 2; ++tt)
#pragma unroll
                    for (int r = 0; r < 4; ++r) { const int tI = 16 * tt + 4 * l4 + r, s2 = 32 * i + tI, t2 = dir ? tok0 + 255 - s2 : tok0 + s2;
                        A.mix[(size_t)(row0 + t2) * DM + h * 64 + 16 * vt + l15] = (bf16)f2bf(oacc[tt][r]); }
            } else {
#pragma unroll
                for (int tt = 0; tt < 2; ++tt)
#pragma unroll
                    for (int r = 0; r < 4; ++r) { const int tI = 16 * tt + 4 * l4 + r, s2 = 32 * i + tI, t2 = dir ? tok0 + 255 - s2 : tok0 + s2;
                        const float o = oacc[tt][r] + bf2f(A.mix[(size_t)(row0 + t2) * DM + h * 64 + 16 * vt + l15]);
                        oacc[tt][r] = o;
                        float qq = o * o; qq += __shfl_xor(qq, 1); qq += __shfl_xor(qq, 2); qq += __shfl_xor(qq, 4); qq += __shfl_xor(qq, 8);
                        if (l15 == 0) SQ[vt * 32 + tI] = qq; }
                __syncthreads();
                if (tg < 32) rstd[tg] = 1.0f / sqrtf((SQ[tg] + SQ[32 + tg] + SQ[64 + tg] + SQ[96 + tg]) * (1.0f / 64.0f) + EPS);
                __syncthreads();
                const float ng = A.normg[h * 64 + 16 * vt + l15];
#pragma unroll
                for (int tt = 0; tt < 2; ++tt)
#pragma unroll
                    for (int r = 0; r < 4; ++r) { const int tI = 16 * tt + 4 * l4 + r, s2 = 32 * i + tI, t2 = dir ? tok0 + 255 - s2 : tok0 + s2;
                        const float gz = bf2f(A.uhg[(size_t)(row0 + t2) * 1280 + 1024 + h * 64 + 16 * vt + l15]);
                        A.mix[(size_t)(row0 + t2) * DM + h * 64 + 16 * vt + l15] = (bf16)f2bf(oacc[tt][r] * rstd[tI] * ng * siluf(gz)); }
            }
        }
#pragma unroll
        for (int kt = 0; kt < 4; ++kt) {
            f32x4 acc;
#pragma unroll
            for (int r = 0; r < 4; ++r) acc[r] = S[kt][r] * ebend[16 * kt + 4 * l4 + r];
            const LAS float* pa = Kh + l4 * HP + 16 * kt + l15; const LAS float* pb = Vt + l4 * HP + 16 * vt + l15;
#pragma unroll
            for (int k4 = 0; k4 < 8; ++k4) acc = MFMA4(pa[4 * k4 * HP], pb[4 * k4 * HP], acc);
            S[kt] = acc;
        }
        __syncthreads();
    }
    if (MODE == 0) {
#pragma unroll
        for (int kt = 0; kt < 4; ++kt) *(f32x4*)(slot + (size_t)(16 * vt + l15) * 64 + 16 * kt + 4 * l4) = S[kt];
        if (tau == 0) {
#pragma unroll
            for (int j = 0; j < 8; ++j) A.dth[((size_t)(((b * 2 + dir) * 33 + sc) * 4 + h)) * 64 + 8 * kg + j] = __expf(sumb[j]);
        }
    }
    __syncthreads();
}

__device__ __forceinline__ void state_scan(float* sst, const float* dts, float* hst, const float* dth, int gid) {
    if (gid < 65536) {
        const int bd = gid >> 14, e = gid & 16383, h = e >> 11, dir = bd & 1;
        float* base = sst + ((size_t)(bd * 33) * 8 + h) * 8192 + (size_t)(e & 2047) * 4;
        f32x4 carry = *(const f32x4*)(base + (size_t)32 * 8 * 8192);
        float* p = base + (size_t)(dir ? 31 : 0) * 8 * 8192; const long pstep = dir ? -(long)(8 * 8192) : (long)(8 * 8192);
        const float* dp = dts + (bd * 33 + (dir ? 31 : 0)) * 8 + h; const int dstep = dir ? -8 : 8;
#pragma unroll 4
        for (int jj = 0; jj < 32; ++jj) {
            const f32x4 loc = *(const f32x4*)p; *(f32x4*)p = carry;
            carry = carry * (*dp) + loc; p += pstep; dp += dstep; }
    } else if (gid < 65536 + 16384) {
        const int g2 = gid - 65536, bd = g2 >> 12, e = g2 & 4095, h = e >> 10, dir = bd & 1, k0 = (e & 15) * 4;
        float* base = hst + ((size_t)(bd * 33) * 4 + h) * 4096 + (size_t)(e & 1023) * 4;
        f32x4 carry = *(const f32x4*)(base + (size_t)32 * 4 * 4096);
        float* p = base + (size_t)(dir ? 31 : 0) * 4 * 4096; const long pstep = dir ? -(long)(4 * 4096) : (long)(4 * 4096);
        const float* dp = dth + ((size_t)((bd * 33 + (dir ? 31 : 0)) * 4 + h)) * 64 + k0; const int dstep = dir ? -256 : 256;
#pragma unroll 4
        for (int jj = 0; jj < 32; ++jj) {
            const f32x4 loc = *(const f32x4*)p; *(f32x4*)p = carry;
            const f32x4 d = *(const f32x4*)dp;
            carry = carry * d + loc; p += pstep; dp += dstep; }
    }
}

__device__ __forceinline__ void mf_hy_tile(LAS unsigned char* lds, const bf16* hyoT, bf16* mix, int tile, int tid) {
    LAS bf16* T = (LAS bf16*)lds;
    __syncthreads();
    { const int ch = tid >> 1, hf = tid & 1; const u32x4* src = (const u32x4*)(hyoT + (size_t)ch * MXR + tile * 64 + hf * 32);
#pragma unroll
      for (int j = 0; j < 4; ++j) *(LAS u32x4*)(T + ch * 72 + hf * 32 + 8 * j) = src[j]; }
    __syncthreads();
    { const int tok = tid >> 3, cgp = tid & 7;
      bf16* dst = mix + (size_t)(tile * 64 + tok) * DM + 256 + cgp * 32;
#pragma unroll
      for (int j = 0; j < 4; ++j) { u32x4 o;
          unsigned w[4];
#pragma unroll
          for (int e = 0; e < 4; ++e) { const int c0 = cgp * 32 + 8 * j + 2 * e; w[e] = (unsigned)T[c0 * 72 + tok] | ((unsigned)T[(c0 + 1) * 72 + tok] << 16); }
          o.x = w[0]; o.y = w[1]; o.z = w[2]; o.w = w[3];
          *(u32x4*)(dst + 8 * j) = o; } }
    __syncthreads();
}
__device__ __forceinline__ void mf_ssd_rows(bf16* mix, const float* ssq, const float* ng, int nrows, int gw, int ngw, int lane) {
    const f32x4 g0 = *(const f32x4*)(ng + 8 * lane), g1 = *(const f32x4*)(ng + 8 * lane + 4);
    const int grp = lane >> 5;
#pragma unroll 1
    for (int m = gw; m < nrows; m += ngw) {
        const f32x4 q = *(const f32x4*)(ssq + (size_t)m * 8 + 4 * grp);
        const float r = 1.0f / sqrtf(((q.x + q.y) + (q.z + q.w)) * (1.0f / 256.0f) + EPS);
        bf16* p = mix + (size_t)m * DM + 512 + 8 * lane;
        const u32x4 v = *(const u32x4*)p; u32x4 o;
        o.x = pk2(bflo(v.x) * r * g0.x, bfhi(v.x) * r * g0.y); o.y = pk2(bflo(v.y) * r * g0.z, bfhi(v.y) * r * g0.w);
        o.z = pk2(bflo(v.z) * r * g1.x, bfhi(v.z) * r * g1.y); o.w = pk2(bflo(v.w) * r * g1.z, bfhi(v.w) * r * g1.w);
        *(u32x4*)p = o;
    }
}
#ifndef MK_PER_PHASE
#define MK_PER_PHASE 0
#endif
constexpr int PH_PER_LAYER = 12, NPHASES = 1 + 2 * PH_PER_LAYER + 1;
struct Args { const float* in[34]; float* out; unsigned char* ws; int ph_lo, ph_hi; };

__global__ void __launch_bounds__(NTHR, 2) hybrid_fwd(Args args) {
    extern __shared__ __attribute__((aligned(16))) unsigned char lds_raw[];
    LAS unsigned char* lds = (LAS unsigned char*)lds_raw;
    volatile LAS unsigned* MISC = (volatile LAS unsigned*)(lds + MISC_OFF);
    const int tid0 = threadIdx.x;
    const int G = gridDim.x, bid = blockIdx.x;
    const int ngw = G * NWAVES, ngt = G * NTHR;
    unsigned char* ws = args.ws;
    for (int u = tid0; u < 32; u += NTHR) MISC[u] = 0u;
    __syncthreads();
    XcdBarrier bar; bar.bar = (unsigned*)(ws + WS_CTL) + CW_BAR; bar.x = 0; bar.st = nullptr;
    if (!MK_PER_PHASE) bar = xcd_barrier_post((unsigned*)(ws + WS_CTL) + CW_BAR, MISC + 8);
    const int lo = args.ph_lo, hi = args.ph_hi;
#ifndef PHMASK
#define PHMASK 0xFFFF
#endif
#define ENA(b) (((PHMASK) >> (b)) & 1)
#ifndef SUBMASK
#define SUBMASK 0xFF
#endif
#define SUB(b) (((SUBMASK) >> (b)) & 1)
#define IN(k) (lo <= (k) && (k) < hi)
#define SEAM(k) do { if (IN(k) && IN((k) + 1)) xcd_barrier(bar); } while (0)
#define FRESH_IDS() int tid_ = tid0; asm volatile("" : "+v"(tid_)); const int tid = tid_, lane = tid & 63, wave = __builtin_amdgcn_readfirstlane(tid >> 6); const int gw = bid * NWAVES + wave, gtid = bid * NTHR + tid; LAS float* wscr = (LAS float*)(lds + wave * 16384); (void)lane; (void)gw; (void)gtid; (void)wscr

    const float* x_in = args.in[0]; const float* c_in = args.in[1]; const float* ctx_in = args.in[2]; const float* cctx_in = args.in[3];
    const float* w_ada = args.in[4]; const float* b_ada = args.in[5]; const float* norm1_g = args.in[6]; const float* norm2_g = args.in[7];
    const float* w_in = args.in[8]; const float* w_out = args.in[9]; const float* hg_lb = args.in[10]; const float* hg_norm_g = args.in[11];
    const float* hy_conv_w = args.in[12]; const float* hy_conv_b = args.in[13]; const float* hy_w1 = args.in[14]; const float* hy_b1 = args.in[15]; const float* hy_f1 = args.in[16];
    const float* hy_w2 = args.in[17]; const float* hy_b2 = args.in[18]; const float* hy_f2 = args.in[19]; const float* hy_w3 = args.in[20]; const float* hy_bias = args.in[21];
    const float* ssd_conv_w = args.in[22]; const float* ssd_conv_b = args.in[23]; const float* ssd_dt_bias = args.in[24]; const float* ssd_a_log = args.in[25]; const float* ssd_d = args.in[26];
    const float* ssd_norm_g = args.in[27]; const float* ffn_w_gate = args.in[28]; const float* ffn_w_up = args.in[29]; const float* ffn_conv_w = args.in[30]; const float* ffn_conv_b = args.in[31];
    const float* ffn_w_down = args.in[32]; const float* final_norm_g = args.in[33];
    float* xs_out = args.out;
    float* mods = (float*)(ws + WS_MODS); f32x2* tw = (f32x2*)(ws + WS_TW); float* ctxs = (float*)(ws + WS_CTXS); float* h2 = (float*)(ws + WS_H2); float* h2c = (float*)(ws + WS_H2C);
    float* ssq = (float*)(ws + WS_SSQ); float* dts = (float*)(ws + WS_DTS); float* dth = (float*)(ws + WS_DTH); float* udt = (float*)(ws + WS_UDT);
    bf16* Win = (bf16*)(ws + WS_WIN); bf16* Wout = (bf16*)(ws + WS_WOUT); bf16* hn = (bf16*)(ws + WS_HN); f32x2* Hs = (f32x2*)(ws + WS_HN);
    bf16* uhg = (bf16*)(ws + WS_UHG); bf16* uhyT = (bf16*)(ws + WS_UHY); bf16* ussd = (bf16*)(ws + WS_USSD); float* sst = (float*)(ws + WS_SST); float* hst = (float*)(ws + WS_HST);
    bf16* mix = (bf16*)(ws + WS_MIX); bf16* hyoT = (bf16*)(ws + WS_HYO); bf16* fa = (bf16*)(ws + WS_A); bf16* fup = (bf16*)(ws + WS_UP); bf16* Wgu = (bf16*)(ws + WS_WGU); bf16* Wd = (bf16*)(ws + WS_WD);

    if (ENA(12) && IN(0)) {
        FRESH_IDS();
#pragma unroll 1
        for (int it = bid; it < 192; it += G) if (SUB(4)) p0_mods_item(c_in, cctx_in, w_ada, b_ada, mods, (LAS float*)lds, it, tid, wave, lane);
        if (SUB(5)) for (int k = gtid; k < FN; k += ngt) { float s, c; sincospif((float)k * (1.0f / 8192.0f), &s, &c); tw[k] = (f32x2){c, -s}; }
#pragma unroll 1
        for (int v = 0; v < 3; ++v) {
            const int hl = v == 1 ? 1 : 0;
            if (SUB(6)) p0_h2_rows(hy_w1 + hl * 33 * 64, hy_b1 + hl * 64, hy_f1 + hl * 64, hy_w2 + hl * 64 * 64, hy_b2 + hl * 64, hy_f2 + hl * 64, v == 2 ? h2c : h2 + (size_t)hl * LX * 64, v == 2 ? LC : LX, gw, ngw, lane);
        }
        __syncthreads();
        if (SUB(7)) { convert_weight(w_in, 1024, NINP, 3600, Win, wscr, gw, ngw, lane);
        convert_weight(w_out, 1024, 1024, 1024, Wout, wscr, gw, ngw, lane); }
    }
    SEAM(0);

    for (int l = 0; l < 2; ++l) {
        const int P = 1 + l * PH_PER_LAYER;
        const float* mods_l = mods + (size_t)l * 3 * 6144;
        const int nrows = l == 0 ? MROWS : MXR;
        if (ENA(0) && IN(P + 0)) {
            FRESH_IDS();
            if (l == 1) { __syncthreads();
                convert_weight(w_in + (size_t)1024 * 3600, 1024, NINP, 3600, Win, wscr, gw, ngw, lane);
                convert_weight(w_out + (size_t)1024 * 1024, 1024, 1024, 1024, Wout, wscr, gw, ngw, lane); }
            norm_rows(l == 0 ? x_in : xs_out, l == 0 ? ctx_in : ctxs, MROWS, norm1_g + l * DM, mods_l, 0, 1, hn, gw, ngw, lane);
        }
        SEAM(P + 0);
        if (ENA(1) && IN(P + 1)) {
            FRESH_IDS();
            pg8::Gemm g{hn, Win, MROWS, NINP, DM}; pg8::StaticOrder S; S.init(MROWS, NINP, G, bid);
            pg8::EpiInProj E{uhg, uhyT, ussd, udt, MROWS};
            pg8::gemm_phase<pg8::EpiInProj, pg8::StaticOrder, true, true>(lds, g, S, E);
        }
        SEAM(P + 1);
        SsdArgs SA{ussd, udt, ssd_conv_w + (size_t)l * 3 * 1024, ssd_conv_b + l * 1024, ssd_dt_bias + l * 16, ssd_a_log + l * 16, ssd_d + l * 8, sst, dts, mix, ssq};
        HgArgs HA{uhg, hg_lb, hg_lb + 256, hg_norm_g + l * 256, l, hst, dth, mix};
        const float* hcw = hy_conv_w + (size_t)l * 3 * 768; const float* hcb = hy_conv_b + l * 768; const float* hbias = hy_bias + l * 512; const float* w3l = hy_w3 + (size_t)l * 64 * 1024;
        if (ENA(2) && IN(P + 2)) {
            FRESH_IDS();
            const int n_spec = 256, n_ssd = 2 * 2 * 33 * 8, n_hg = 2 * 2 * 33 * 2, n_hyc = l == 0 ? 256 : 0, total = n_spec + n_ssd + n_hg + n_hyc;
            #pragma unroll 1
            for (int id = bid; id < total; id += G) {
                FRESH_IDS();
                if (id < n_spec) { if (SUB(0)) hy_spectrum_item(lds, h2 + (size_t)l * LX * 64, w3l, hbias, Hs, tw, id, tid, wave, lane); }
                else if (id < n_spec + n_ssd) { if (SUB(1)) { int r = id - n_spec; const int h = r & 7; r >>= 3; const int sc = r % 33; r /= 33; ssd_item<0>(lds, SA, r >> 1, sc, h, r & 1, tid, wave, lane); } }
                else if (id < n_spec + n_ssd + n_hg) { if (SUB(2)) { int r = id - n_spec - n_ssd; const int hp = r & 1; r >>= 1; const int sc = r % 33; r /= 33; hg_item<0>(lds, HA, r >> 1, sc, hp, r & 1, tid, lane); } }
                else if (SUB(3)) hy_ctx_item(lds, uhyT, hcw, hcb, hbias, h2c, w3l, mix, id - n_spec - n_ssd - n_hg, tid, wave, lane);
            }
        }
        SEAM(P + 2);
        if (ENA(3) && IN(P + 3)) {
            FRESH_IDS();
            state_scan(sst, dts, hst, dth, gtid);
            #pragma unroll 1
            for (int id = bid; id < 256; id += G) { FRESH_IDS(); hy_fft_item(lds, uhyT, hcw, hcb, Hs, tw, hyoT, id, tid); }
        }
        SEAM(P + 3);
        const int nsc = l == 0 ? 33 : 32;
        if (ENA(4) && IN(P + 4)) {
            FRESH_IDS();
            const int n_ssd = 2 * nsc * 8, n_hg = 2 * nsc * 2;
            #pragma unroll 1
            for (int id = bid; id < n_ssd + n_hg; id += G) {
                FRESH_IDS();
                if (id < n_ssd) { int r = id; const int h = r & 7; r >>= 3; ssd_item<1>(lds, SA, r / nsc, r % nsc, h, 0, tid, wave, lane); }
                else { int r = id - n_ssd; const int hp = r & 1; r >>= 1; hg_item<1>(lds, HA, r / nsc, r % nsc, hp, 0, tid, lane); }
            }
        }
        SEAM(P + 4);
        if (ENA(5) && IN(P + 5)) {
            FRESH_IDS();
            const int n_ssd = 2 * nsc * 8, n_hg = 2 * nsc * 2;
            #pragma unroll 1
            for (int id = bid; id < n_ssd + n_hg; id += G) {
                FRESH_IDS();
                if (id < n_ssd) { int r = id; const int h = r & 7; r >>= 3; ssd_item<2>(lds, SA, r / nsc, r % nsc, h, 1, tid, wave, lane); }
                else { int r = id - n_ssd; const int hp = r & 1; r >>= 1; hg_item<2>(lds, HA, r / nsc, r % nsc, hp, 1, tid, lane); }
            }
        }
        SEAM(P + 5);
        if (ENA(6) && IN(P + 6)) {
            FRESH_IDS();
            #pragma unroll 1
            for (int id = bid; id < 256; id += G) { FRESH_IDS(); mf_hy_tile(lds, hyoT, mix, id, tid); }
            mf_ssd_rows(mix, ssq, ssd_norm_g + l * 512, nrows, gw, ngw, lane);
        }
        SEAM(P + 6);
        if (ENA(7) && IN(P + 7)) {
            FRESH_IDS();
            pg8::Gemm g{mix, Wout, nrows, DM, DM}; pg8::StaticOrder S; S.init(nrows, DM, G, bid);
            pg8::EpiResid E{l == 0 ? x_in : xs_out, xs_out, ctxs, l == 0 ? ctx_in : ctxs, mods_l + 2 * 1024, 6144, mods_l + 2 * 6144 + 2 * 1024};
            pg8::gemm_phase<pg8::EpiResid, pg8::StaticOrder, true, true>(lds, g, S, E);
        }
        SEAM(P + 7);
        if (ENA(8) && IN(P + 8)) {
            FRESH_IDS();
            __syncthreads();
            convert_weight(ffn_w_gate + (size_t)l * 1024 * DFF, 1024, DFF, DFF, Wgu, wscr, gw, ngw, lane);
            convert_weight(ffn_w_up + (size_t)l * 1024 * DFF, 1024, DFF, DFF, Wgu + (size_t)DFF * 1024, wscr, gw, ngw, lane);
            convert_weight(ffn_w_down + (size_t)l * DFF * 1024, DFF, 1024, 1024, Wd, wscr, gw, ngw, lane);
            norm_rows(xs_out, ctxs, nrows, norm2_g + l * DM, mods_l, 3, 4, hn, gw, ngw, lane);
        }
        SEAM(P + 8);
        if (ENA(9) && IN(P + 9)) {
            FRESH_IDS();
            pg8::Gemm g{hn, Wgu, nrows, 2 * DFF, DM}; pg8::StaticOrder S; S.init(nrows, 2 * DFF, G, bid);
            pg8::EpiGateUp E{fa, fup};
            pg8::gemm_phase<pg8::EpiGateUp, pg8::StaticOrder, true, true>(lds, g, S, E);
        }
        SEAM(P + 9);
        if (ENA(10) && IN(P + 10)) { FRESH_IDS(); ffn_conv_phase(fa, fup, ffn_conv_w + (size_t)l * 9 * DFF, ffn_conv_b + l * DFF, nrows, gtid, ngt); }
        SEAM(P + 10);
        if (ENA(11) && IN(P + 11)) {
            FRESH_IDS();
            pg8::Gemm g{fup, Wd, nrows, DM, DFF}; pg8::StaticOrder S; S.init(nrows, DM, G, bid);
            pg8::EpiResid E{xs_out, xs_out, ctxs, ctxs, mods_l + 5 * 1024, 6144, mods_l + 2 * 6144 + 5 * 1024};
            pg8::gemm_phase<pg8::EpiResid, pg8::StaticOrder, true, true>(lds, g, S, E);
        }
        SEAM(P + 11);
    }
    if (ENA(13) && IN(NPHASES - 1)) { FRESH_IDS(); final_norm_rows(xs_out, final_norm_g, gw, ngw, lane); }
#undef IN
#undef SEAM
}

extern "C" void kernel_launch(void* const* d_in, const int* in_sizes, int n_in, void* d_out, int out_size, void* d_ws, size_t ws_size, hipStream_t stream) {
    static int grid = 0;
    if (grid == 0) {
        if (n_in != 34 || out_size != MXR * DM || ws_size < WS_END) { fprintf(stderr, "kernel_launch: unexpected shapes (n_in %d out %d ws %zu)\n", n_in, out_size, ws_size); grid = -1; return; }
        int dev = 0, cus = 0, per_cu = 0;
        if (hipGetDevice(&dev) != hipSuccess || hipDeviceGetAttribute(&cus, hipDeviceAttributeMultiprocessorCount, dev) != hipSuccess) { grid = -1; return; }
        if (hipFuncSetAttribute((const void*)hybrid_fwd, hipFuncAttributeMaxDynamicSharedMemorySize, LDS_BYTES) != hipSuccess) { fprintf(stderr, "kernel_launch: hipFuncSetAttribute failed\n"); grid = -1; return; }
        if (hipOccupancyMaxActiveBlocksPerMultiprocessor(&per_cu, (const void*)hybrid_fwd, NTHR, LDS_BYTES) != hipSuccess || per_cu < 1)
            fprintf(stderr, "kernel_launch: note: occupancy query reports %d workgroups per CU\n", per_cu);
        (void)hipGetLastError();
        grid = cus;
    }
    if (grid < 0) return;
    if (hipMemsetAsync((char*)d_ws + WS_CTL, 0, CTL_ZERO_BYTES, stream) != hipSuccess) { fprintf(stderr, "kernel_launch: memset failed\n"); return; }
    Args a{};
    for (int i = 0; i < 34; ++i) a.in[i] = (const float*)d_in[i];
    a.out = (float*)d_out; a.ws = (unsigned char*)d_ws;
#if MK_PER_PHASE
    for (int p = 0; p < NPHASES; ++p) { a.ph_lo = p; a.ph_hi = p + 1; hipLaunchKernelGGL(hybrid_fwd, dim3(grid), dim3(NTHR), LDS_BYTES, stream, a); }
#else
    a.ph_lo = 0; a.ph_hi = NPHASES;
    hipLaunchKernelGGL(hybrid_fwd, dim3(grid), dim3(NTHR), LDS_BYTES, stream, a);
#endif
    const hipError_t le = hipPeekAtLastError();
    if (le != hipSuccess) fprintf(stderr, "kernel_launch: launch failed: %s\n", hipGetErrorName(le));
}
```

```cpp
#include <hip/hip_runtime.h>
#include <cstdio>
#include <cstdint>
namespace pg8 {
#define PG8_LAS __attribute__((address_space(3)))
typedef unsigned short bf16_t;
typedef short bf16x8 __attribute__((ext_vector_type(8)));
typedef float f32x4 __attribute__((ext_vector_type(4)));
typedef unsigned u32x4 __attribute__((ext_vector_type(4)));
constexpr int BM = 256, BK = 64, HALF = 128, HTB = HALF * BK * 2  , STAGE_BYTES = 8 * HTB, NXCD = 8, WGM = 8;

__host__ __device__ __forceinline__ int lds_byte(int r, int c) { const int st = (r >> 4) * 2 + (c >> 5), rr = r & 15, cc = c & 31, ob = rr * 64 + cc * 2; return st * 1024 + (ob ^ (((ob >> 9) & 1) << 5)); }
__host__ __device__ __forceinline__ void stage_rc(int b, int& R, int& C) { const int st = b / 1024, sb = b % 1024, swz = sb ^ (((sb >> 9) & 1) << 5); R = (st >> 1) * 16 + swz / 64; C = (st & 1) * 32 + (swz % 64) / 2; }
__host__ __device__ __forceinline__ int perm32(int rho) { const int n = rho >> 4, i = rho & 15; return 8 * (i >> 2) + 4 * n + (i & 3); }

struct Unit { int pm, pn, koff, ks; };
struct Gemm { const bf16_t* A; const bf16_t* Bt; int M, N, K, ld; };

struct StaticOrder {
    int nM, nN, nwg, G, c;
    __host__ __device__ void init(int M, int N, int G_, int c_) { nM = M / BM; nN = N / BM; nwg = nM * nN; G = G_; c = c_; }
    __host__ __device__ bool next(int i, Unit& u) const {
        const long L = (long)i * G + c; if (L >= nwg) return false;
        int wgid = (int)L; { const int q = nwg / NXCD, r = nwg % NXCD, xcd = wgid % NXCD, off = wgid / NXCD; wgid = (xcd < r ? xcd * (q + 1) : r * (q + 1) + (xcd - r) * q) + off; }
        const int nig = WGM * nN, gid = wgid / nig, fm = gid * WGM, gsz = (nM - fm) < WGM ? (nM - fm) : WGM;
        u.pm = fm + ((wgid % nig) % gsz); u.pn = (wgid % nig) / gsz; u.koff = 0; u.ks = 0; return true;
    }
    __device__ __forceinline__ void a_ready(const Unit&) const {}
    __device__ __forceinline__ void done(const Unit&) const {}
};

__device__ __forceinline__ unsigned cvt_pk_bf16(float lo, float hi) { unsigned r; asm volatile("v_cvt_pk_bf16_f32 %0, %1, %2" : "=v"(r) : "v"(lo), "v"(hi)); return r; }
typedef float f32x2 __attribute__((ext_vector_type(2)));

struct EpiInProj {
    static constexpr bool PERM = true, AFTER_DRAIN = false;
    bf16_t* uhg; bf16_t* uhyT; bf16_t* uz; long off_xs, off_bc; float* udt; int mrows;
    __device__ __forceinline__ void operator()(const f32x4 (&acc)[2][2][4][2], const Unit& u, int wr, int wc, int fr, int fq) const {
        const int row0 = u.pm * BM + wr * 64 + fr;
        const int colt = u.pn * BM + wc * 32 + 8 * fq;
#pragma unroll
        for (int ai = 0; ai < 2; ++ai)
#pragma unroll
            for (int m = 0; m < 4; ++m) {
                const int r = row0 + ai * HALF + m * 16;
#pragma unroll
                for (int bj = 0; bj < 2; ++bj) {
                    const f32x4 v0 = acc[ai][bj][m][0], v1 = acc[ai][bj][m][1];
                    const int c = colt + bj * HALF;
                    if (u.pn < 5) {
                        u32x4 w; w.x = cvt_pk_bf16(v0[0], v0[1]); w.y = cvt_pk_bf16(v0[2], v0[3]); w.z = cvt_pk_bf16(v1[0], v1[1]); w.w = cvt_pk_bf16(v1[2], v1[3]);
                        *(u32x4*)(uhg + (size_t)r * 1280 + c) = w;
                    } else if (u.pn < 8) {
                        const int cc = c - 1280;
                        const unsigned w0 = cvt_pk_bf16(v0[0], v0[1]), w1 = cvt_pk_bf16(v0[2], v0[3]), w2 = cvt_pk_bf16(v1[0], v1[1]), w3 = cvt_pk_bf16(v1[2], v1[3]);
                        bf16_t* d = uhyT + (size_t)cc * mrows + r;
                        d[0] = (bf16_t)(w0 & 0xffffu); d[(size_t)mrows] = (bf16_t)(w0 >> 16); d[(size_t)2 * mrows] = (bf16_t)(w1 & 0xffffu); d[(size_t)3 * mrows] = (bf16_t)(w1 >> 16);
                        d[(size_t)4 * mrows] = (bf16_t)(w2 & 0xffffu); d[(size_t)5 * mrows] = (bf16_t)(w2 >> 16); d[(size_t)6 * mrows] = (bf16_t)(w3 & 0xffffu); d[(size_t)7 * mrows] = (bf16_t)(w3 >> 16);
                    } else {
                        const int cc = c - 2048;
                        if (cc < 1536) {
                            u32x4 w; w.x = cvt_pk_bf16(v0[0], v0[1]); w.y = cvt_pk_bf16(v0[2], v0[3]); w.z = cvt_pk_bf16(v1[0], v1[1]); w.w = cvt_pk_bf16(v1[2], v1[3]);
                            bf16_t* dst = uz + (u.pn >= 10 ? off_xs : 0) + (u.pn >= 12 ? off_bc - off_xs : 0);
                            *(u32x4*)(dst + (size_t)r * 512 + (cc & 511)) = w;
                        } else if (cc < 1552) {
                            float* d = udt + (size_t)r * 16 + (cc - 1536);
                            *(f32x4*)d = v0; *(f32x4*)(d + 4) = v1;
                        }
                    }
                }
            }
    }
};
struct EpiGateUp {
    static constexpr bool PERM = true, AFTER_DRAIN = false;
    bf16_t* a; bf16_t* up;
    __device__ __forceinline__ void operator()(const f32x4 (&acc)[2][2][4][2], const Unit& u, int wr, int wc, int fr, int fq) const {
        const int row0 = u.pm * BM + wr * 64 + fr;
        int colt = u.pn * BM; bf16_t* base = a; if (u.pn >= 11) { base = up; colt -= 2816; }
        colt += wc * 32 + 8 * fq;
#pragma unroll
        for (int ai = 0; ai < 2; ++ai)
#pragma unroll
            for (int m = 0; m < 4; ++m) { bf16_t* rowp = base + (size_t)(row0 + ai * HALF + m * 16) * 2816 + colt;
#pragma unroll
                for (int bj = 0; bj < 2; ++bj) { const f32x4 v0 = acc[ai][bj][m][0], v1 = acc[ai][bj][m][1];
                    u32x4 w; w.x = cvt_pk_bf16(v0[0], v0[1]); w.y = cvt_pk_bf16(v0[2], v0[3]); w.z = cvt_pk_bf16(v1[0], v1[1]); w.w = cvt_pk_bf16(v1[2], v1[3]);
                    *(u32x4*)(rowp + bj * HALF) = w; } }
    }
};
struct EpiResid {
    static constexpr bool PERM = false, AFTER_DRAIN = false;
    const float* xbase; float* xout; float* cstream; const float* cbase; const float* gate_x; int gate_bstride; const float* gate_c;
    __device__ __forceinline__ void operator()(const f32x4 (&acc)[2][2][4][2], const Unit& u, int wr, int wc, int fr, int fq) const {
        const int row0 = u.pm * BM + wr * 64 + fr;
        const int col0 = u.pn * BM + wc * 32 + 4 * fq;
        const bool isctx = u.pm >= 64;
#pragma unroll
        for (int bj = 0; bj < 2; ++bj)
#pragma unroll
            for (int n = 0; n < 2; ++n) {
                const int c = col0 + bj * HALF + n * 16;
#pragma unroll
                for (int ai = 0; ai < 2; ++ai)
#pragma unroll
                    for (int m = 0; m < 4; ++m) {
                        const int r = row0 + ai * HALF + m * 16;
                        if (!isctx) {
                            const f32x4 g = *(const f32x4*)(gate_x + (size_t)(r >> 13) * gate_bstride + c);
                            const f32x4 b = *(const f32x4*)(xbase + (size_t)r * 1024 + c);
                            *(f32x4*)(xout + (size_t)r * 1024 + c) = b + g * acc[ai][bj][m][n];
                        } else {
                            const f32x4 g = *(const f32x4*)(gate_c + c);
                            const f32x4 b = *(const f32x4*)(cbase + (size_t)(r - 16384) * 1024 + c);
                            *(f32x4*)(cstream + (size_t)(r - 16384) * 1024 + c) = b + g * acc[ai][bj][m][n];
                        }
                    }
            }
    }
};
struct CtxOrder {
    int c;
    __host__ __device__ bool next(int i, Unit& u) const { if (i != 0 || c >= 8) return false; u.pm = 64 + (c >> 2); u.pn = c & 3; u.koff = 0; u.ks = 0; return true; }
    __device__ __forceinline__ void a_ready(const Unit&) const {}
    __device__ __forceinline__ void done(const Unit&) const {}
};
struct SplitOrder {
    int c, nsplit, kc;
    __host__ __device__ bool next(int i, Unit& u) const { if (i != 0 || c >= 8 * nsplit) return false; const int t = c / nsplit; u.pm = 64 + (t >> 2); u.pn = t & 3; u.ks = c % nsplit; u.koff = u.ks * kc * 2; return true; }
    __device__ __forceinline__ void a_ready(const Unit&) const {}
    __device__ __forceinline__ void done(const Unit&) const {}
};
struct EpiSlab {
    static constexpr bool PERM = false, AFTER_DRAIN = false;
    float* slab; int nsplit;
    __device__ __forceinline__ void operator()(const f32x4 (&acc)[2][2][4][2], const Unit& u, int wr, int wc, int fr, int fq) const {
        float* base = slab + (size_t)((((u.pm - 64) * 4 + u.pn) * nsplit + u.ks)) * 65536;
        const int row0 = wr * 64 + fr, col0 = wc * 32 + 4 * fq;
#pragma unroll
        for (int bj = 0; bj < 2; ++bj)
#pragma unroll
            for (int n = 0; n < 2; ++n)
#pragma unroll
                for (int ai = 0; ai < 2; ++ai)
#pragma unroll
                    for (int m = 0; m < 4; ++m) *(f32x4*)(base + (size_t)(row0 + ai * HALF + m * 16) * 256 + col0 + bj * HALF + n * 16) = acc[ai][bj][m][n];
    }
};
template <class Epi, class Sched, bool ALIGN_EPI = false, bool SP2 = false>
__device__ __forceinline__ void gemm_phase(PG8_LAS unsigned char* lds, const Gemm g, const Sched& S, const Epi& E, const int tid) {
    const int wid = __builtin_amdgcn_readfirstlane(tid >> 6), lane = tid & 63, wr = wid >> 2, wc = wid & 3, fr = lane & 15, fq = lane >> 4;
    const int K = g.K, nt = K / BK, ld = g.ld;
    unsigned voffA[2], voffB[2];
#pragma unroll
    for (int i = 0; i < 2; ++i) { int R, C; stage_rc(tid * 16 + i * 8192, R, C); const int Rb = Epi::PERM ? ((R & ~31) + perm32(R & 31)) : R;
        voffA[i] = (unsigned)(R * ld + C) * 2u; voffB[i] = (unsigned)(Rb * ld + C) * 2u; }
    const size_t kstep = (size_t)(BK * 2);
    const size_t hstep = (size_t)HALF * ld * 2;
    const size_t tstep = 2 * hstep;
    const unsigned ldsw = (unsigned)wid * 1024u;
    const int aoff = lds_byte(wr * 64 + fr, fq * 8), boff = lds_byte(wc * 32 + fr, fq * 8);
#define PG8_SA(b, h) (((b) * 2 + (h)) * HTB)
#define PG8_SB(b, h) ((4 + (b) * 2 + (h)) * HTB)
#define PG8_STAGE(bufoff, gbase, voff) do { _Pragma("unroll") for (int _i = 0; _i < 2; ++_i) \
        __builtin_amdgcn_global_load_lds((const unsigned*)((const char*)(gbase) + (voff)[_i]), (PG8_LAS unsigned*)(lds + (bufoff) + ldsw + _i * 8192), 16, 0, 0); } while (0)
#define PG8_LDA(dst, b, h) do { _Pragma("unroll") for (int m = 0; m < 4; ++m) _Pragma("unroll") for (int k = 0; k < 2; ++k) dst[m][k] = *(const PG8_LAS bf16x8*)(lds + PG8_SA(b, h) + aoff + m * 2048 + k * 1024); } while (0)
#define PG8_LDB(dst, b, h) do { _Pragma("unroll") for (int n = 0; n < 2; ++n) _Pragma("unroll") for (int k = 0; k < 2; ++k) dst[n][k] = *(const PG8_LAS bf16x8*)(lds + PG8_SB(b, h) + boff + n * 2048 + k * 1024); } while (0)
#define PG8_MMA(ai, bj, At, Bt) do { __builtin_amdgcn_s_setprio(1); _Pragma("unroll") for (int m = 0; m < 4; ++m) _Pragma("unroll") for (int n = 0; n < 2; ++n) _Pragma("unroll") for (int k = 0; k < 2; ++k) \
        acc[ai][bj][m][n] = __builtin_amdgcn_mfma_f32_16x16x32_bf16(Bt[n][k], At[m][k], acc[ai][bj][m][n], 0, 0, 0); __builtin_amdgcn_s_setprio(0); } while (0)
#define PG8_WAIT_V(n) asm volatile("s_waitcnt vmcnt(" #n ")" ::: "memory")
#define PG8_WAIT_L(n) asm volatile("s_waitcnt lgkmcnt(" #n ")" ::: "memory")
#define PG8_BAR __builtin_amdgcn_s_barrier()
#define PG8_SCHED __builtin_amdgcn_sched_barrier(0)
    Unit cur, nxt; int ui = 0;
    if (!S.next(0, cur)) return;
    f32x4 acc[2][2][4][2];
#pragma unroll
    for (int a = 0; a < 2; ++a)
#pragma unroll
        for (int b = 0; b < 2; ++b)
#pragma unroll
            for (int m = 0; m < 4; ++m)
#pragma unroll
                for (int n = 0; n < 2; ++n) acc[a][b][m][n] = (f32x4){0.f, 0.f, 0.f, 0.f};
    bf16x8 At[4][2], B0[2][2], B1[2][2];
    const char* cA = (const char*)g.A + (size_t)cur.pm * tstep + cur.koff; const char* cB = (const char*)g.Bt + (size_t)cur.pn * tstep + cur.koff;
    S.a_ready(cur);
    if constexpr (SP2) {
        PG8_STAGE(PG8_SB(0, 0), cB, voffB); PG8_STAGE(PG8_SB(0, 1), cB + hstep, voffB); PG8_STAGE(PG8_SA(0, 0), cA, voffA); PG8_STAGE(PG8_SA(0, 1), cA + hstep, voffA);
        if (wr == 1) PG8_BAR;
        PG8_WAIT_V(2); PG8_BAR;
        PG8_STAGE(PG8_SB(1, 0), cB + kstep, voffB); PG8_STAGE(PG8_SA(1, 0), cA + kstep, voffA); PG8_STAGE(PG8_SB(1, 1), cB + hstep + kstep, voffB);
        PG8_WAIT_V(6); PG8_BAR;
    } else {
        PG8_STAGE(PG8_SB(0, 0), cB, voffB); PG8_STAGE(PG8_SA(0, 0), cA, voffA); PG8_STAGE(PG8_SB(0, 1), cB + hstep, voffB); PG8_STAGE(PG8_SA(0, 1), cA + hstep, voffA);
        if (wr == 1) PG8_BAR;
        PG8_WAIT_V(4); PG8_BAR;
        PG8_STAGE(PG8_SB(1, 0), cB + kstep, voffB); PG8_STAGE(PG8_SA(1, 0), cA + kstep, voffA); PG8_STAGE(PG8_SB(1, 1), cB + hstep + kstep, voffB);
        PG8_WAIT_V(6); PG8_BAR;
    }
    for (;;) {
        const bool has_next = S.next(ui + 1, nxt);
        const char* nA = has_next ? (const char*)g.A + (size_t)nxt.pm * tstep + nxt.koff : cA; const char* nB = has_next ? (const char*)g.Bt + (size_t)nxt.pn * tstep + nxt.koff : cB;
        for (int t = 0; t < nt; t += 2) {
            const bool last = (t == nt - 2);
            const char* a1 = cA + (size_t)(t + 1) * kstep;
            const char* a2 = last ? nA : cA + (size_t)(t + 2) * kstep; const char* b2 = last ? nB : cB + (size_t)(t + 2) * kstep;
            const char* a3 = a2 + kstep; const char* b3 = b2 + kstep;
            if (last && has_next) S.a_ready(nxt);
            if constexpr (SP2) {
            PG8_LDB(B0, 0, 0); PG8_LDB(B1, 0, 1); PG8_SCHED; PG8_LDA(At, 0, 0); PG8_STAGE(PG8_SA(1, 1), a1 + hstep, voffA);
            PG8_WAIT_V(8); PG8_WAIT_L(0); PG8_BAR; PG8_MMA(0, 0, At, B0); PG8_MMA(0, 1, At, B1); PG8_BAR; PG8_SCHED;
            PG8_LDA(At, 0, 1); PG8_STAGE(PG8_SB(0, 0), b2, voffB); PG8_STAGE(PG8_SB(0, 1), b2 + hstep, voffB); PG8_STAGE(PG8_SA(0, 0), a2, voffA);
            PG8_WAIT_V(8); PG8_WAIT_L(0); PG8_BAR; PG8_MMA(1, 0, At, B0); PG8_MMA(1, 1, At, B1); PG8_BAR; PG8_SCHED;
            PG8_LDB(B0, 1, 0); PG8_LDB(B1, 1, 1); PG8_SCHED; PG8_LDA(At, 1, 0); PG8_STAGE(PG8_SA(0, 1), a2 + hstep, voffA);
            PG8_WAIT_V(8); PG8_WAIT_L(0); PG8_BAR; PG8_MMA(0, 0, At, B0); PG8_MMA(0, 1, At, B1); PG8_BAR; PG8_SCHED;
            PG8_LDA(At, 1, 1); PG8_STAGE(PG8_SB(1, 0), b3, voffB); PG8_STAGE(PG8_SB(1, 1), b3 + hstep, voffB); PG8_STAGE(PG8_SA(1, 0), a3, voffA);
            PG8_WAIT_V(8); PG8_WAIT_L(0); PG8_BAR; PG8_MMA(1, 0, At, B0); PG8_MMA(1, 1, At, B1); PG8_BAR; PG8_SCHED;
            } else {
            PG8_LDB(B0, 0, 0); PG8_SCHED; PG8_LDA(At, 0, 0); PG8_STAGE(PG8_SA(1, 1), a1 + hstep, voffA);
            PG8_WAIT_L(8); PG8_BAR; PG8_WAIT_L(0); PG8_MMA(0, 0, At, B0); PG8_BAR; PG8_SCHED;
            PG8_LDB(B1, 0, 1); PG8_STAGE(PG8_SB(0, 0), b2, voffB);
            PG8_BAR; PG8_WAIT_L(0); PG8_MMA(0, 1, At, B1); PG8_BAR;
            PG8_LDA(At, 0, 1); PG8_STAGE(PG8_SA(0, 0), a2, voffA);
            PG8_BAR; PG8_WAIT_L(0); PG8_MMA(1, 0, At, B0); PG8_BAR; PG8_SCHED;
            PG8_STAGE(PG8_SB(0, 1), b2 + hstep, voffB);
            PG8_WAIT_V(6); PG8_BAR; PG8_MMA(1, 1, At, B1); PG8_BAR;
            PG8_LDB(B0, 1, 0); PG8_SCHED; PG8_LDA(At, 1, 0); PG8_STAGE(PG8_SA(0, 1), a2 + hstep, voffA);
            PG8_WAIT_L(8); PG8_BAR; PG8_WAIT_L(0); PG8_MMA(0, 0, At, B0); PG8_BAR; PG8_SCHED;
            PG8_LDB(B1, 1, 1); PG8_STAGE(PG8_SB(1, 0), b3, voffB);
            PG8_BAR; PG8_WAIT_L(0); PG8_MMA(0, 1, At, B1); PG8_BAR;
            PG8_LDA(At, 1, 1); PG8_STAGE(PG8_SA(1, 0), a3, voffA);
            PG8_BAR; PG8_WAIT_L(0); PG8_MMA(1, 0, At, B0); PG8_BAR; PG8_SCHED;
            PG8_STAGE(PG8_SB(1, 1), b3 + hstep, voffB);
            PG8_WAIT_V(6); PG8_BAR; PG8_MMA(1, 1, At, B1); PG8_BAR;
            }
        }
        if constexpr (ALIGN_EPI) { if (wr == 0) PG8_BAR; }
        if constexpr (!Epi::AFTER_DRAIN) { E(acc, cur, wr, wc, fr, fq); S.done(cur); }
        if (!has_next) break;
#pragma unroll
        for (int a = 0; a < 2; ++a)
#pragma unroll
            for (int b = 0; b < 2; ++b)
#pragma unroll
                for (int m = 0; m < 4; ++m)
#pragma unroll
                    for (int n = 0; n < 2; ++n) acc[a][b][m][n] = (f32x4){0.f, 0.f, 0.f, 0.f};
        cur = nxt; cA = nA; cB = nB; ++ui;
        if constexpr (ALIGN_EPI) { if (wr == 1) PG8_BAR; }
    }
    PG8_WAIT_V(0);
    if constexpr (!ALIGN_EPI) { if (wr == 0) PG8_BAR; }
    PG8_BAR;
    if constexpr (Epi::AFTER_DRAIN) { E.fused(acc, cur, wr, wc, fr, fq, lds, wid, lane); S.done(cur); }
#undef PG8_SA
#undef PG8_SB
#undef PG8_STAGE
#undef PG8_LDA
#undef PG8_LDB
#undef PG8_MMA
#undef PG8_WAIT_V
#undef PG8_WAIT_L
#undef PG8_BAR
#undef PG8_SCHED
}
}
#define GAS __attribute__((address_space(1)))
#define LAS __attribute__((address_space(3)))
typedef unsigned short bf16;
typedef unsigned v4u __attribute__((ext_vector_type(4)));
typedef float f32x4 __attribute__((ext_vector_type(4)));
typedef short bf16x8 __attribute__((ext_vector_type(8)));
typedef GAS unsigned gu32;
typedef GAS unsigned long long gu64;
#define RLX_AGENT __ATOMIC_RELAXED, __HIP_MEMORY_SCOPE_AGENT
#define LDS_WAIT() asm volatile("s_waitcnt lgkmcnt(0)" ::: "memory")
#define VM_WAIT() asm volatile("s_waitcnt vmcnt(0)" ::: "memory")
__device__ __forceinline__ unsigned long long rt() { return __builtin_amdgcn_s_memrealtime(); }
__device__ __forceinline__ unsigned f2bf(float f) { unsigned u = __builtin_bit_cast(unsigned, f); return (u + 0x7fffu + ((u >> 16) & 1u)) >> 16; }
__device__ __forceinline__ unsigned pk2(float lo, float hi) { return f2bf(lo) | (f2bf(hi) << 16); }

#define XB_TMO      128
#define XB_XCNT(j)  (256  + 64 * (j))
#define XB_XSUB(j)  (1280 + 64 * (j))
#define XB_XGEN(j)  (2304 + 64 * (j))
#define XB_TOP      3328
#define XB_TOPGEN   3392
#define XCD_BAR_WORDS 3456
#define XB_SPIN_CAP (1u << 18)

__device__ __forceinline__ unsigned xb_ld(unsigned* p)              { return __hip_atomic_load(p, __ATOMIC_RELAXED, __HIP_MEMORY_SCOPE_AGENT); }
__device__ __forceinline__ unsigned xb_add(unsigned* p, unsigned v) { return __hip_atomic_fetch_add(p, v, __ATOMIC_RELAXED, __HIP_MEMORY_SCOPE_AGENT); }
__device__ __forceinline__ unsigned xb_xcc_id() { return (unsigned)__builtin_amdgcn_s_getreg((3 << 11) | 20) & 0xFu; }
#define XB_SPIN(cond, bar) do { unsigned _sp = 0; while (cond) { __builtin_amdgcn_s_sleep(1); \
    if ((++_sp & 255u) == 0u) { if (xb_ld(&(bar)[XB_TMO])) break; if (_sp > XB_SPIN_CAP) { atomicAdd(&(bar)[XB_TMO], 1u); break; } } } } while (0)

struct XcdBarrier {
    unsigned* bar; unsigned x;
    volatile LAS unsigned* st;
};

__device__ __forceinline__ XcdBarrier xcd_barrier_post(unsigned* bar, volatile LAS unsigned* st) {
    XcdBarrier b; b.bar = bar; b.x = xb_xcc_id(); b.st = st;
    if (threadIdx.x == 0) (void)xb_add(&bar[XB_XCNT(b.x)], 1u);
    return b;
}
__device__ __forceinline__ void xcd_barrier_complete(unsigned* bar, unsigned x, unsigned& nloc, unsigned& nx) {
    const unsigned G = gridDim.x * gridDim.y * gridDim.z;
    unsigned sum, cnt, mine, sp = 0u;
    for (;;) {
        sum = 0u; cnt = 0u; mine = 0u;
#pragma unroll
        for (unsigned j = 0; j < 16; ++j) { const unsigned c = xb_ld(&bar[XB_XCNT(j)]); sum += c; cnt += (c > 0u) ? 1u : 0u; mine = (j == x) ? c : mine; }
        if (sum == G) break;
        __builtin_amdgcn_s_sleep(1);
        if ((++sp & 255u) == 0u) { if (xb_ld(&bar[XB_TMO])) break; if (sp > XB_SPIN_CAP) { atomicAdd(&bar[XB_TMO], 1u); break; } }
    }
    nloc = mine > 0u ? mine : 1u; nx = cnt > 0u ? cnt : 1u;
}

__device__ __forceinline__ void xcd_barrier(const XcdBarrier& b) {
    asm volatile("s_waitcnt vmcnt(0)" ::: "memory");
    __syncthreads();
    if (threadIdx.x == 0) {
        unsigned* bar = b.bar;
        __builtin_amdgcn_s_waitcnt(0);
        unsigned nloc = b.st[0], nx = b.st[1];
        if (nloc == 0u) { xcd_barrier_complete(bar, b.x, nloc, nx); b.st[0] = nloc; b.st[1] = nx; }
        const unsigned old = xb_add(&bar[XB_XSUB(b.x)], 1u);
        const unsigned gen = old / nloc;
        if (old + 1u == (gen + 1u) * nloc) {
            __builtin_amdgcn_fence(__ATOMIC_RELEASE, "agent");
            asm volatile("s_waitcnt vmcnt(0)" ::: "memory");
            const unsigned og = xb_add(&bar[XB_TOP], 1u);
            const unsigned tg = og / nx;
            if (og + 1u == (tg + 1u) * nx) xb_add(&bar[XB_TOPGEN], 1u);
            else XB_SPIN(xb_ld(&bar[XB_TOPGEN]) == tg, bar);
            __builtin_amdgcn_fence(__ATOMIC_ACQUIRE, "agent");
            xb_add(&bar[XB_XGEN(b.x)], 1u);
            asm volatile("s_waitcnt vmcnt(0)" ::: "memory");
        } else {
            XB_SPIN(xb_ld(&bar[XB_XGEN(b.x)]) == gen, bar);
            __builtin_amdgcn_fence(__ATOMIC_ACQUIRE, "agent");
            asm volatile("s_waitcnt vmcnt(0)" ::: "memory");
        }
    }
    __syncthreads();
}
constexpr int NWAVES = 8, NTHR = 512;
constexpr int LX = 8192, LC = 256, DM = 1024, MXR = 16384, MROWS = 16896, NINP = 3840, DFF = 2816;
constexpr float EPS = 1e-6f;
constexpr size_t MiB = 1u << 20, KiB = 1u << 10;
constexpr size_t WS_CTL = 0, CTL_ZERO_BYTES = 64 * KiB;
constexpr size_t WS_MODS = 1 * MiB;
constexpr size_t WS_TW = 1 * MiB + 512 * KiB;
constexpr size_t WS_CTXS = 2 * MiB;
constexpr size_t WS_H2 = 4 * MiB;
constexpr size_t WS_H2C = 8 * MiB;
constexpr size_t WS_SSQ = 8 * MiB + 64 * KiB;
constexpr size_t WS_DTS = 8 * MiB + 640 * KiB;
constexpr size_t WS_DTH = 8 * MiB + 704 * KiB;
constexpr size_t WS_UDT = 9 * MiB;
constexpr size_t WS_WIN = 11 * MiB;
constexpr size_t WS_WOUT = 18 * MiB + 512 * KiB;
constexpr size_t WS_HN = 21 * MiB;
constexpr size_t WS_UHG = 54 * MiB;
constexpr size_t WS_UHY = 96 * MiB;
constexpr size_t WS_UZ = 121 * MiB;
constexpr size_t WS_UXS = 138 * MiB;
constexpr size_t WS_UBC = 154 * MiB + 512 * KiB;
constexpr size_t WS_SST = 138 * MiB;
constexpr size_t WS_AXT = 171 * MiB;
constexpr size_t WS_ABC = 187 * MiB + 512 * KiB;
constexpr size_t WS_ABT = 204 * MiB;
constexpr size_t WS_HST = 213 * MiB;
constexpr size_t WS_MIX = 222 * MiB;
constexpr size_t WS_A = 54 * MiB;
constexpr size_t WS_UP = 145 * MiB;
constexpr size_t WS_WGU = 236 * MiB;
constexpr size_t WS_WD = 247 * MiB;
constexpr size_t WS_END = 256 * MiB;
constexpr int HSP = 8200;
constexpr int CW_BAR = 1024;
constexpr int RING_BYTES = 131072, SCR_OFF = 131072, LDS_BYTES = 147456, MISC_OFF = LDS_BYTES - 128;

typedef float f32x2 __attribute__((ext_vector_type(2)));
typedef unsigned u32x2 __attribute__((ext_vector_type(2)));
typedef unsigned u32x4 __attribute__((ext_vector_type(4)));
#define MFMA4(a, b, c) __builtin_amdgcn_mfma_f32_16x16x4f32((a), (b), (c), 0, 0, 0)

__device__ __forceinline__ float bflo(unsigned w) { return __builtin_bit_cast(float, w << 16); }
__device__ __forceinline__ float bfhi(unsigned w) { return __builtin_bit_cast(float, w & 0xffff0000u); }
__device__ __forceinline__ float bf2f(bf16 h) { return __builtin_bit_cast(float, (unsigned)h << 16); }
__device__ __forceinline__ float siluf(float x) { return x / (1.0f + __expf(-x)); }
__device__ __forceinline__ float sigmf(float x) { return 1.0f / (1.0f + __expf(-x)); }
__device__ __forceinline__ u32x4 pack8(const float (&o)[8]) { u32x4 u; u.x = pk2(o[0], o[1]); u.y = pk2(o[2], o[3]); u.z = pk2(o[4], o[5]); u.w = pk2(o[6], o[7]); return u; }
__device__ __forceinline__ float wave_sum(float v) {
#pragma unroll
    for (int o = 1; o < 64; o <<= 1) v += __shfl_xor(v, o);
    return v;
}
__device__ __forceinline__ void block_sum2(float& a, float& b, LAS float* red, int wave, int lane) {
    a = wave_sum(a); b = wave_sum(b);
    __syncthreads();
    if (lane == 0) { red[wave] = a; red[8 + wave] = b; }
    __syncthreads();
    float sa = 0.f, sb = 0.f;
#pragma unroll
    for (int w = 0; w < 8; ++w) { sa += red[w]; sb += red[8 + w]; }
    a = sa; b = sb;
    __syncthreads();
}

__device__ __forceinline__ void p0_mods_item(const float* c, const float* cctx, const float* w_ada, const float* b_ada, float* mods, LAS float* sm, int item, int tid, int wave, int lane) {
    for (int k = tid; k < 1024; k += NTHR) { sm[k] = siluf(c[k]); sm[1024 + k] = siluf(c[1024 + k]); sm[2048 + k] = siluf(cctx[k]); }
    __syncthreads();
    const int l = item / 96, n0 = (item % 96) * 64;
    const float* W = w_ada + (size_t)l * 1024 * 6144 + n0 + lane;
    float a0 = 0.f, a1 = 0.f, a2 = 0.f;
#pragma unroll 32
    for (int kk = 0; kk < 128; ++kk) { const int k = wave * 128 + kk; const float w = W[(size_t)k * 6144]; a0 += sm[k] * w; a1 += sm[1024 + k] * w; a2 += sm[2048 + k] * w; }
    LAS float* red = sm + 3072;
    red[(wave * 3 + 0) * 64 + lane] = a0; red[(wave * 3 + 1) * 64 + lane] = a1; red[(wave * 3 + 2) * 64 + lane] = a2;
    __syncthreads();
    if (tid < 192) { const int v = tid >> 6, ln = tid & 63; float s = 0.f;
#pragma unroll
        for (int w = 0; w < 8; ++w) s += red[(w * 3 + v) * 64 + ln];
        mods[(size_t)(l * 3 + v) * 6144 + n0 + ln] = s + b_ada[(size_t)l * 6144 + n0 + ln]; }
    __syncthreads();
}
__device__ __forceinline__ void p0_h2_rows(const float* w1, const float* b1, const float* f1, const float* w2, const float* b2, const float* f2, float* out, bf16* outb, int slen, int first, int step, int lane) {
    float w1c[33], w2c[64];
#pragma unroll
    for (int i = 0; i < 33; ++i) w1c[i] = w1[i * 64 + lane];
#pragma unroll
    for (int i = 0; i < 64; ++i) w2c[i] = w2[i * 64 + lane];
    const float bb1 = b1[lane], ff1 = f1[lane], bb2 = b2[lane], ff2 = f2[lane];
#pragma unroll 1
    for (int t = first; t < slen; t += step) {
        const float tl = (float)t / (float)(slen - 1);
        const float w = (6.283185307179586f * (float)t) / (float)slen;
        float z = 0.f;
        if (lane == 0) z = tl;
        else if (lane <= 16) { const float band = 1e-4f + (float)(lane - 1) * ((15.0f - 1e-4f) / 15.0f); z = __cosf(band * w); }
        else if (lane <= 32) { const float band = 1e-4f + (float)(lane - 17) * ((15.0f - 1e-4f) / 15.0f); z = -__sinf(band * w); }
        float pre = bb1;
#pragma unroll
        for (int i = 0; i < 33; ++i) pre += __builtin_bit_cast(float, __builtin_amdgcn_readlane(__builtin_bit_cast(int, z), i)) * w1c[i];
        const float h1 = __sinf(ff1 * pre);
        float pre2 = bb2;
#pragma unroll
        for (int i = 0; i < 64; ++i) pre2 += __builtin_bit_cast(float, __builtin_amdgcn_readlane(__builtin_bit_cast(int, h1), i)) * w2c[i];
        const float hv = __sinf(ff2 * pre2);
        if (outb) outb[(size_t)t * 64 + lane] = (bf16)f2bf(hv); else out[(size_t)t * 64 + lane] = hv;
    }
}
__device__ __forceinline__ void transpose_item(const float* W, int K, int N, int Nvalid, bf16* WT, LAS float* scr, int item, int lane) {
    const int nblk = N / 32, kb = item / nblk, nb = item % nblk, k0 = 64 * kb, n0 = 32 * nb;
    const int n4 = (lane & 7) * 4, nn = n0 + n4;
    f32x4 ld[8];
#pragma unroll
    for (int i = 0; i < 8; ++i) { const int kk = 8 * i + (lane >> 3); ld[i] = nn < Nvalid ? *(const f32x4*)(W + (size_t)(k0 + kk) * Nvalid + nn) : (f32x4){0.f, 0.f, 0.f, 0.f}; }
#pragma unroll
    for (int i = 0; i < 8; ++i) { const int kk = 8 * i + (lane >> 3); LAS float* d = scr + kk * 33 + n4; d[0] = ld[i].x; d[1] = ld[i].y; d[2] = ld[i].z; d[3] = ld[i].w; }
    LDS_WAIT(); asm volatile("" ::: "memory");
    const int c = lane & 7;
#pragma unroll
    for (int j = 0; j < 4; ++j) { const int n = (lane >> 3) + 8 * j; const LAS float* s = scr + (8 * c) * 33 + n;
        v4u o; o.x = pk2(s[0 * 33], s[1 * 33]); o.y = pk2(s[2 * 33], s[3 * 33]); o.z = pk2(s[4 * 33], s[5 * 33]); o.w = pk2(s[6 * 33], s[7 * 33]);
        *(GAS v4u*)(WT + (size_t)(n0 + n) * K + k0 + 8 * c) = o; }
    LDS_WAIT(); asm volatile("" ::: "memory");
}
__device__ __forceinline__ void convert_weight(const float* W, int K, int N, int Nvalid, bf16* WT, LAS float* scr, int gw, int ngw, int lane) {
    const int nitems = (K / 64) * (N / 32);
#pragma unroll 1
    for (int it = gw; it < nitems; it += ngw) transpose_item(W, K, N, Nvalid, WT, scr, it, lane);
}

__device__ __forceinline__ void norm_rows(const float* xsrc, const float* csrc, int nrows, const float* g, const float* mods_l, int kshift, int kscale, bf16* hn, int gw, int ngw, int lane,
                                          const float* pend = nullptr, int pnsplit = 0, const float* pgate = nullptr, float* cdst = nullptr) {
    f32x4 gv[4];
#pragma unroll
    for (int j = 0; j < 4; ++j) gv[j] = *(const f32x4*)(g + 4 * lane + 256 * j);
    f32x4 x[4];
    if (gw < nrows) { const float* src = gw < MXR ? xsrc + (size_t)gw * DM : csrc + (size_t)(gw - MXR) * DM;
#pragma unroll
        for (int j = 0; j < 4; ++j) x[j] = *(const f32x4*)(src + 4 * lane + 256 * j); }
#pragma unroll 1
    for (int m = gw; m < nrows; m += ngw) {
        const int v = m < MXR ? (m >> 13) : 2;
        const float* sh = mods_l + (size_t)v * 6144 + kshift * 1024; const float* sc = mods_l + (size_t)v * 6144 + kscale * 1024;
        float ss = 0.f;
        f32x4 xn[4];
        { const int mn = m + ngw; if (mn < nrows) { const float* srcn = mn < MXR ? xsrc + (size_t)mn * DM : csrc + (size_t)(mn - MXR) * DM;
#pragma unroll
            for (int j = 0; j < 4; ++j) xn[j] = *(const f32x4*)(srcn + 4 * lane + 256 * j); } }
        if (pend && m >= MXR) {
            const int rl = m - MXR;
#pragma unroll
            for (int j = 0; j < 4; ++j) {
                const float* sp = pend + (size_t)(((rl >> 8) * 4 + j) * pnsplit) * 65536 + (size_t)(rl & 255) * 256 + 4 * lane;
                f32x4 sum = (f32x4){0.f, 0.f, 0.f, 0.f};
                for (int ks = 0; ks < pnsplit; ++ks) sum += *(const f32x4*)(sp + (size_t)ks * 65536);
                x[j] += *(const f32x4*)(pgate + 4 * lane + 256 * j) * sum;
                *(f32x4*)(cdst + (size_t)rl * DM + 4 * lane + 256 * j) = x[j];
            }
        }
#pragma unroll
        for (int j = 0; j < 4; ++j) ss += (x[j].x * x[j].x + x[j].y * x[j].y) + (x[j].z * x[j].z + x[j].w * x[j].w);
        const float rstd = 1.0f / sqrtf(wave_sum(ss) * (1.0f / DM) + EPS);
#pragma unroll
        for (int j = 0; j < 4; ++j) {
            const f32x4 s4 = *(const f32x4*)(sc + 4 * lane + 256 * j), h4 = *(const f32x4*)(sh + 4 * lane + 256 * j);
            const f32x4 y = x[j] * rstd * gv[j] * (s4 + 1.0f) + h4;
            u32x2 o; o.x = pk2(y.x, y.y); o.y = pk2(y.z, y.w);
            *(u32x2*)(hn + (size_t)m * DM + 4 * lane + 256 * j) = o;
        }
#pragma unroll
        for (int j = 0; j < 4; ++j) x[j] = xn[j];
    }
}
__device__ __forceinline__ void final_norm_rows(float* x, const float* g, int gw, int ngw, int lane) {
    f32x4 gv[4];
#pragma unroll
    for (int j = 0; j < 4; ++j) gv[j] = *(const f32x4*)(g + 4 * lane + 256 * j);
    f32x4 v[4];
    if (gw < MXR) {
#pragma unroll
        for (int j = 0; j < 4; ++j) v[j] = *(const f32x4*)(x + (size_t)gw * DM + 4 * lane + 256 * j); }
#pragma unroll 1
    for (int m = gw; m < MXR; m += ngw) {
        float* src = x + (size_t)m * DM;
        float ss = 0.f;
        f32x4 vn[4];
        if (m + ngw < MXR) {
#pragma unroll
            for (int j = 0; j < 4; ++j) vn[j] = *(const f32x4*)(x + (size_t)(m + ngw) * DM + 4 * lane + 256 * j); }
#pragma unroll
        for (int j = 0; j < 4; ++j) ss += (v[j].x * v[j].x + v[j].y * v[j].y) + (v[j].z * v[j].z + v[j].w * v[j].w);
        const float rstd = 1.0f / sqrtf(wave_sum(ss) * (1.0f / DM) + EPS);
#pragma unroll
        for (int j = 0; j < 4; ++j) *(f32x4*)(src + 4 * lane + 256 * j) = v[j] * rstd * gv[j];
#pragma unroll
        for (int j = 0; j < 4; ++j) v[j] = vn[j];
    }
}

__device__ __forceinline__ void cv_unpack(const u32x4 v, float (&o)[8]) { o[0] = bflo(v.x); o[1] = bfhi(v.x); o[2] = bflo(v.y); o[3] = bfhi(v.y); o[4] = bflo(v.z); o[5] = bfhi(v.z); o[6] = bflo(v.w); o[7] = bfhi(v.w); }
__device__ __forceinline__ void ffn_conv_phase(const bf16* a, bf16* up, const float* cw  , const float* cb, int row_first, int nrows, int gtid, int ngt, bf16* outp, long out_row_delta) {
    constexpr int ncg = DFF / 8, SEG = 16;
    const int nseg = nrows / SEG, tpc = ngt / ncg;
    if (gtid >= tpc * ncg) return;
    const int cgi = gtid % ncg, c = cgi * 8;
    float w[9][8], bias[8];
#pragma unroll
    for (int k = 0; k < 9; ++k) { const f32x4 w0 = *(const f32x4*)(cw + (size_t)k * DFF + c), w1 = *(const f32x4*)(cw + (size_t)k * DFF + c + 4);
        w[k][0] = w0.x; w[k][1] = w0.y; w[k][2] = w0.z; w[k][3] = w0.w; w[k][4] = w1.x; w[k][5] = w1.y; w[k][6] = w1.z; w[k][7] = w1.w; }
    { const f32x4 b0 = *(const f32x4*)(cb + c), b1 = *(const f32x4*)(cb + c + 4); bias[0] = b0.x; bias[1] = b0.y; bias[2] = b0.z; bias[3] = b0.w; bias[4] = b1.x; bias[5] = b1.y; bias[6] = b1.z; bias[7] = b1.w; }
#pragma unroll 1
    for (int seg = gtid / ncg; seg < nseg; seg += tpc) {
        const int row0 = row_first + seg * SEG;
        int rr, ww0, nr, nw;
        if (row0 < MXR) { const int t = row0 & 8191; rr = t >> 6; ww0 = t & 63; nr = 128; nw = 64; } else { const int t = (row0 - MXR) & 255; rr = 0; ww0 = t; nr = 1; nw = 256; }
        const bool has_up = rr > 0, has_dn = rr < nr - 1;
        const u32x4 zero = (u32x4){0u, 0u, 0u, 0u};
        u32x4 win[3][3];
        const bf16* pm = a + (size_t)row0 * DFF + c;
#pragma unroll
        for (int ky = 0; ky < 3; ++ky) {
            const bool okr = ky == 0 ? has_up : (ky == 2 ? has_dn : true);
            const bf16* pr = pm + (ptrdiff_t)(ky - 1) * nw * DFF;
            win[ky][0] = (okr && ww0 > 0) ? *(const u32x4*)(pr - DFF) : zero;
            win[ky][1] = okr ? *(const u32x4*)pr : zero;
        }
#pragma unroll 4
        for (int i = 0; i < SEG; ++i) {
            const int wcur = ww0 + i;
            const bool okn = wcur + 1 < nw;
#pragma unroll
            for (int ky = 0; ky < 3; ++ky) {
                const bool okr = ky == 0 ? has_up : (ky == 2 ? has_dn : true);
                win[ky][2] = (okr && okn) ? *(const u32x4*)(pm + (ptrdiff_t)((ky - 1) * nw + i + 1) * DFF) : zero;
            }
            const u32x4 uv = *(const u32x4*)(up + (size_t)(row0 + i) * DFF + c);
            float acc[8];
#pragma unroll
            for (int j = 0; j < 8; ++j) acc[j] = bias[j];
#pragma unroll
            for (int ky = 0; ky < 3; ++ky)
#pragma unroll
                for (int kx = 0; kx < 3; ++kx) { float v[8]; cv_unpack(win[ky][kx], v);
#pragma unroll
                    for (int j = 0; j < 8; ++j) acc[j] += w[ky * 3 + kx][j] * v[j]; }
            float u[8]; cv_unpack(uv, u);
            u32x4 o;
            o.x = pk2(siluf(acc[0]) * u[0], siluf(acc[1]) * u[1]); o.y = pk2(siluf(acc[2]) * u[2], siluf(acc[3]) * u[3]);
            o.z = pk2(siluf(acc[4]) * u[4], siluf(acc[5]) * u[5]); o.w = pk2(siluf(acc[6]) * u[6], siluf(acc[7]) * u[7]);
            *(u32x4*)(outp + (size_t)(row0 + i + out_row_delta) * DFF + c) = o;
#pragma unroll
            for (int ky = 0; ky < 3; ++ky) { win[ky][0] = win[ky][1]; win[ky][1] = win[ky][2]; }
        }
    }
}
constexpr int FN = 16384, FNP = FN + (FN >> 6) * 4;
constexpr int FFT_SCR = FNP * 8;
__device__ __forceinline__ int DI(int i) { return i + ((i >> 6) << 2); }
__device__ __forceinline__ f32x2 cmul(f32x2 a, f32x2 b) { return (f32x2){a.x * b.x - a.y * b.y, a.x * b.y + a.y * b.x}; }
__device__ __forceinline__ f32x2 cmulc(f32x2 a, f32x2 b) { return (f32x2){a.x * b.x + a.y * b.y, a.y * b.x - a.x * b.y}; }
__device__ __forceinline__ int rev4(int p) {
    unsigned r = __brev((unsigned)p) >> 18;
    return (int)(((r & 0x1555u) << 1) | ((r >> 1) & 0x1555u));
}
#define BF4F(x0, x1, x2, x3) do { const f32x2 a_ = x0 + x2, b_ = x0 - x2, c_ = x1 + x3, d_ = x1 - x3; x0 = a_ + c_; x2 = a_ - c_; x1 = (f32x2){b_.x + d_.y, b_.y - d_.x}; x3 = (f32x2){b_.x - d_.y, b_.y + d_.x}; } while (0)
#define BF4I(x0, x1, x2, x3) do { const f32x2 a_ = x0 + x2, b_ = x0 - x2, c_ = x1 + x3, d_ = x1 - x3; x0 = a_ + c_; x2 = a_ - c_; x1 = (f32x2){b_.x - d_.y, b_.y + d_.x}; x3 = (f32x2){b_.x + d_.y, b_.y - d_.x}; } while (0)
#define W16_C1 0.92387953251128674f
#define W16_S1 0.38268343236508977f
#define W16_H 0.70710678118654752f
__device__ __forceinline__ f32x2 w16(int e) {
    switch (e) { case 1: return (f32x2){W16_C1, -W16_S1}; case 2: return (f32x2){W16_H, -W16_H}; case 3: return (f32x2){W16_S1, -W16_C1}; case 4: return (f32x2){0.f, -1.f};
                 case 6: return (f32x2){-W16_H, -W16_H}; default: return (f32x2){-W16_C1, W16_S1}; }
}
template <bool INV> __device__ __forceinline__ void fft_pass16(LAS f32x2* D, int lgm, int tid) {
    const int m = 1 << lgm; const float rn = 1.0f / (float)(16 << lgm);
#pragma unroll 1
    for (int it = 0; it < 2; ++it) {
        const int bf = tid + NTHR * it, j0 = bf & (m - 1), base = ((bf >> lgm) << (lgm + 4)) + j0;
        f32x2 v[16];
#pragma unroll
        for (int r = 0; r < 16; ++r) v[r] = D[DI(base + r * m)];
        const float rev = (float)j0 * rn;
        const f32x2 w1 = (f32x2){__builtin_amdgcn_cosf(rev), -__builtin_amdgcn_sinf(rev)}, w2 = cmul(w1, w1), w3 = cmul(w2, w1);
        const f32x2 u1 = cmul(w2, w2), u2 = cmul(u1, u1), u3 = cmul(u2, u1);
        if (!INV) {
#pragma unroll
            for (int a = 0; a < 4; ++a) {
                BF4F(v[a], v[a + 4], v[a + 8], v[a + 12]);
                if (a > 0) { v[a + 4] = cmul(v[a + 4], w16(a)); v[a + 8] = cmul(v[a + 8], w16(2 * a)); v[a + 12] = cmul(v[a + 12], w16(3 * a)); }
                v[a + 4] = cmul(v[a + 4], w1); v[a + 8] = cmul(v[a + 8], w2); v[a + 12] = cmul(v[a + 12], w3);
            }
#pragma unroll
            for (int q = 0; q < 4; ++q) {
                BF4F(v[4 * q], v[4 * q + 1], v[4 * q + 2], v[4 * q + 3]);
                v[4 * q + 1] = cmul(v[4 * q + 1], u1); v[4 * q + 2] = cmul(v[4 * q + 2], u2); v[4 * q + 3] = cmul(v[4 * q + 3], u3);
            }
        } else {
#pragma unroll
            for (int q = 0; q < 4; ++q) {
                v[4 * q + 1] = cmulc(v[4 * q + 1], u1); v[4 * q + 2] = cmulc(v[4 * q + 2], u2); v[4 * q + 3] = cmulc(v[4 * q + 3], u3);
                BF4I(v[4 * q], v[4 * q + 1], v[4 * q + 2], v[4 * q + 3]);
            }
#pragma unroll
            for (int a = 0; a < 4; ++a) {
                v[a + 4] = cmulc(v[a + 4], w1); v[a + 8] = cmulc(v[a + 8], w2); v[a + 12] = cmulc(v[a + 12], w3);
                if (a > 0) { v[a + 4] = cmulc(v[a + 4], w16(a)); v[a + 8] = cmulc(v[a + 8], w16(2 * a)); v[a + 12] = cmulc(v[a + 12], w16(3 * a)); }
                BF4I(v[a], v[a + 4], v[a + 8], v[a + 12]);
            }
        }
#pragma unroll
        for (int r = 0; r < 16; ++r) D[DI(base + r * m)] = v[r];
    }
    __syncthreads();
}
template <bool INV> __device__ __forceinline__ void fft_pass4(LAS f32x2* D, int tid) {
#pragma unroll 2
    for (int it = 0; it < 8; ++it) {
        const int i0 = DI(4 * (tid + NTHR * it));
        f32x4 p01 = *(LAS f32x4*)(D + i0), p23 = *(LAS f32x4*)(D + i0 + 2);
        f32x2 x0 = (f32x2){p01.x, p01.y}, x1 = (f32x2){p01.z, p01.w}, x2 = (f32x2){p23.x, p23.y}, x3 = (f32x2){p23.z, p23.w};
        if (!INV) BF4F(x0, x1, x2, x3); else BF4I(x0, x1, x2, x3);
        *(LAS f32x4*)(D + i0) = (f32x4){x0.x, x0.y, x1.x, x1.y}; *(LAS f32x4*)(D + i0 + 2) = (f32x4){x2.x, x2.y, x3.x, x3.y};
    }
    __syncthreads();
}
__device__ __forceinline__ void fft_fwd(LAS f32x2* D, int tid) { fft_pass16<false>(D, 10, tid); fft_pass16<false>(D, 6, tid); fft_pass16<false>(D, 2, tid); fft_pass4<false>(D, tid); }
__device__ __forceinline__ void fft_inv(LAS f32x2* D, int tid) { fft_pass4<true>(D, tid); fft_pass16<true>(D, 2, tid); fft_pass16<true>(D, 6, tid); fft_pass16<true>(D, 10, tid); }
__device__ __forceinline__ void spec_mul(LAS f32x2* D, const f32x2* H, int tid) {
#pragma unroll 8
    for (int i = 0; i < 32; ++i) {
        const int p = tid + NTHR * i, k = rev4(p);
        f32x2 h;
        if (k <= 8192) h = H[k]; else { h = H[FN - k]; h.y = -h.y; }
        D[DI(p)] = cmul(D[DI(p)], h);
    }
    __syncthreads();
}

__device__ __forceinline__ f32x2 spec_at(const f32x2* H, int k) { f32x2 h; if (k <= 8192) h = H[k]; else { h = H[FN - k]; h.y = -h.y; } return h; }
__device__ __forceinline__ void fft_mid(LAS f32x2* D, const f32x2* H, int tid) {
#pragma unroll 4
    for (int it = 0; it < 8; ++it) {
        const int p = 4 * (tid + NTHR * it), i0 = DI(p);
        const f32x2 h0 = spec_at(H, rev4(p)), h1 = spec_at(H, rev4(p + 1)), h2 = spec_at(H, rev4(p + 2)), h3 = spec_at(H, rev4(p + 3));
        f32x4 p01 = *(LAS f32x4*)(D + i0), p23 = *(LAS f32x4*)(D + i0 + 2);
        f32x2 x0 = (f32x2){p01.x, p01.y}, x1 = (f32x2){p01.z, p01.w}, x2 = (f32x2){p23.x, p23.y}, x3 = (f32x2){p23.z, p23.w};
        BF4F(x0, x1, x2, x3);
        x0 = cmul(x0, h0); x1 = cmul(x1, h1); x2 = cmul(x2, h2); x3 = cmul(x3, h3);
        BF4I(x0, x1, x2, x3);
        *(LAS f32x4*)(D + i0) = (f32x4){x0.x, x0.y, x1.x, x1.y}; *(LAS f32x4*)(D + i0 + 2) = (f32x4){x2.x, x2.y, x3.x, x3.y};
    }
    __syncthreads();
}
__device__ __forceinline__ void fft_conv(LAS f32x2* D, const f32x2* H, int tid) {
    fft_pass16<false>(D, 10, tid); fft_pass16<false>(D, 6, tid); fft_pass16<false>(D, 2, tid);
    fft_mid(D, H, tid);
    fft_pass16<true>(D, 2, tid); fft_pass16<true>(D, 6, tid); fft_pass16<true>(D, 10, tid);
}

__device__ __forceinline__ void hy_spectrum_item(LAS unsigned char* lds, const bf16* h2l  , const float* w3l  , const float* hbias  , f32x2* Hs, int c, int tid, int wave, int lane) {
    LAS f32x2* D = (LAS f32x2*)lds;
    LAS f32x4* W3 = (LAS f32x4*)(lds + FFT_SCR);
    LAS float* red = (LAS float*)(lds + FFT_SCR + 2048);
    __syncthreads();
    if (tid < 64) { const float* wr = w3l + (size_t)tid * 1024 + c; W3[tid] = (f32x4){wr[0], wr[256], wr[512], wr[768]}; }
    __syncthreads();
    const float delta = fabsf(-3.0701134573253946f + (float)c * ((-15.350567286626973f + 3.0701134573253946f) / 255.0f));
    float s0 = 0.f, s1 = 0.f;
#pragma unroll 1
    for (int ib = 0; ib < 4; ++ib) {
        asm volatile("" ::: "memory");
        f32x4 acc[4];
#pragma unroll
        for (int u = 0; u < 4; ++u) acc[u] = (f32x4){0.f, 0.f, 0.f, 0.f};
#pragma unroll 2
        for (int j8 = 0; j8 < 8; ++j8) {
            f32x4 w[8];
#pragma unroll
            for (int e = 0; e < 8; ++e) w[e] = W3[8 * j8 + e];
#pragma unroll
            for (int u = 0; u < 4; ++u) {
                const int t = tid + NTHR * (4 * ib + u);
                const u32x4 hv = *(const u32x4*)(h2l + (size_t)t * 64 + 8 * j8);
                acc[u] += w[0] * bflo(hv.x) + w[1] * bfhi(hv.x) + w[2] * bflo(hv.y) + w[3] * bfhi(hv.y) + w[4] * bflo(hv.z) + w[5] * bfhi(hv.z) + w[6] * bflo(hv.w) + w[7] * bfhi(hv.w);
            }
        }
#pragma unroll
        for (int u = 0; u < 4; ++u) {
            const int t = tid + NTHR * (4 * ib + u);
            const f32x4 a = acc[u] * __expf(-((float)t / 8191.0f) * delta);
            D[DI(t)] = (f32x2){a.x, a.y};
            s0 += fabsf(a.x); s1 += fabsf(a.y);
            if (t >= 1) { D[DI(FN - t)] = (f32x2){a.z, a.w}; s0 += fabsf(a.z); s1 += fabsf(a.w); }
            if (t == 0) D[DI(8192)] = (f32x2){0.f, 0.f};
        }
    }
    block_sum2(s0, s1, red, wave, lane);
    fft_fwd(D, tid);
    const float i0 = 0.5f / s0, i1 = 0.5f / s1, bias0 = hbias[c], bias1 = hbias[256 + c];
#pragma unroll 1
    for (int i = 0; i < 17; ++i) {
        const int k = tid + NTHR * i;
        if (k <= 8192) {
            const f32x2 zk = D[DI(rev4(k))], zn = D[DI(rev4((FN - k) & (FN - 1)))];
            Hs[(size_t)(c * 2 + 0) * HSP + k] = (f32x2){(zk.x + zn.x) * i0 + bias0, (zk.y - zn.y) * i0};
            Hs[(size_t)(c * 2 + 1) * HSP + k] = (f32x2){(zk.y + zn.y) * i1 + bias1, -(zk.x - zn.x) * i1};
        }
    }
    __syncthreads();
}

__device__ __forceinline__ float hy_conv3(const bf16* row, int t, int len, float w0, float w1, float w2, float bias) {
    const float um = t > 0 ? bf2f(row[t - 1]) : 0.f, u0 = bf2f(row[t]), up = t < len - 1 ? bf2f(row[t + 1]) : 0.f;
    return w0 * um + w1 * u0 + w2 * up + bias;
}
__device__ __forceinline__ void hy_conv8(const bf16* row, int t0, int len, float w0, float w1, float w2, float bias, float (&o)[8]) {
    const u32x4 v = *(const u32x4*)(row + t0);
    const float um = t0 > 0 ? bf2f(row[t0 - 1]) : 0.f, un = t0 + 8 < len ? bf2f(row[t0 + 8]) : 0.f;
    float x[10]; x[0] = um; x[1] = bflo(v.x); x[2] = bfhi(v.x); x[3] = bflo(v.y); x[4] = bfhi(v.y); x[5] = bflo(v.z); x[6] = bfhi(v.z); x[7] = bflo(v.w); x[8] = bfhi(v.w); x[9] = un;
#pragma unroll
    for (int e = 0; e < 8; ++e) o[e] = w0 * x[e] + w1 * x[e + 1] + w2 * x[e + 2] + bias;
}
__device__ __forceinline__ void hy_fft_item(LAS unsigned char* lds, const bf16* uhyT, const float* cw  , const float* cb  , const f32x2* Hs, bf16* hyoT, int c, int tid) {
    LAS f32x2* D = (LAS f32x2*)lds;
    const bf16* rv = uhyT + (size_t)c * MROWS; const bf16* r1 = uhyT + (size_t)(256 + c) * MROWS; const bf16* r2 = uhyT + (size_t)(512 + c) * MROWS;
    const float vw0 = cw[c], vw1 = cw[768 + c], vw2 = cw[1536 + c], vb = cb[c];
    const float aw0 = cw[256 + c], aw1 = cw[768 + 256 + c], aw2 = cw[1536 + 256 + c], ab = cb[256 + c];
    const float bw0 = cw[512 + c], bw1 = cw[768 + 512 + c], bw2 = cw[1536 + 512 + c], bb = cb[512 + c];
    const float inv = 1.0f / (float)FN;
    __syncthreads();
#pragma unroll
    for (int i = 0; i < 2; ++i) { const int t0 = 8 * (tid + NTHR * i);
        float a[8], b[8]; hy_conv8(rv, t0, LX, vw0, vw1, vw2, vb, a); hy_conv8(rv + LX, t0, LX, vw0, vw1, vw2, vb, b);
#pragma unroll
        for (int e = 0; e < 8; ++e) { D[DI(t0 + e)] = (f32x2){a[e], b[e]}; D[DI(t0 + e + LX)] = (f32x2){0.f, 0.f}; } }
    __syncthreads();
    fft_conv(D, Hs + (size_t)(c * 2 + 0) * HSP, tid);
#pragma unroll
    for (int i = 0; i < 2; ++i) { const int t0 = 8 * (tid + NTHR * i);
        float a[8], b[8]; hy_conv8(r1, t0, LX, aw0, aw1, aw2, ab, a); hy_conv8(r1 + LX, t0, LX, aw0, aw1, aw2, ab, b);
#pragma unroll
        for (int e = 0; e < 8; ++e) { const f32x2 cv = D[DI(t0 + e)]; D[DI(t0 + e)] = (f32x2){a[e] * cv.x * inv, b[e] * cv.y * inv}; D[DI(t0 + e + LX)] = (f32x2){0.f, 0.f}; } }
    __syncthreads();
    fft_conv(D, Hs + (size_t)(c * 2 + 1) * HSP, tid);
#pragma unroll
    for (int i = 0; i < 2; ++i) { const int t0 = 8 * (tid + NTHR * i);
        float a[8], b[8], oa[8], ob[8]; hy_conv8(r2, t0, LX, bw0, bw1, bw2, bb, a); hy_conv8(r2 + LX, t0, LX, bw0, bw1, bw2, bb, b);
#pragma unroll
        for (int e = 0; e < 8; ++e) { const f32x2 cv = D[DI(t0 + e)]; oa[e] = a[e] * cv.x * inv; ob[e] = b[e] * cv.y * inv; }
        *(u32x4*)(hyoT + (size_t)c * MROWS + t0) = pack8(oa);
        *(u32x4*)(hyoT + (size_t)c * MROWS + LX + t0) = pack8(ob); }
    __syncthreads();
}

__device__ __forceinline__ void hy_ctx_conv(const LAS float* Gn, const LAS float* Yb, LAS float* Rb, int t0) {
    const LAS float* Gp = Gn + 255 + t0;
    float a0 = 0.f, a1 = 0.f, a2 = 0.f, a3 = 0.f, g0 = Gp[0], g1 = Gp[1], g2 = Gp[2], g3 = Gp[3];
#pragma unroll 4
    for (int s = 0; s < 256; ++s) {
        const float y = Yb[s];
        a0 += y * g0; a1 += y * g1; a2 += y * g2; a3 += y * g3;
        g3 = g2; g2 = g1; g1 = g0; g0 = Gp[-(s + 1)];
    }
    Rb[t0] = a0; Rb[t0 + 1] = a1; Rb[t0 + 2] = a2; Rb[t0 + 3] = a3;
}
__device__ __forceinline__ void hy_ctx_item(LAS unsigned char* lds, const bf16* uhyT, const float* cw, const float* cb, const float* hbias, const float* h2c  , const float* w3l, bf16* mix, int c, int tid, int wave, int lane) {
    LAS float* G = (LAS float*)lds + 4;
    LAS float* Y = G + 1024;
    LAS float* R = Y + 512;
    LAS f32x4* W3 = (LAS f32x4*)((LAS float*)lds + 2064);
    LAS float* red = (LAS float*)lds + 2064 + 256;
    __syncthreads();
    if (tid < 64) { const float* wr = w3l + (size_t)tid * 1024 + c; W3[tid] = (f32x4){wr[0], wr[256], wr[512], wr[768]}; }
    if (tid < 2) G[tid * 512 + 511] = 0.f;
    __syncthreads();
    const float delta = fabsf(-3.0701134573253946f + (float)c * ((-15.350567286626973f + 3.0701134573253946f) / 255.0f));
    float s0 = 0.f, s1 = 0.f;
    if (tid < 256) {
        const f32x4* hr = (const f32x4*)(h2c + (size_t)tid * 64);
        f32x4 acc = (f32x4){0.f, 0.f, 0.f, 0.f};
#pragma unroll
        for (int j4 = 0; j4 < 16; ++j4) { const f32x4 hv = hr[j4];
            acc += W3[4 * j4 + 0] * hv.x; acc += W3[4 * j4 + 1] * hv.y; acc += W3[4 * j4 + 2] * hv.z; acc += W3[4 * j4 + 3] * hv.w; }
        acc *= __expf(-((float)tid / 255.0f) * delta);
        G[255 + tid] = acc.x; G[512 + 255 + tid] = acc.y;
        if (tid >= 1) { G[255 - tid] = acc.z; G[512 + 255 - tid] = acc.w; }
        s0 = fabsf(acc.x) + (tid >= 1 ? fabsf(acc.z) : 0.f); s1 = fabsf(acc.y) + (tid >= 1 ? fabsf(acc.w) : 0.f);
    }
    block_sum2(s0, s1, red, wave, lane);
    const float n0 = 1.0f / s0, n1 = 1.0f / s1;
    const int b = tid >> 8, t = tid & 255;
    const bf16* rv = uhyT + (size_t)c * MROWS + MXR + b * LC; const bf16* r1 = uhyT + (size_t)(256 + c) * MROWS + MXR + b * LC; const bf16* r2 = uhyT + (size_t)(512 + c) * MROWS + MXR + b * LC;
    const float v = hy_conv3(rv, t, LC, cw[c], cw[768 + c], cw[1536 + c], cb[c]);
    const float g1 = hy_conv3(r1, t, LC, cw[256 + c], cw[768 + 256 + c], cw[1536 + 256 + c], cb[256 + c]);
    const float g2 = hy_conv3(r2, t, LC, cw[512 + c], cw[768 + 512 + c], cw[1536 + 512 + c], cb[512 + c]);
    Y[b * 256 + t] = v;
    __syncthreads();
    if (tid < 128) hy_ctx_conv(G, Y + (tid >> 6) * 256, R + (tid >> 6) * 256, 4 * (tid & 63));
    __syncthreads();
    const float y1 = g1 * (R[b * 256 + t] * n0 + v * hbias[c]);
    Y[b * 256 + t] = y1;
    __syncthreads();
    if (tid < 128) hy_ctx_conv(G + 512, Y + (tid >> 6) * 256, R + (tid >> 6) * 256, 4 * (tid & 63));
    __syncthreads();
    const float o = g2 * (R[b * 256 + t] * n1 + y1 * hbias[256 + c]);
    mix[(size_t)(MXR + b * LC + t) * DM + 256 + c] = (bf16)f2bf(o);
    __syncthreads();
}
typedef short s16x4 __attribute__((ext_vector_type(4)));
#define LBAR() do { asm volatile("s_waitcnt lgkmcnt(0)" ::: "memory"); __builtin_amdgcn_s_barrier(); asm volatile("" ::: "memory"); } while (0)
#define MFMA32(a, b, c) __builtin_amdgcn_mfma_f32_16x16x32_bf16((a), (b), (c), 0, 0, 0)
__device__ __forceinline__ bf16x8 frag16(const LAS bf16* p) { return *(const LAS bf16x8*)p; }
__device__ __forceinline__ bf16x8 frag2x8(const LAS bf16* p0, const LAS bf16* p1) { const s16x4 a = *(const LAS s16x4*)p0, b = *(const LAS s16x4*)p1; return __builtin_shufflevector(a, b, 0, 1, 2, 3, 4, 5, 6, 7); }
__device__ __forceinline__ bf16x8 pack_acc2(const f32x4 a, const f32x4 b) { u32x4 u; u.x = pk2(a[0], a[1]); u.y = pk2(a[2], a[3]); u.z = pk2(b[0], b[1]); u.w = pk2(b[2], b[3]); return __builtin_bit_cast(bf16x8, u); }

__device__ __forceinline__ void ssd_prepass(const bf16* uxs, const bf16* ubc, const float* cw  , const float* cb  , bf16* axt, bf16* abc, bf16* abt, int gw, int ngw, int lane) {
    const int wpc = ngw / 96;
    if (gw < wpc * 96) {
    const int cg = gw % 96, xcol = cg < 64 ? 8 * cg : 512 + 8 * (cg - 64);
    float tw0[8], tw1[8], tw2[8], tb[8];
#pragma unroll
    for (int j = 0; j < 8; ++j) { tw0[j] = cw[xcol + j]; tw1[j] = cw[1024 + xcol + j]; tw2[j] = cw[2048 + xcol + j]; tb[j] = cb[xcol + j]; }
#pragma unroll 2
    for (int C = gw / 96; C < 264; C += wpc) {
        const int row = 64 * C + lane;
        const int t = row < MXR ? (row & 8191) : ((row - MXR) & 255), len = row < MXR ? LX : LC;
        const bf16* src = cg < 64 ? uxs + (size_t)row * 512 + 8 * cg : ubc + (size_t)row * 512 + 8 * (cg - 64);
        const u32x4 u0 = *(const u32x4*)src;
        const u32x4 um = t > 0 ? *(const u32x4*)(src - 512) : (u32x4){0u, 0u, 0u, 0u};
        const u32x4 un = t < len - 1 ? *(const u32x4*)(src + 512) : (u32x4){0u, 0u, 0u, 0u};
        float a[8], c0[8], c2[8], o[8];
        cv_unpack(um, a); cv_unpack(u0, c0); cv_unpack(un, c2);
#pragma unroll
        for (int j = 0; j < 8; ++j) o[j] = siluf(tw0[j] * a[j] + tw1[j] * c0[j] + tw2[j] * c2[j] + tb[j]);
        bf16* dst = cg < 64 ? axt + ((size_t)(C * 8 + (cg >> 3)) * 64 + 8 * (cg & 7)) * 64 + lane : abt + ((size_t)(C * 2 + ((cg - 64) >> 4)) * 128 + 8 * ((cg - 64) & 15)) * 64 + lane;
#pragma unroll
        for (int j = 0; j < 8; ++j) dst[j * 64] = (bf16)f2bf(o[j]);
    }
    }
    {
        float w0[8], w1[8], w2[8], bi[8];
#pragma unroll
        for (int j = 0; j < 8; ++j) { const int xcol = 512 + 8 * lane + j; w0[j] = cw[xcol]; w1[j] = cw[1024 + xcol]; w2[j] = cw[2048 + xcol]; bi[j] = cb[xcol]; }
#pragma unroll 1
        for (int it = gw; it < MROWS / 16; it += ngw) {
            const int r0 = 16 * it;
            const int t0 = r0 < MXR ? (r0 & 8191) : ((r0 - MXR) & 255), len = r0 < MXR ? LX : LC;
            const bf16* src = ubc + (size_t)r0 * 512 + 8 * lane;
            u32x4 pm = t0 > 0 ? *(const u32x4*)(src - 512) : (u32x4){0u, 0u, 0u, 0u};
            u32x4 pc = *(const u32x4*)src;
#pragma unroll 4
            for (int i = 0; i < 16; ++i) {
                const u32x4 pn = (t0 + i < len - 1) ? *(const u32x4*)(src + (size_t)(i + 1) * 512) : (u32x4){0u, 0u, 0u, 0u};
                float a[8], c0[8], c2[8], o[8];
                cv_unpack(pm, a); cv_unpack(pc, c0); cv_unpack(pn, c2);
#pragma unroll
                for (int j = 0; j < 8; ++j) o[j] = siluf(w0[j] * a[j] + w1[j] * c0[j] + w2[j] * c2[j] + bi[j]);
                *(u32x4*)(abc + (size_t)(r0 + i) * 512 + 8 * lane) = pack8(o);
                pm = pc; pc = pn;
            }
        }
    }
}

struct SsdArgs {
    const bf16* axt; const bf16* abc; const bf16* abt; const bf16* uz; const float* udt; const float* dtb; const float* alog; const float* dvec;
    float* sst; float* dts; bf16* mix; float* ssq;
};
constexpr int XP = 72, BP = 136;

__device__ __forceinline__ void ssd_state_item(LAS unsigned char* lds, const SsdArgs& A, int b, int sc, int h, int tid, int wave, int lane) {
    LAS bf16* XsT = (LAS bf16*)lds;
    LAS bf16* BtT = XsT + 4 * 64 * XP;
    LAS float* wv = (LAS float*)(BtT + 4 * 128 * XP);
    LAS float* aend = wv + 512;
    const int g = h >> 2;
    const int row0 = sc == 32 ? MXR + b * LC : b * LX, tok0 = sc == 32 ? 0 : sc * 256;
    const int pt = wave & 3, half = wave >> 2, l15 = lane & 15, l4 = lane >> 4;
    const int Cg0 = (row0 + tok0) >> 6;
    u32x4 raw[4][3];
#pragma unroll
    for (int ci = 0; ci < 4; ++ci) {
        raw[ci][0] = *(const u32x4*)(A.axt + ((size_t)((Cg0 + ci) * 8 + h) * 64 + (tid >> 3)) * 64 + 8 * (tid & 7));
#pragma unroll
        for (int k = 0; k < 2; ++k) { const int e = tid + NTHR * k; raw[ci][1 + k] = *(const u32x4*)(A.abt + ((size_t)((Cg0 + ci) * 2 + g) * 128 + (e >> 3)) * 64 + 8 * (e & 7)); }
    }
    {
        const int dir = wave >> 2, ci = wave & 3, tok = dir ? 63 - lane : lane;
        const float rawv = A.udt[(size_t)(row0 + tok0 + 64 * ci + tok) * 16 + dir * 8 + h] + A.dtb[dir * 8 + h];
        const float dt = rawv > 20.f ? rawv : log1pf(__expf(rawv));
        float x = dt * (-__expf(A.alog[dir * 8 + h]));
#pragma unroll
        for (int off = 1; off < 64; off <<= 1) { const float y = __shfl_up(x, off); if (lane >= off) x += y; }
        const float ae = __shfl(x, 63);
        __syncthreads();
        wv[(dir * 4 + ci) * 64 + tok] = dt * __expf(ae - x);
        if (lane == 0) aend[dir * 4 + ci] = ae;
    }
#pragma unroll
    for (int ci = 0; ci < 4; ++ci) {
        *(LAS u32x4*)(XsT + (ci * 64 + (tid >> 3)) * XP + 8 * (tid & 7)) = raw[ci][0];
#pragma unroll
        for (int k = 0; k < 2; ++k) { const int e = tid + NTHR * k; *(LAS u32x4*)(BtT + (ci * 128 + (e >> 3)) * XP + 8 * (e & 7)) = raw[ci][1 + k]; }
    }
    __syncthreads();
#pragma unroll 1
    for (int dir = 0; dir < 2; ++dir) {
        f32x4 ST[4];
#pragma unroll
        for (int nt = 0; nt < 4; ++nt) ST[nt] = (f32x4){0.f, 0.f, 0.f, 0.f};
#pragma unroll 1
        for (int step = 0; step < 4; ++step) {
            const int ci = dir ? 3 - step : step;
            const float ea = __expf(aend[dir * 4 + ci]);
            bf16x8 xw[2];
#pragma unroll
            for (int kk = 0; kk < 2; ++kk) {
                const u32x4 xu = *(const LAS u32x4*)(XsT + (ci * 64 + 16 * pt + l15) * XP + 32 * kk + 8 * l4);
                const LAS float* wp = wv + (dir * 4 + ci) * 64 + 32 * kk + 8 * l4;
                const f32x4 w0 = *(const LAS f32x4*)wp, w1 = *(const LAS f32x4*)(wp + 4);
                u32x4 u; u.x = pk2(bflo(xu.x) * w0.x, bfhi(xu.x) * w0.y); u.y = pk2(bflo(xu.y) * w0.z, bfhi(xu.y) * w0.w); u.z = pk2(bflo(xu.z) * w1.x, bfhi(xu.z) * w1.y); u.w = pk2(bflo(xu.w) * w1.z, bfhi(xu.w) * w1.w);
                xw[kk] = __builtin_bit_cast(bf16x8, u);
            }
#pragma unroll
            for (int nt = 0; nt < 4; ++nt) {
                f32x4 acc = ST[nt] * ea;
                const LAS bf16* pa = BtT + (ci * 128 + 16 * (4 * half + nt) + l15) * XP + 8 * l4;
#pragma unroll
                for (int kk = 0; kk < 2; ++kk) acc = MFMA32(frag16(pa + 32 * kk), xw[kk], acc);
                ST[nt] = acc;
            }
        }
        float* slot = A.sst + ((size_t)(((b * 2 + dir) * 33 + sc) * 8 + h)) * 8192;
#pragma unroll
        for (int nt = 0; nt < 4; ++nt) *(f32x4*)(slot + (size_t)(16 * pt + l15) * 128 + 16 * (4 * half + nt) + 4 * l4) = ST[nt];
    }
    if (tid < 2) A.dts[((b * 2 + tid) * 33 + sc) * 8 + h] = __expf((aend[tid * 4] + aend[tid * 4 + 1]) + (aend[tid * 4 + 2] + aend[tid * 4 + 3]));
}

template <int MODE>
__device__ __forceinline__ void ssd_item(LAS unsigned char* lds, const SsdArgs& A, int b, int sc, int hp, int dir, int tid, int wave, int lane) {
    LAS bf16* Bt = (LAS bf16*)lds;
    LAS bf16* BtT = Bt + 64 * BP;
    LAS bf16* Ct = BtT + 128 * XP;
    LAS bf16* XsT0 = Ct + 64 * BP;
    LAS bf16* Mt0 = XsT0 + 2 * 64 * XP;
    LAS float* vec0 = (LAS float*)(Mt0 + 2 * 64 * XP);
    LAS float* SQ0 = vec0 + 2 * 272;
    const int hh = wave >> 2, pt = wave & 3, h = 2 * hp + hh, g = hp >> 1, l15 = lane & 15, l4 = lane >> 4;
    LAS bf16* XsT = XsT0 + hh * 64 * XP; LAS bf16* Mt = Mt0 + hh * 64 * XP;
    LAS float* dtv = vec0 + hh * 272, *acs = dtv + 64, *wv = dtv + 128, *eacs = dtv + 192, *misc = dtv + 256;
    LAS float* SQ = SQ0 + hh * 256;
    const int row0 = sc == 32 ? MXR + b * LC : b * LX, tok0 = sc == 32 ? 0 : sc * 256;
    const int Cg0 = (row0 + tok0) >> 6;
    const float* slot = A.sst + ((size_t)(((b * 2 + dir) * 33 + sc) * 8 + h)) * 8192;
    f32x4 ST[8];
#pragma unroll
    for (int nt = 0; nt < 8; ++nt) {
        if (sc == 32) ST[nt] = (f32x4){0.f, 0.f, 0.f, 0.f};
        else ST[nt] = *(const f32x4*)(slot + (size_t)(16 * pt + l15) * 128 + 16 * nt + 4 * l4);
    }
    const float a_h = -__expf(A.alog[dir * 8 + h]), dtb_h = A.dtb[dir * 8 + h], d_h = A.dvec[h];
    u32x4 raw[8]; float dtraw = 0.f;
#define SSD_ISSUE(ci) do { const int Cg = Cg0 + (ci); const size_t rb = (size_t)(row0 + tok0 + 64 * (ci)); \
        _Pragma("unroll") for (int k = 0; k < 2; ++k) { const int e = tid + NTHR * k; \
            raw[k] = *(const u32x4*)(A.axt + ((size_t)(Cg * 8 + 2 * hp + k) * 64 + (tid >> 3)) * 64 + 8 * (tid & 7)); \
            raw[2 + k] = *(const u32x4*)(A.abt + ((size_t)(Cg * 2 + g) * 128 + (e >> 3)) * 64 + 8 * (e & 7)); \
            raw[4 + k] = *(const u32x4*)(A.abc + (rb + (e >> 4)) * 512 + g * 128 + 8 * (e & 15)); \
            raw[6 + k] = *(const u32x4*)(A.abc + (rb + (e >> 4)) * 512 + 256 + g * 128 + 8 * (e & 15)); } \
        if (pt == 0) dtraw = A.udt[(rb + (dir ? 63 - lane : lane)) * 16 + dir * 8 + h]; } while (0)
    SSD_ISSUE(dir ? 3 : 0);
    __syncthreads();
#pragma unroll 1
    for (int i = 0; i < 4; ++i) {
        const int ci = dir ? 3 - i : i, tokc = tok0 + 64 * ci;
#pragma unroll
        for (int k = 0; k < 2; ++k) { const int e = tid + NTHR * k;
            *(LAS u32x4*)(XsT0 + (k * 64 + (tid >> 3)) * XP + 8 * (tid & 7)) = raw[k];
            *(LAS u32x4*)(BtT + (e >> 3) * XP + 8 * (e & 7)) = raw[2 + k];
            *(LAS u32x4*)(Bt + (e >> 4) * BP + 8 * (e & 15)) = raw[4 + k];
            *(LAS u32x4*)(Ct + (e >> 4) * BP + 8 * (e & 15)) = raw[6 + k]; }
        if (pt == 0) {
            const int tok = dir ? 63 - lane : lane;
            const float rawv = dtraw + dtb_h;
            const float dt = rawv > 20.f ? rawv : log1pf(__expf(rawv));
            float x = dt * a_h;
#pragma unroll
            for (int off = 1; off < 64; off <<= 1) { const float y = __shfl_up(x, off); if (lane >= off) x += y; }
            const float aend = __shfl(x, 63);
            dtv[tok] = dt; acs[tok] = x; wv[tok] = dt * __expf(aend - x); eacs[tok] = __expf(x);
            if (lane == 0) misc[0] = __expf(aend);
        }
        if (i < 3) SSD_ISSUE(dir ? 2 - i : i + 1);
        u32x2 pm_[4], pz_[4];
        if (MODE == 2) {
#pragma unroll
            for (int tt2 = 0; tt2 < 4; ++tt2) {
                const int t = tokc + 16 * tt2 + l15;
                pm_[tt2] = *(const u32x2*)(A.mix + (unsigned)((row0 + t) * DM + 512 + h * 64 + 16 * pt + 4 * l4));
                pz_[tt2] = *(const u32x2*)(A.uz + (unsigned)((row0 + t) * 512 + h * 64 + 16 * pt + 4 * l4));
            }
        }
        LBAR();
        {
            const int tt = wave >> 1;
#pragma unroll
            for (int j = 0; j < 2; ++j) {
                const int st = 2 * (wave & 1) + j;
                const bool live = dir ? st >= tt : st <= tt;
                f32x4 acc = (f32x4){0.f, 0.f, 0.f, 0.f};
                if (live) {
                    const LAS bf16* pa = Ct + (16 * tt + l15) * BP + 8 * l4; const LAS bf16* pb = Bt + (16 * st + l15) * BP + 8 * l4;
                    bf16x8 fa_[4], fb_[4];
#pragma unroll
                    for (int kk = 0; kk < 4; ++kk) { fa_[kk] = frag16(pa + 32 * kk); fb_[kk] = frag16(pb + 32 * kk); }
#pragma unroll
                    for (int kk = 0; kk < 4; ++kk) acc = MFMA32(fa_[kk], fb_[kk], acc);
                }
                const int sI = 16 * st + l15;
#pragma unroll
                for (int q = 0; q < 2; ++q) {
                    const LAS float* dq = vec0 + q * 272; const float as = dq[64 + sI], ds = dq[sI];
#pragma unroll
                    for (int r = 0; r < 4; ++r) { const int tI = 16 * tt + 4 * l4 + r;
                        const bool ok = live && (dir ? sI >= tI : sI <= tI);
                        Mt0[(q * 64 + tI) * XP + sI] = (bf16)f2bf(ok ? acc[r] * __expf(dq[64 + tI] - as) * ds : 0.f); }
                }
            }
            LBAR();
            bf16x8 STf[4];
#pragma unroll
            for (int m = 0; m < 4; ++m) STf[m] = pack_acc2(ST[2 * m], ST[2 * m + 1]);
            const bf16x8 xf0 = frag16(XsT + (16 * pt + l15) * XP + 8 * l4), xf1 = frag16(XsT + (16 * pt + l15) * XP + 32 + 8 * l4);
#pragma unroll
            for (int tt2 = 0; tt2 < 4; ++tt2) {
                const int tI = 16 * tt2 + l15;
                f32x4 accS = (f32x4){0.f, 0.f, 0.f, 0.f}, accI = (f32x4){0.f, 0.f, 0.f, 0.f};
                bf16x8 cf_[4]; const bf16x8 mf0 = frag16(Mt + tI * XP + 8 * l4), mf1 = frag16(Mt + tI * XP + 32 + 8 * l4);
#pragma unroll
                for (int m = 0; m < 4; ++m) { const LAS bf16* pc = Ct + tI * BP + 32 * m + 4 * l4; cf_[m] = frag2x8(pc, pc + 16); }
#pragma unroll
                for (int m = 0; m < 4; ++m) accS = MFMA32(STf[m], cf_[m], accS);
                if (dir ? (1 >= tt2) : true) accI = MFMA32(xf0, mf0, accI);
                if (dir ? true : (2 <= tt2)) accI = MFMA32(xf1, mf1, accI);
                f32x4 yv = accI + accS * eacs[tI];
                const int t = tokc + tI;
                bf16* mp = A.mix + (unsigned)((row0 + t) * DM + 512 + h * 64 + 16 * pt + 4 * l4);
                if (MODE == 2) {
                    const LAS bf16* xp = XsT + (16 * pt + 4 * l4) * XP + tI;
                    yv[0] = (yv[0] + bflo(pm_[tt2].x) + d_h * bf2f(xp[0])) * siluf(bflo(pz_[tt2].x)); yv[1] = (yv[1] + bfhi(pm_[tt2].x) + d_h * bf2f(xp[XP])) * siluf(bfhi(pz_[tt2].x));
                    yv[2] = (yv[2] + bflo(pm_[tt2].y) + d_h * bf2f(xp[2 * XP])) * siluf(bflo(pz_[tt2].y)); yv[3] = (yv[3] + bfhi(pm_[tt2].y) + d_h * bf2f(xp[3 * XP])) * siluf(bfhi(pz_[tt2].y));
                    float qq = (yv[0] * yv[0] + yv[1] * yv[1]) + (yv[2] * yv[2] + yv[3] * yv[3]);
                    qq += __shfl_xor(qq, 16); qq += __shfl_xor(qq, 32);
                    if (l4 == 0) SQ[pt * 64 + tI] = qq;
                }
                u32x2 o; o.x = pk2(yv[0], yv[1]); o.y = pk2(yv[2], yv[3]);
                *(u32x2*)mp = o;
            }
        }
        {
            const float ea = misc[0];
            bf16x8 xw[2];
#pragma unroll
            for (int kk = 0; kk < 2; ++kk) {
                const u32x4 xu = *(const LAS u32x4*)(XsT + (16 * pt + l15) * XP + 32 * kk + 8 * l4);
                const f32x4 w0 = *(const LAS f32x4*)(wv + 32 * kk + 8 * l4), w1 = *(const LAS f32x4*)(wv + 32 * kk + 8 * l4 + 4);
                u32x4 u; u.x = pk2(bflo(xu.x) * w0.x, bfhi(xu.x) * w0.y); u.y = pk2(bflo(xu.y) * w0.z, bfhi(xu.y) * w0.w); u.z = pk2(bflo(xu.z) * w1.x, bfhi(xu.z) * w1.y); u.w = pk2(bflo(xu.w) * w1.z, bfhi(xu.w) * w1.w);
                xw[kk] = __builtin_bit_cast(bf16x8, u);
            }
            bf16x8 af_[8][2];
#pragma unroll
            for (int nt = 0; nt < 8; ++nt) { const LAS bf16* pa = BtT + (16 * nt + l15) * XP + 8 * l4; af_[nt][0] = frag16(pa); af_[nt][1] = frag16(pa + 32); }
#pragma unroll
            for (int nt = 0; nt < 8; ++nt) ST[nt] = MFMA32(af_[nt][1], xw[1], MFMA32(af_[nt][0], xw[0], ST[nt] * ea));
        }
        LBAR();
        if (MODE == 2 && tid < 128) { const int q = tid >> 6, tI = tid & 63; const LAS float* sq = SQ0 + q * 256 + tI;
            A.ssq[(size_t)(row0 + tokc + tI) * 8 + 2 * hp + q] = (sq[0] + sq[64]) + (sq[128] + sq[192]); }
    }
#undef SSD_ISSUE
    __syncthreads();
}

struct HgArgs {
    const bf16* uhg; const float* lb0; const float* lb1; const float* normg; int layer;
    float* hst; float* dth; bf16* mix;
};
constexpr int HP = 72, PP = 40, HG_LDS_BYTES = (3 * 32 * HP + 2 * 64 * PP + 32 * PP) * 2 + (256 + 64 + 128 + 32) * 4;
template <int MODE>
__device__ __forceinline__ void hg_item(LAS unsigned char* lds, const HgArgs& A, int b, int sc, int hp, int dir, int tid, int lane) {
    const int hgp = tid >> 8, tg = tid & 255, hw = (tid >> 6) & 3, h = 2 * hp + hgp;
    LAS bf16* Qt = (LAS bf16*)(lds + hgp * HG_LDS_BYTES);
    LAS bf16* Kt = Qt + 32 * HP;
    LAS bf16* Qh = Kt + 32 * HP;
    LAS bf16* KhT = Qh + 32 * HP;
    LAS bf16* VtT = KhT + 64 * PP;
    LAS bf16* Pm = VtT + 64 * PP;
    LAS float* tot = (LAS float*)(Pm + 32 * PP);
    LAS float* ebend = tot + 256;
    LAS float* SQ = ebend + 64;
    LAS float* rstd = SQ + 128;
    const int row0 = sc == 32 ? MXR + b * LC : b * LX, tok0 = sc == 32 ? 0 : sc * 256;
    const int l15 = lane & 15, l4 = lane >> 4, vt = hw;
    float* slot = A.hst + ((size_t)(((b * 2 + dir) * 33 + sc) * 4 + h)) * 4096;
    f32x4 S[4];
#pragma unroll
    for (int kt = 0; kt < 4; ++kt) {
        if (MODE == 0 || sc == 32) S[kt] = (f32x4){0.f, 0.f, 0.f, 0.f};
        else S[kt] = *(const f32x4*)(slot + (size_t)(16 * vt + l15) * 64 + 16 * kt + 4 * l4);
    }
    const int tau = tg >> 3, kg = tg & 7;
    float lbv[8], sumb[8];
#pragma unroll
    for (int j = 0; j < 8; ++j) { const int k = h * 64 + 8 * kg + j; lbv[j] = A.layer == 0 ? 0.f : sigmf(A.lb1[k] - A.lb0[k]); sumb[j] = 0.f; }
    u32x4 qv, fv, vv;
#define HG_ISSUE(ci) do { const int s_ = 32 * (ci) + tau, t_ = dir ? tok0 + 255 - s_ : tok0 + s_; \
        const bf16* up_ = A.uhg + (size_t)(row0 + t_) * 1280 + h * 64 + 8 * kg; \
        qv = *(const u32x4*)up_; fv = *(const u32x4*)(up_ + 256 + dir * 256); vv = *(const u32x4*)(up_ + 768); } while (0)
    HG_ISSUE(0);
    __syncthreads();
#pragma unroll 1
    for (int i = 0; i < 8; ++i) {
        float q[8], f[8], v[8], kk[8], bb[8];
        q[0] = bflo(qv.x); q[1] = bfhi(qv.x); q[2] = bflo(qv.y); q[3] = bfhi(qv.y); q[4] = bflo(qv.z); q[5] = bfhi(qv.z); q[6] = bflo(qv.w); q[7] = bfhi(qv.w);
        f[0] = bflo(fv.x); f[1] = bfhi(fv.x); f[2] = bflo(fv.y); f[3] = bfhi(fv.y); f[4] = bflo(fv.z); f[5] = bfhi(fv.z); f[6] = bflo(fv.w); f[7] = bfhi(fv.w);
        v[0] = bflo(vv.x); v[1] = bfhi(vv.x); v[2] = bflo(vv.y); v[3] = bfhi(vv.y); v[4] = bflo(vv.z); v[5] = bfhi(vv.z); v[6] = bflo(vv.w); v[7] = bfhi(vv.w);
        if (i < 7) HG_ISSUE(i + 1);
#pragma unroll
        for (int j = 0; j < 8; ++j) {
            const float sg = sigmf(f[j]);
            const float fj = lbv[j] + (1.0f - lbv[j]) * sg;
            kk[j] = (1.0f - lbv[j]) * (1.0f - sg);
            float x = lbv[j] == 0.f ? fminf(f[j], 0.f) - __logf(1.0f + __expf(-fabsf(f[j]))) : __logf(fj);
#pragma unroll
            for (int off = 8; off < 64; off <<= 1) { const float y = __shfl_up(x, off); if (lane >= off) x += y; }
            bb[j] = x;
        }
        if (lane >= 56) {
#pragma unroll
            for (int j = 0; j < 8; ++j) tot[hw * 64 + 8 * kg + j] = bb[j];
        }
        LBAR();
        {
            float oq[8], ok[8], oh[8];
#pragma unroll
            for (int j = 0; j < 8; ++j) {
                const int k = 8 * kg + j;
                const float t0 = tot[k], t1 = tot[64 + k], t2 = tot[128 + k], t3 = tot[192 + k];
                const float off = hw == 0 ? 0.f : (hw == 1 ? t0 : (hw == 2 ? t0 + t1 : t0 + t1 + t2));
                const float bj = bb[j] + off, bmid = t0 + t1, bend = (t0 + t1) + (t2 + t3);
                oq[j] = q[j] * 0.125f * __expf(bj - bmid); ok[j] = kk[j] * __expf(bmid - bj); oh[j] = q[j] * 0.125f * __expf(bj);
                KhT[k * PP + tau] = (bf16)f2bf(kk[j] * __expf(bend - bj)); VtT[k * PP + tau] = (bf16)f2bf(v[j]);
                if (tau == 0) { ebend[k] = __expf(bend); sumb[j] += bend; }
            }
            if (MODE != 0) { *(LAS u32x4*)(Qt + tau * HP + 8 * kg) = pack8(oq); *(LAS u32x4*)(Kt + tau * HP + 8 * kg) = pack8(ok); *(LAS u32x4*)(Qh + tau * HP + 8 * kg) = pack8(oh); }
        }
        LBAR();
        u32x2 pv_[2], gz[2];
        if (MODE == 2) {
#pragma unroll
            for (int tt = 0; tt < 2; ++tt) { const int tI = 16 * tt + l15, s2 = 32 * i + tI, t2 = dir ? tok0 + 255 - s2 : tok0 + s2;
                pv_[tt] = *(const u32x2*)(A.mix + (unsigned)((row0 + t2) * DM + h * 64 + 16 * vt + 4 * l4));
                gz[tt] = *(const u32x2*)(A.uhg + (unsigned)((row0 + t2) * 1280 + 1024 + h * 64 + 16 * vt + 4 * l4)); }
        }
        if (MODE != 0) {
            {
                const int tt = hw >> 1, st = hw & 1;
                f32x4 acc = (f32x4){0.f, 0.f, 0.f, 0.f};
                if (st <= tt) {
                    const LAS bf16* pa = Qt + (16 * tt + l15) * HP + 8 * l4; const LAS bf16* pb = Kt + (16 * st + l15) * HP + 8 * l4;
                    acc = MFMA32(frag16(pa), frag16(pb), acc); acc = MFMA32(frag16(pa + 32), frag16(pb + 32), acc);
                }
#pragma unroll
                for (int r = 0; r < 4; ++r) { const int tI = 16 * tt + 4 * l4 + r, sI = 16 * st + l15; Pm[tI * PP + sI] = (bf16)f2bf((st <= tt && sI <= tI) ? acc[r] : 0.f); }
            }
            LBAR();
            bf16x8 Sf[2];
#pragma unroll
            for (int m = 0; m < 2; ++m) Sf[m] = pack_acc2(S[2 * m], S[2 * m + 1]);
            const bf16x8 vf = frag16(VtT + (16 * vt + l15) * PP + 8 * l4);
            f32x4 oacc[2];
#pragma unroll
            for (int tt = 0; tt < 2; ++tt) {
                f32x4 acc = (f32x4){0.f, 0.f, 0.f, 0.f};
                acc = MFMA32(vf, frag16(Pm + (16 * tt + l15) * PP + 8 * l4), acc);
#pragma unroll
                for (int m = 0; m < 2; ++m) { const LAS bf16* pq = Qh + (16 * tt + l15) * HP + 32 * m + 4 * l4;
                    acc = MFMA32(Sf[m], frag2x8(pq, pq + 16), acc); }
                oacc[tt] = acc;
            }
            if (MODE == 1) {
#pragma unroll
                for (int tt = 0; tt < 2; ++tt) { const int tI = 16 * tt + l15, s2 = 32 * i + tI, t2 = dir ? tok0 + 255 - s2 : tok0 + s2;
                    u32x2 o; o.x = pk2(oacc[tt][0], oacc[tt][1]); o.y = pk2(oacc[tt][2], oacc[tt][3]);
                    *(u32x2*)(A.mix + (unsigned)((row0 + t2) * DM + h * 64 + 16 * vt + 4 * l4)) = o; }
            } else {
#pragma unroll
                for (int tt = 0; tt < 2; ++tt) { const int tI = 16 * tt + l15; const u32x2 pv = pv_[tt];
                    oacc[tt][0] += bflo(pv.x); oacc[tt][1] += bfhi(pv.x); oacc[tt][2] += bflo(pv.y); oacc[tt][3] += bfhi(pv.y);
                    float qq = (oacc[tt][0] * oacc[tt][0] + oacc[tt][1] * oacc[tt][1]) + (oacc[tt][2] * oacc[tt][2] + oacc[tt][3] * oacc[tt][3]);
                    qq += __shfl_xor(qq, 16); qq += __shfl_xor(qq, 32);
                    if (l4 == 0) SQ[vt * 32 + tI] = qq; }
                LBAR();
                const f32x4 ng = *(const f32x4*)(A.normg + h * 64 + 16 * vt + 4 * l4);
#pragma unroll
                for (int tt = 0; tt < 2; ++tt) { const int tI = 16 * tt + l15, s2 = 32 * i + tI, t2 = dir ? tok0 + 255 - s2 : tok0 + s2;
                    const float rs = 1.0f / sqrtf(((SQ[tI] + SQ[32 + tI]) + (SQ[64 + tI] + SQ[96 + tI])) * (1.0f / 64.0f) + EPS);
                    u32x2 o; o.x = pk2(oacc[tt][0] * rs * ng.x * siluf(bflo(gz[tt].x)), oacc[tt][1] * rs * ng.y * siluf(bfhi(gz[tt].x)));
                    o.y = pk2(oacc[tt][2] * rs * ng.z * siluf(bflo(gz[tt].y)), oacc[tt][3] * rs * ng.w * siluf(bfhi(gz[tt].y)));
                    *(u32x2*)(A.mix + (unsigned)((row0 + t2) * DM + h * 64 + 16 * vt + 4 * l4)) = o; }
            }
        }
        {
            const bf16x8 vf2 = frag16(VtT + (16 * vt + l15) * PP + 8 * l4);
#pragma unroll
            for (int kt = 0; kt < 4; ++kt) {
                f32x4 acc;
#pragma unroll
                for (int r = 0; r < 4; ++r) acc[r] = S[kt][r] * ebend[16 * kt + 4 * l4 + r];
                S[kt] = MFMA32(frag16(KhT + (16 * kt + l15) * PP + 8 * l4), vf2, acc);
            }
        }
        LBAR();
    }
#undef HG_ISSUE
    if (MODE == 0) {
#pragma unroll
        for (int kt = 0; kt < 4; ++kt) *(f32x4*)(slot + (size_t)(16 * vt + l15) * 64 + 16 * kt + 4 * l4) = S[kt];
        if (tau == 0) {
#pragma unroll
            for (int j = 0; j < 8; ++j) A.dth[((size_t)(((b * 2 + dir) * 33 + sc) * 4 + h)) * 64 + 8 * kg + j] = __expf(sumb[j]);
        }
    }
    __syncthreads();
}


constexpr int SP = 264;
__device__ __forceinline__ void hg_state_item(LAS unsigned char* lds, const HgArgs& A, int b, int sc, int h, int tid, int wave, int lane) {
    LAS bf16* KfT = (LAS bf16*)lds;
    LAS bf16* KbT = KfT + 64 * SP;
    LAS bf16* VtT = KbT + 64 * SP;
    const int row0 = sc == 32 ? MXR + b * LC : b * LX, tok0 = sc == 32 ? 0 : sc * 256;
    const int kg = wave, l15 = lane & 15, l4 = lane >> 4;
    u32x4 fa[4], fb[4], va[4];
#pragma unroll
    for (int e = 0; e < 4; ++e) { const bf16* up = A.uhg + (size_t)(row0 + tok0 + 4 * lane + e) * 1280 + h * 64 + 8 * kg;
        fa[e] = *(const u32x4*)(up + 256); fb[e] = *(const u32x4*)(up + 512); va[e] = *(const u32x4*)(up + 768); }
    float lbv[8];
#pragma unroll
    for (int j = 0; j < 8; ++j) { const int k = h * 64 + 8 * kg + j; lbv[j] = A.layer == 0 ? 0.f : sigmf(A.lb1[k] - A.lb0[k]); }
    __syncthreads();
#pragma unroll
    for (int dir = 0; dir < 2; ++dir) {
        float lf[4][8], kk[4][8];
#pragma unroll
        for (int e = 0; e < 4; ++e) { float f[8]; cv_unpack(dir ? fb[e] : fa[e], f);
#pragma unroll
            for (int j = 0; j < 8; ++j) { const float sg = sigmf(f[j]); kk[e][j] = (1.0f - lbv[j]) * (1.0f - sg);
                lf[e][j] = lbv[j] == 0.f ? fminf(f[j], 0.f) - __logf(1.0f + __expf(-fabsf(f[j]))) : __logf(lbv[j] + (1.0f - lbv[j]) * sg); } }
#pragma unroll
        for (int j = 0; j < 8; ++j) {
            const float tsum = (lf[0][j] + lf[1][j]) + (lf[2][j] + lf[3][j]);
            float x = tsum;
            if (!dir) {
#pragma unroll
                for (int off = 1; off < 64; off <<= 1) { const float y = __shfl_up(x, off); if (lane >= off) x += y; }
            } else {
#pragma unroll
                for (int off = 1; off < 64; off <<= 1) { const float y = __shfl_down(x, off); if (lane + off < 64) x += y; }
            }
            const float total = __shfl(x, dir ? 0 : 63);
            const float rest = total - x;
            float aft[4];
            if (!dir) { aft[3] = rest; aft[2] = aft[3] + lf[3][j]; aft[1] = aft[2] + lf[2][j]; aft[0] = aft[1] + lf[1][j]; }
            else { aft[0] = rest; aft[1] = aft[0] + lf[0][j]; aft[2] = aft[1] + lf[1][j]; aft[3] = aft[2] + lf[2][j]; }
            LAS bf16* d = (dir ? KbT : KfT) + (8 * kg + j) * SP + 4 * lane;
            u32x2 o; o.x = pk2(kk[0][j] * __expf(aft[0]), kk[1][j] * __expf(aft[1])); o.y = pk2(kk[2][j] * __expf(aft[2]), kk[3][j] * __expf(aft[3]));
            *(LAS u32x2*)d = o;
            if (lane == 0) A.dth[((size_t)(((b * 2 + dir) * 33 + sc) * 4 + h)) * 64 + 8 * kg + j] = __expf(total);
        }
    }
    {
        float v[4][8];
#pragma unroll
        for (int e = 0; e < 4; ++e) cv_unpack(va[e], v[e]);
#pragma unroll
        for (int j = 0; j < 8; ++j) { u32x2 o; o.x = pk2(v[0][j], v[1][j]); o.y = pk2(v[2][j], v[3][j]); *(LAS u32x2*)(VtT + (8 * kg + j) * SP + 4 * lane) = o; }
    }
    __syncthreads();
    const int kt = wave & 3, vt0 = 2 * (wave >> 2);
#pragma unroll
    for (int dir = 0; dir < 2; ++dir) {
        f32x4 S0 = (f32x4){0.f, 0.f, 0.f, 0.f}, S1 = S0;
        const LAS bf16* pa = (dir ? KbT : KfT) + (16 * kt + l15) * SP + 8 * l4;
        const LAS bf16* pb0 = VtT + (16 * vt0 + l15) * SP + 8 * l4; const LAS bf16* pb1 = pb0 + 16 * SP;
#pragma unroll
        for (int kk8 = 0; kk8 < 8; ++kk8) { const bf16x8 af = frag16(pa + 32 * kk8); S0 = MFMA32(af, frag16(pb0 + 32 * kk8), S0); S1 = MFMA32(af, frag16(pb1 + 32 * kk8), S1); }
        float* slot = A.hst + ((size_t)(((b * 2 + dir) * 33 + sc) * 4 + h)) * 4096;
        *(f32x4*)(slot + (size_t)(16 * vt0 + l15) * 64 + 16 * kt + 4 * l4) = S0;
        *(f32x4*)(slot + (size_t)(16 * (vt0 + 1) + l15) * 64 + 16 * kt + 4 * l4) = S1;
    }
}
__device__ __forceinline__ void state_scan(float* sst, const float* dts, float* hst, const float* dth, int gid) {
    if (gid < 65536) {
        const int bd = gid >> 14, e = gid & 16383, h = e >> 11, dir = bd & 1;
        float* base = sst + ((size_t)(bd * 33) * 8 + h) * 8192 + (size_t)(e & 2047) * 4;
        f32x4 carry = *(const f32x4*)(base + (size_t)32 * 8 * 8192);
        float* p = base + (size_t)(dir ? 31 : 0) * 8 * 8192; const long pstep = dir ? -(long)(8 * 8192) : (long)(8 * 8192);
        const float* dp = dts + (bd * 33 + (dir ? 31 : 0)) * 8 + h; const int dstep = dir ? -8 : 8;
#pragma unroll 4
        for (int jj = 0; jj < 32; ++jj) {
            const f32x4 loc = *(const f32x4*)p; *(f32x4*)p = carry;
            carry = carry * (*dp) + loc; p += pstep; dp += dstep; }
    } else if (gid < 65536 + 16384) {
        const int g2 = gid - 65536, bd = g2 >> 12, e = g2 & 4095, h = e >> 10, dir = bd & 1, k0 = (e & 15) * 4;
        float* base = hst + ((size_t)(bd * 33) * 4 + h) * 4096 + (size_t)(e & 1023) * 4;
        f32x4 carry = *(const f32x4*)(base + (size_t)32 * 4 * 4096);
        float* p = base + (size_t)(dir ? 31 : 0) * 4 * 4096; const long pstep = dir ? -(long)(4 * 4096) : (long)(4 * 4096);
        const float* dp = dth + ((size_t)((bd * 33 + (dir ? 31 : 0)) * 4 + h)) * 64 + k0; const int dstep = dir ? -256 : 256;
#pragma unroll 4
        for (int jj = 0; jj < 32; ++jj) {
            const f32x4 loc = *(const f32x4*)p; *(f32x4*)p = carry;
            const f32x4 d = *(const f32x4*)dp;
            carry = carry * d + loc; p += pstep; dp += dstep; }
    }
}

__device__ __forceinline__ void mf_hy_tile(LAS unsigned char* lds, const bf16* hyoT, bf16* mix, int tile, int tid) {
    LAS bf16* T = (LAS bf16*)lds;
    __syncthreads();
    { const int ch = tid >> 1, hf = tid & 1; const u32x4* src = (const u32x4*)(hyoT + (size_t)ch * MROWS + tile * 64 + hf * 32);
#pragma unroll
      for (int j = 0; j < 4; ++j) *(LAS u32x4*)(T + ch * 72 + hf * 32 + 8 * j) = src[j]; }
    __syncthreads();
    { const int tok = tid >> 3, cgp = tid & 7;
      bf16* dst = mix + (size_t)(tile * 64 + tok) * DM + 256 + cgp * 32;
#pragma unroll
      for (int j = 0; j < 4; ++j) { u32x4 o;
          unsigned w[4];
#pragma unroll
          for (int e = 0; e < 4; ++e) { const int c0 = cgp * 32 + 8 * j + 2 * e; w[e] = (unsigned)T[c0 * 72 + tok] | ((unsigned)T[(c0 + 1) * 72 + tok] << 16); }
          o.x = w[0]; o.y = w[1]; o.z = w[2]; o.w = w[3];
          *(u32x4*)(dst + 8 * j) = o; } }
    __syncthreads();
}
__device__ __forceinline__ void mf_ssd_rows(bf16* mix, const float* ssq, const float* ng, int row_first, int nrows, int gw, int ngw, int lane) {
    const f32x4 g0 = *(const f32x4*)(ng + 8 * lane), g1 = *(const f32x4*)(ng + 8 * lane + 4);
    const int grp = lane >> 5;
#pragma unroll 1
    for (int m = row_first + gw; m < row_first + nrows; m += ngw) {
        const f32x4 q = *(const f32x4*)(ssq + (size_t)m * 8 + 4 * grp);
        const float r = 1.0f / sqrtf(((q.x + q.y) + (q.z + q.w)) * (1.0f / 256.0f) + EPS);
        bf16* p = mix + (size_t)m * DM + 512 + 8 * lane;
        const u32x4 v = *(const u32x4*)p; u32x4 o;
        o.x = pk2(bflo(v.x) * r * g0.x, bfhi(v.x) * r * g0.y); o.y = pk2(bflo(v.y) * r * g0.z, bfhi(v.y) * r * g0.w);
        o.z = pk2(bflo(v.z) * r * g1.x, bfhi(v.z) * r * g1.y); o.w = pk2(bflo(v.w) * r * g1.z, bfhi(v.w) * r * g1.w);
        *(u32x4*)p = o;
    }
}
__device__ __forceinline__ void mf_ctx_rows(const bf16* mix, const float* ssq, const float* ng, int row_first, bf16* priv, int wave, int lane) {
    const f32x4 g0 = *(const f32x4*)(ng + 8 * lane), g1 = *(const f32x4*)(ng + 8 * lane + 4);
    const int grp = lane >> 5;
#pragma unroll 2
    for (int i = wave; i < 256; i += NWAVES) {
        const int m = row_first + i;
        const f32x4 q = *(const f32x4*)(ssq + (size_t)m * 8 + 4 * grp);
        const float r = 1.0f / sqrtf(((q.x + q.y) + (q.z + q.w)) * (1.0f / 256.0f) + EPS);
        const u32x4 lo = *(const u32x4*)(mix + (size_t)m * DM + 8 * lane);
        const u32x4 v = *(const u32x4*)(mix + (size_t)m * DM + 512 + 8 * lane); u32x4 o;
        o.x = pk2(bflo(v.x) * r * g0.x, bfhi(v.x) * r * g0.y); o.y = pk2(bflo(v.y) * r * g0.z, bfhi(v.y) * r * g0.w);
        o.z = pk2(bflo(v.z) * r * g1.x, bfhi(v.z) * r * g1.y); o.w = pk2(bflo(v.w) * r * g1.z, bfhi(v.w) * r * g1.w);
        *(u32x4*)(priv + (size_t)i * DM + 8 * lane) = lo;
        *(u32x4*)(priv + (size_t)i * DM + 512 + 8 * lane) = o;
    }
}
#ifndef MK_PER_PHASE
#define MK_PER_PHASE 0
#endif
#ifndef SPLITK_CTX
#define SPLITK_CTX 1
#endif
constexpr int PH_PER_LAYER = 13, NPHASES = 1 + 2 * PH_PER_LAYER + 1;
struct Args { const float* in[34]; float* out; unsigned char* ws; int ph_lo, ph_hi; };

__global__ void __launch_bounds__(NTHR, 2) hybrid_fwd(Args args) {
    extern __shared__ __attribute__((aligned(16))) unsigned char lds_raw[];
    LAS unsigned char* lds = (LAS unsigned char*)lds_raw;
    volatile LAS unsigned* MISC = (volatile LAS unsigned*)(lds + MISC_OFF);
    const int tid0 = threadIdx.x;
    const int G = gridDim.x, bid = blockIdx.x;
    const int ngw = G * NWAVES, ngt = G * NTHR;
    unsigned char* ws = args.ws;
    for (int u = tid0; u < 32; u += NTHR) MISC[u] = 0u;
    __syncthreads();
    XcdBarrier bar; bar.bar = (unsigned*)(ws + WS_CTL) + CW_BAR; bar.x = 0; bar.st = nullptr;
    if (!MK_PER_PHASE) bar = xcd_barrier_post((unsigned*)(ws + WS_CTL) + CW_BAR, MISC + 8);
    const int lo = args.ph_lo, hi = args.ph_hi;
#ifndef PHMASK
#define PHMASK 0xFFFF
#endif
#define ENA(b) (((PHMASK) >> (b)) & 1)
#ifndef SUBMASK
#define SUBMASK 0xFF
#endif
#define SUB(b) (((SUBMASK) >> (b)) & 1)
#define IN(k) (lo <= (k) && (k) < hi)
#ifndef TIME_MASK
#define TIME_MASK 0u
#endif
#ifndef TIME_MULT
#define TIME_MULT 8
#endif
#ifndef TIME_KIND
#define TIME_KIND 0
#endif
    unsigned long long tsum = 0ull, tbeg = 0ull;
#define SEAM(k) do { if (IN(k) && IN((k) + 1)) xcd_barrier(bar); if (TIME_MASK) { const unsigned long long tnow = __builtin_amdgcn_s_memrealtime(); if ((TIME_MASK >> (k)) & 1u) tsum += tnow - tbeg; tbeg = tnow; } } while (0)
#define NEXT_ITEM(qidx) ({ __syncthreads(); if (tid0 == 0) MISC[16] = __hip_atomic_fetch_add((unsigned*)(ws + WS_CTL) + 8192 + 64 * (qidx), 1u, __ATOMIC_RELAXED, __HIP_MEMORY_SCOPE_AGENT); __syncthreads(); (int)MISC[16]; })
#define FRESH_IDS() int tid_ = tid0; asm volatile("" : "+v"(tid_)); const int tid = tid_, lane = tid & 63, wave = __builtin_amdgcn_readfirstlane(tid >> 6); const int gw = bid * NWAVES + wave, gtid = bid * NTHR + tid; LAS float* wscr = (LAS float*)(lds + wave * 16384); (void)lane; (void)gw; (void)gtid; (void)wscr

    const float* x_in = args.in[0]; const float* c_in = args.in[1]; const float* ctx_in = args.in[2]; const float* cctx_in = args.in[3];
    const float* w_ada = args.in[4]; const float* b_ada = args.in[5]; const float* norm1_g = args.in[6]; const float* norm2_g = args.in[7];
    const float* w_in = args.in[8]; const float* w_out = args.in[9]; const float* hg_lb = args.in[10]; const float* hg_norm_g = args.in[11];
    const float* hy_conv_w = args.in[12]; const float* hy_conv_b = args.in[13]; const float* hy_w1 = args.in[14]; const float* hy_b1 = args.in[15]; const float* hy_f1 = args.in[16];
    const float* hy_w2 = args.in[17]; const float* hy_b2 = args.in[18]; const float* hy_f2 = args.in[19]; const float* hy_w3 = args.in[20]; const float* hy_bias = args.in[21];
    const float* ssd_conv_w = args.in[22]; const float* ssd_conv_b = args.in[23]; const float* ssd_dt_bias = args.in[24]; const float* ssd_a_log = args.in[25]; const float* ssd_d = args.in[26];
    const float* ssd_norm_g = args.in[27]; const float* ffn_w_gate = args.in[28]; const float* ffn_w_up = args.in[29]; const float* ffn_conv_w = args.in[30]; const float* ffn_conv_b = args.in[31];
    const float* ffn_w_down = args.in[32]; const float* final_norm_g = args.in[33];
    float* xs_out = args.out;
    float* mods = (float*)(ws + WS_MODS); float* ctxs = (float*)(ws + WS_CTXS); bf16* h2b = (bf16*)(ws + WS_H2); float* h2c = (float*)(ws + WS_H2C);
    float* ssq = (float*)(ws + WS_SSQ); float* dts = (float*)(ws + WS_DTS); float* dth = (float*)(ws + WS_DTH); float* udt = (float*)(ws + WS_UDT);
    bf16* Win = (bf16*)(ws + WS_WIN); bf16* Wout = (bf16*)(ws + WS_WOUT); bf16* hn = (bf16*)(ws + WS_HN); f32x2* Hs = (f32x2*)(ws + WS_HN);
    bf16* uhg = (bf16*)(ws + WS_UHG); bf16* uhyT = (bf16*)(ws + WS_UHY); bf16* uz = (bf16*)(ws + WS_UZ); bf16* uxs = (bf16*)(ws + WS_UXS); bf16* ubc = (bf16*)(ws + WS_UBC); bf16* axt = (bf16*)(ws + WS_AXT); bf16* abc = (bf16*)(ws + WS_ABC); bf16* abt = (bf16*)(ws + WS_ABT); float* sst = (float*)(ws + WS_SST); float* hst = (float*)(ws + WS_HST);
    float* slabO = (float*)(ws + WS_UHG); float* slabF = (float*)(ws + WS_A);
    bf16* mix = (bf16*)(ws + WS_MIX); bf16* fa = (bf16*)(ws + WS_A); bf16* fup = (bf16*)(ws + WS_UP); bf16* Wgu = (bf16*)(ws + WS_WGU); bf16* Wd = (bf16*)(ws + WS_WD);

    if (TIME_MASK) tbeg = __builtin_amdgcn_s_memrealtime();
    if (ENA(14) && IN(0)) {
        FRESH_IDS();
#pragma unroll 1
        for (int it = bid; it < 192; it += G) if (SUB(4)) p0_mods_item(c_in, cctx_in, w_ada, b_ada, mods, (LAS float*)lds, it, tid, wave, lane);
#pragma unroll 1
        for (int v = 0; v < 3; ++v) {
            const int hl = v == 1 ? 1 : 0;
            if (SUB(6)) p0_h2_rows(hy_w1 + hl * 33 * 64, hy_b1 + hl * 64, hy_f1 + hl * 64, hy_w2 + hl * 64 * 64, hy_b2 + hl * 64, hy_f2 + hl * 64, h2c, v == 2 ? (bf16*)nullptr : h2b + (size_t)hl * LX * 64, v == 2 ? LC : LX, gw, ngw, lane);
        }
        __syncthreads();
        if (SUB(7)) { convert_weight(w_in, 1024, NINP, 3600, Win, wscr, gw, ngw, lane);
        convert_weight(w_out, 1024, 1024, 1024, Wout, wscr, gw, ngw, lane); }
    }
    SEAM(0);

    for (int l = 0; l < 2; ++l) {
        const int P = 1 + l * PH_PER_LAYER;
        const float* mods_l = mods + (size_t)l * 3 * 6144;
        const int nrows = l == 0 ? MROWS : MXR;
        if (ENA(0) && IN(P + 0)) {
            FRESH_IDS();
            if (l == 1) { __syncthreads();
                convert_weight(w_in + (size_t)1024 * 3600, 1024, NINP, 3600, Win, wscr, gw, ngw, lane);
                convert_weight(w_out + (size_t)1024 * 1024, 1024, 1024, 1024, Wout, wscr, gw, ngw, lane); }
            if (SPLITK_CTX && l == 1) norm_rows(xs_out, ctxs, MROWS, norm1_g + l * DM, mods_l, 0, 1, hn, gw, ngw, lane, slabF, 11, mods + 2 * 6144 + 5 * 1024, ctxs);
            else norm_rows(l == 0 ? x_in : xs_out, l == 0 ? ctx_in : ctxs, MROWS, norm1_g + l * DM, mods_l, 0, 1, hn, gw, ngw, lane);
        }
        SEAM(P + 0);
        if (ENA(1) && IN(P + 1)) {
            FRESH_IDS();
            pg8::Gemm g{hn, Win, MROWS, NINP, DM, DM}; pg8::StaticOrder S; S.init(MROWS, NINP, G, bid);
            pg8::EpiInProj E{uhg, uhyT, uz, (long)((WS_UXS - WS_UZ) / 2), (long)((WS_UBC - WS_UZ) / 2), udt, MROWS};
            pg8::gemm_phase<pg8::EpiInProj, pg8::StaticOrder, true, true>(lds, g, S, E, tid);
        }
        SEAM(P + 1);
        SsdArgs SA{axt, abc, abt, uz, udt, ssd_dt_bias + l * 16, ssd_a_log + l * 16, ssd_d + l * 8, sst, dts, mix, ssq};
        HgArgs HA{uhg, hg_lb, hg_lb + 256, hg_norm_g + l * 256, l, hst, dth, mix};
        const float* hcw = hy_conv_w + (size_t)l * 3 * 768; const float* hcb = hy_conv_b + l * 768; const float* hbias = hy_bias + l * 512; const float* w3l = hy_w3 + (size_t)l * 64 * 1024;
        if (ENA(2) && IN(P + 2)) {
            FRESH_IDS();
            ssd_prepass(uxs, ubc, ssd_conv_w + (size_t)l * 3 * 1024, ssd_conv_b + l * 1024, axt, abc, abt, gw, ngw, lane);
        }
        SEAM(P + 2);
        if (ENA(3) && IN(P + 3)) {
            FRESH_IDS();
            const int n_spec = 256, n_hg = 2 * 33 * 4, n_hyc = l == 0 ? 256 : 0, n_ssd = 2 * 33 * 8, total = n_spec + n_hg + n_hyc + n_ssd;
#pragma unroll 1
            for (;;) {
                const int id = NEXT_ITEM(P + 3);
                if (id >= total) break;
                FRESH_IDS();
                if (id < n_spec) { if (SUB(0)) hy_spectrum_item(lds, h2b + (size_t)l * LX * 64, w3l, hbias, Hs, id, tid, wave, lane); }
                else if (id < n_spec + n_hg) { if (SUB(2)) { int r = id - n_spec; const int h = r & 3; r >>= 2; hg_state_item(lds, HA, r / 33, r % 33, h, tid, wave, lane); } }
                else if (id < n_spec + n_hg + n_hyc) { if (SUB(3)) hy_ctx_item(lds, uhyT, hcw, hcb, hbias, h2c, w3l, mix, id - n_spec - n_hg, tid, wave, lane); }
                else if (SUB(1)) { int r = id - n_spec - n_hg - n_hyc; const int h = r & 7; r >>= 3; ssd_state_item(lds, SA, r / 33, r % 33, h, tid, wave, lane); }
            }
        }
        SEAM(P + 3);
        if (ENA(4) && IN(P + 4)) {
            FRESH_IDS();
            state_scan(sst, dts, hst, dth, gtid);
            #pragma unroll 1
            for (int id = bid; id < 256; id += G) { FRESH_IDS(); hy_fft_item(lds, uhyT, hcw, hcb, Hs, uhyT, id, tid); }
        }
        SEAM(P + 4);
        const int nsc = l == 0 ? 33 : 32;
        if (ENA(5) && IN(P + 5)) {
            FRESH_IDS();
            const int n_ssd = 2 * nsc * 4, n_hg = 2 * nsc * 2;
#pragma unroll 1
            for (;;) {
                const int id = NEXT_ITEM(P + 5);
                if (id >= n_ssd + n_hg) break;
                FRESH_IDS();
                unsigned long long tk0 = 0ull; const int kind_ = id >= n_hg ? 6 : 5; if (TIME_KIND && l == 0 && kind_ == TIME_KIND) tk0 = __builtin_amdgcn_s_memrealtime();
                if (id >= n_hg) { if (SUB(1)) { int r = id - n_hg; const int hp = r & 3; r >>= 2; ssd_item<1>(lds, SA, r / nsc, r % nsc, hp, 0, tid, wave, lane); } }
                else if (SUB(2)) { int r = id; const int hp = r & 1; r >>= 1; hg_item<1>(lds, HA, r / nsc, r % nsc, hp, 0, tid, lane); }
                if (TIME_KIND && l == 0 && kind_ == TIME_KIND) tsum += __builtin_amdgcn_s_memrealtime() - tk0;
            }
        }
        SEAM(P + 5);
        if (ENA(6) && IN(P + 6)) {
            FRESH_IDS();
            const int n_ssd = 2 * nsc * 4, n_hg = 2 * nsc * 2;
#pragma unroll 1
            for (;;) {
                const int id = NEXT_ITEM(P + 6);
                if (id >= n_ssd + n_hg) break;
                FRESH_IDS();
                if (id >= n_hg) { if (SUB(1)) { int r = id - n_hg; const int hp = r & 3; r >>= 2; ssd_item<2>(lds, SA, r / nsc, r % nsc, hp, 1, tid, wave, lane); } }
                else if (SUB(2)) { int r = id; const int hp = r & 1; r >>= 1; hg_item<2>(lds, HA, r / nsc, r % nsc, hp, 1, tid, lane); }
            }
        }
        SEAM(P + 6);
#ifndef CTX_ASIDE
#define CTX_ASIDE 0
#endif
        const bool ctx_cu = CTX_ASIDE && (l == 0) && bid < 8;
        const int xb = (CTX_ASIDE && l == 0) ? bid - 8 : bid, xG = (CTX_ASIDE && l == 0) ? G - 8 : G;
        const int nrows3 = (CTX_ASIDE || SPLITK_CTX) ? MXR : nrows;
        const int nrows2 = CTX_ASIDE ? MXR : nrows;
        if (ENA(7) && IN(P + 7)) {
            FRESH_IDS();
            if (ctx_cu) {
                bf16* priv = hn + (size_t)bid * 256 * DM;
                mf_ctx_rows(mix, ssq, ssd_norm_g + l * 512, MXR + 256 * (bid >> 2), priv, wave, lane);
                asm volatile("s_waitcnt vmcnt(0)" ::: "memory"); __syncthreads();
                if (tid == 0) { __builtin_amdgcn_fence(__ATOMIC_ACQUIRE, "agent"); asm volatile("s_waitcnt vmcnt(0)" ::: "memory"); }
                __syncthreads();
                pg8::Gemm g{priv - (size_t)(64 + (bid >> 2)) * 256 * DM, Wout, MROWS, DM, DM, DM}; pg8::CtxOrder S{bid};
                pg8::EpiResid E{x_in, xs_out, ctxs, ctx_in, mods_l + 2 * 1024, 6144, mods_l + 2 * 6144 + 2 * 1024};
                pg8::gemm_phase<pg8::EpiResid, pg8::CtxOrder, false, true>(lds, g, S, E, tid);
            } else {
#pragma unroll 1
                for (int id = xb; id < 256; id += xG) { FRESH_IDS(); mf_hy_tile(lds, uhyT, mix, id, tid); }
                mf_ssd_rows(mix, ssq, ssd_norm_g + l * 512, 0, nrows2, xb * NWAVES + wave, xG * NWAVES, lane);
            }
        }
        SEAM(P + 7);
        if (ENA(8) && IN(P + 8)) {
            FRESH_IDS();
            pg8::Gemm g{mix, Wout, nrows3, DM, DM, DM}; pg8::StaticOrder S; S.init(nrows3, DM, G, bid);
            pg8::EpiResid E{l == 0 ? x_in : xs_out, xs_out, ctxs, l == 0 ? ctx_in : ctxs, mods_l + 2 * 1024, 6144, mods_l + 2 * 6144 + 2 * 1024};
            pg8::gemm_phase<pg8::EpiResid, pg8::StaticOrder, true, true>(lds, g, S, E, tid);
            if (SPLITK_CTX && l == 0) {
                pg8::Gemm g2{mix, Wout, MROWS, DM, 128, DM}; pg8::SplitOrder S2{bid, 8, 128}; pg8::EpiSlab E2{slabO, 8};
                pg8::gemm_phase<pg8::EpiSlab, pg8::SplitOrder, false, true>(lds, g2, S2, E2, tid);
            }
        }
        SEAM(P + 8);
        if (ENA(9) && IN(P + 9)) {
            FRESH_IDS();
            __syncthreads();
            convert_weight(ffn_w_gate + (size_t)l * 1024 * DFF, 1024, DFF, DFF, Wgu, wscr, gw, ngw, lane);
            convert_weight(ffn_w_up + (size_t)l * 1024 * DFF, 1024, DFF, DFF, Wgu + (size_t)DFF * 1024, wscr, gw, ngw, lane);
            convert_weight(ffn_w_down + (size_t)l * DFF * 1024, DFF, 1024, 1024, Wd, wscr, gw, ngw, lane);
            if (SPLITK_CTX && l == 0) norm_rows(xs_out, ctx_in, nrows, norm2_g + l * DM, mods_l, 3, 4, hn, gw, ngw, lane, slabO, 8, mods_l + 2 * 6144 + 2 * 1024, ctxs);
            else norm_rows(xs_out, ctxs, nrows, norm2_g + l * DM, mods_l, 3, 4, hn, gw, ngw, lane);
        }
        SEAM(P + 9);
        if (ENA(10) && IN(P + 10)) {
            FRESH_IDS();
            pg8::Gemm g{hn, Wgu, nrows, 2 * DFF, DM, DM}; pg8::StaticOrder S; S.init(nrows, 2 * DFF, G, bid);
            pg8::EpiGateUp E{fa, fup};
            pg8::gemm_phase<pg8::EpiGateUp, pg8::StaticOrder, true, true>(lds, g, S, E, tid);
        }
        SEAM(P + 10);
        if (ENA(11) && IN(P + 11)) {
            FRESH_IDS();
            if (ctx_cu) {
                bf16* priv = hn + (size_t)bid * 256 * DFF;
                ffn_conv_phase(fa, fup, ffn_conv_w + (size_t)l * 9 * DFF, ffn_conv_b + l * DFF, MXR + 256 * (bid >> 2), 256, tid, NTHR, priv, -(long)(MXR + 256 * (bid >> 2)));
                asm volatile("s_waitcnt vmcnt(0)" ::: "memory"); __syncthreads();
                if (tid == 0) { __builtin_amdgcn_fence(__ATOMIC_ACQUIRE, "agent"); asm volatile("s_waitcnt vmcnt(0)" ::: "memory"); }
                __syncthreads();
                pg8::Gemm g{priv - (size_t)(64 + (bid >> 2)) * 256 * DFF, Wd, MROWS, DM, DFF, DFF}; pg8::CtxOrder S{bid};
                pg8::EpiResid E{xs_out, xs_out, ctxs, ctxs, mods_l + 5 * 1024, 6144, mods_l + 2 * 6144 + 5 * 1024};
                pg8::gemm_phase<pg8::EpiResid, pg8::CtxOrder, false, true>(lds, g, S, E, tid);
            } else ffn_conv_phase(fa, fup, ffn_conv_w + (size_t)l * 9 * DFF, ffn_conv_b + l * DFF, 0, nrows2, xb * NTHR + tid, xG * NTHR, fup, 0);
        }
        SEAM(P + 11);
        if (ENA(12) && IN(P + 12)) {
            FRESH_IDS();
            pg8::Gemm g{fup, Wd, nrows3, DM, DFF, DFF}; pg8::StaticOrder S; S.init(nrows3, DM, G, bid);
            pg8::EpiResid E{xs_out, xs_out, ctxs, ctxs, mods_l + 5 * 1024, 6144, mods_l + 2 * 6144 + 5 * 1024};
            pg8::gemm_phase<pg8::EpiResid, pg8::StaticOrder, true, true>(lds, g, S, E, tid);
            if (SPLITK_CTX && l == 0) {
                pg8::Gemm g2{fup, Wd, MROWS, DM, 256, DFF}; pg8::SplitOrder S2{bid, 11, 256}; pg8::EpiSlab E2{slabF, 11};
                pg8::gemm_phase<pg8::EpiSlab, pg8::SplitOrder, false, true>(lds, g2, S2, E2, tid);
            }
        }
        SEAM(P + 12);
    }
    if (ENA(15) && IN(NPHASES - 1)) { FRESH_IDS(); final_norm_rows(xs_out, final_norm_g, gw, ngw, lane); }
    if (TIME_MASK || TIME_KIND) { const unsigned long long tnow = __builtin_amdgcn_s_memrealtime(); if ((TIME_MASK >> (NPHASES - 1)) & 1u) tsum += tnow - tbeg;
        if (bid == 0 && tid0 == 0) { while (__builtin_amdgcn_s_memrealtime() - tnow < (unsigned long long)TIME_MULT * tsum) __builtin_amdgcn_s_sleep(32); } }
#undef IN
#undef SEAM
}

extern "C" void kernel_launch(void* const* d_in, const int* in_sizes, int n_in, void* d_out, int out_size, void* d_ws, size_t ws_size, hipStream_t stream) {
    static int grid = 0;
    if (grid == 0) {
        if (n_in != 34 || out_size != MXR * DM || ws_size < WS_END) { fprintf(stderr, "kernel_launch: unexpected shapes (n_in %d out %d ws %zu)\n", n_in, out_size, ws_size); grid = -1; return; }
        int dev = 0, cus = 0, per_cu = 0;
        if (hipGetDevice(&dev) != hipSuccess || hipDeviceGetAttribute(&cus, hipDeviceAttributeMultiprocessorCount, dev) != hipSuccess) { grid = -1; return; }
        if (hipFuncSetAttribute((const void*)hybrid_fwd, hipFuncAttributeMaxDynamicSharedMemorySize, LDS_BYTES) != hipSuccess) { fprintf(stderr, "kernel_launch: hipFuncSetAttribute failed\n"); grid = -1; return; }
        if (hipOccupancyMaxActiveBlocksPerMultiprocessor(&per_cu, (const void*)hybrid_fwd, NTHR, LDS_BYTES) != hipSuccess || per_cu < 1)
            fprintf(stderr, "kernel_launch: note: occupancy query reports %d workgroups per CU\n", per_cu);
        (void)hipGetLastError();
        grid = cus;
    }
    if (grid < 0) return;
    if (hipMemsetAsync((char*)d_ws + WS_CTL, 0, CTL_ZERO_BYTES, stream) != hipSuccess) { fprintf(stderr, "kernel_launch: memset failed\n"); return; }
    Args a{};
    for (int i = 0; i < 34; ++i) a.in[i] = (const float*)d_in[i];
    a.out = (float*)d_out; a.ws = (unsigned char*)d_ws;
#if MK_PER_PHASE
    for (int p = 0; p < NPHASES; ++p) { a.ph_lo = p; a.ph_hi = p + 1; hipLaunchKernelGGL(hybrid_fwd, dim3(grid), dim3(NTHR), LDS_BYTES, stream, a); }
#else
    a.ph_lo = 0; a.ph_hi = NPHASES;
    hipLaunchKernelGGL(hybrid_fwd, dim3(grid), dim3(NTHR), LDS_BYTES, stream, a);
#endif
    const hipError_t le = hipPeekAtLastError();
    if (le != hipSuccess) fprintf(stderr, "kernel_launch: launch failed: %s\n", hipGetErrorName(le));
}
```

```cpp
#include <hip/hip_runtime.h>
#include <cstdio>
#include <cstdint>
namespace pg8 {
#define PG8_LAS __attribute__((address_space(3)))
typedef unsigned short bf16_t;
typedef short bf16x8 __attribute__((ext_vector_type(8)));
typedef float f32x4 __attribute__((ext_vector_type(4)));
typedef unsigned u32x4 __attribute__((ext_vector_type(4)));
constexpr int BM = 256, BK = 64, HALF = 128, HTB = HALF * BK * 2  , STAGE_BYTES = 8 * HTB, NXCD = 8, WGM = 8;

__host__ __device__ __forceinline__ int lds_byte(int r, int c) { const int st = (r >> 4) * 2 + (c >> 5), rr = r & 15, cc = c & 31, ob = rr * 64 + cc * 2; return st * 1024 + (ob ^ (((ob >> 9) & 1) << 5)); }
__host__ __device__ __forceinline__ void stage_rc(int b, int& R, int& C) { const int st = b / 1024, sb = b % 1024, swz = sb ^ (((sb >> 9) & 1) << 5); R = (st >> 1) * 16 + swz / 64; C = (st & 1) * 32 + (swz % 64) / 2; }
__host__ __device__ __forceinline__ int perm32(int rho) { const int n = rho >> 4, i = rho & 15; return 8 * (i >> 2) + 4 * n + (i & 3); }

struct Unit { int pm, pn, koff, ks; };
struct Gemm { const bf16_t* A; const bf16_t* Bt; int M, N, K, ld; };

struct StaticOrder {
    int nM, nN, nwg, G, c;
    __host__ __device__ void init(int M, int N, int G_, int c_) { nM = M / BM; nN = N / BM; nwg = nM * nN; G = G_; c = c_; }
    __host__ __device__ bool next(int i, Unit& u) const {
        const long L = (long)i * G + c; if (L >= nwg) return false;
        int wgid = (int)L; { const int q = nwg / NXCD, r = nwg % NXCD, xcd = wgid % NXCD, off = wgid / NXCD; wgid = (xcd < r ? xcd * (q + 1) : r * (q + 1) + (xcd - r) * q) + off; }
        const int nig = WGM * nN, gid = wgid / nig, fm = gid * WGM, gsz = (nM - fm) < WGM ? (nM - fm) : WGM;
        u.pm = fm + ((wgid % nig) % gsz); u.pn = (wgid % nig) / gsz; u.koff = 0; u.ks = 0; return true;
    }
    __device__ __forceinline__ void a_ready(const Unit&) const {}
    __device__ __forceinline__ void done(const Unit&) const {}
};

__device__ __forceinline__ unsigned cvt_pk_bf16(float lo, float hi) { unsigned r; asm volatile("v_cvt_pk_bf16_f32 %0, %1, %2" : "=v"(r) : "v"(lo), "v"(hi)); return r; }
typedef float f32x2 __attribute__((ext_vector_type(2)));

struct EpiInProj {
    static constexpr bool PERM = true, AFTER_DRAIN = false;
    bf16_t* uhg; bf16_t* uhyT; bf16_t* uz; long off_xs, off_bc; float* udt; int mrows;
    __device__ __forceinline__ void operator()(const f32x4 (&acc)[2][2][4][2], const Unit& u, int wr, int wc, int fr, int fq) const {
        const int row0 = u.pm * BM + wr * 64 + fr;
        const int colt = u.pn * BM + wc * 32 + 8 * fq;
#pragma unroll
        for (int ai = 0; ai < 2; ++ai)
#pragma unroll
            for (int m = 0; m < 4; ++m) {
                const int r = row0 + ai * HALF + m * 16;
#pragma unroll
                for (int bj = 0; bj < 2; ++bj) {
                    const f32x4 v0 = acc[ai][bj][m][0], v1 = acc[ai][bj][m][1];
                    const int c = colt + bj * HALF;
                    if (u.pn < 5) {
                        u32x4 w; w.x = cvt_pk_bf16(v0[0], v0[1]); w.y = cvt_pk_bf16(v0[2], v0[3]); w.z = cvt_pk_bf16(v1[0], v1[1]); w.w = cvt_pk_bf16(v1[2], v1[3]);
                        *(u32x4*)(uhg + (size_t)r * 1280 + c) = w;
                    } else if (u.pn < 8) {
                        const int cc = c - 1280;
                        const unsigned w0 = cvt_pk_bf16(v0[0], v0[1]), w1 = cvt_pk_bf16(v0[2], v0[3]), w2 = cvt_pk_bf16(v1[0], v1[1]), w3 = cvt_pk_bf16(v1[2], v1[3]);
                        bf16_t* d = uhyT + (size_t)cc * mrows + r;
                        d[0] = (bf16_t)(w0 & 0xffffu); d[(size_t)mrows] = (bf16_t)(w0 >> 16); d[(size_t)2 * mrows] = (bf16_t)(w1 & 0xffffu); d[(size_t)3 * mrows] = (bf16_t)(w1 >> 16);
                        d[(size_t)4 * mrows] = (bf16_t)(w2 & 0xffffu); d[(size_t)5 * mrows] = (bf16_t)(w2 >> 16); d[(size_t)6 * mrows] = (bf16_t)(w3 & 0xffffu); d[(size_t)7 * mrows] = (bf16_t)(w3 >> 16);
                    } else {
                        const int cc = c - 2048;
                        if (cc < 1536) {
                            u32x4 w; w.x = cvt_pk_bf16(v0[0], v0[1]); w.y = cvt_pk_bf16(v0[2], v0[3]); w.z = cvt_pk_bf16(v1[0], v1[1]); w.w = cvt_pk_bf16(v1[2], v1[3]);
                            bf16_t* dst = uz + (u.pn >= 10 ? off_xs : 0) + (u.pn >= 12 ? off_bc - off_xs : 0);
                            *(u32x4*)(dst + (size_t)r * 512 + (cc & 511)) = w;
                        } else if (cc < 1552) {
                            float* d = udt + (size_t)r * 16 + (cc - 1536);
                            *(f32x4*)d = v0; *(f32x4*)(d + 4) = v1;
                        }
                    }
                }
            }
    }
};
struct EpiGateUp {
    static constexpr bool PERM = true, AFTER_DRAIN = false;
    bf16_t* a; bf16_t* up;
    __device__ __forceinline__ void operator()(const f32x4 (&acc)[2][2][4][2], const Unit& u, int wr, int wc, int fr, int fq) const {
        const int row0 = u.pm * BM + wr * 64 + fr;
        int colt = u.pn * BM; bf16_t* base = a; if (u.pn >= 11) { base = up; colt -= 2816; }
        colt += wc * 32 + 8 * fq;
#pragma unroll
        for (int ai = 0; ai < 2; ++ai)
#pragma unroll
            for (int m = 0; m < 4; ++m) { bf16_t* rowp = base + (size_t)(row0 + ai * HALF + m * 16) * 2816 + colt;
#pragma unroll
                for (int bj = 0; bj < 2; ++bj) { const f32x4 v0 = acc[ai][bj][m][0], v1 = acc[ai][bj][m][1];
                    u32x4 w; w.x = cvt_pk_bf16(v0[0], v0[1]); w.y = cvt_pk_bf16(v0[2], v0[3]); w.z = cvt_pk_bf16(v1[0], v1[1]); w.w = cvt_pk_bf16(v1[2], v1[3]);
                    *(u32x4*)(rowp + bj * HALF) = w; } }
    }
};
struct EpiResid {
    static constexpr bool PERM = false, AFTER_DRAIN = false;
    const float* xbase; float* xout; float* cstream; const float* cbase; const float* gate_x; int gate_bstride; const float* gate_c;
    __device__ __forceinline__ void operator()(const f32x4 (&acc)[2][2][4][2], const Unit& u, int wr, int wc, int fr, int fq) const {
        const int row0 = u.pm * BM + wr * 64 + fr;
        const int col0 = u.pn * BM + wc * 32 + 4 * fq;
        const bool isctx = u.pm >= 64;
#pragma unroll
        for (int bj = 0; bj < 2; ++bj)
#pragma unroll
            for (int n = 0; n < 2; ++n) {
                const int c = col0 + bj * HALF + n * 16;
#pragma unroll
                for (int ai = 0; ai < 2; ++ai)
#pragma unroll
                    for (int m = 0; m < 4; ++m) {
                        const int r = row0 + ai * HALF + m * 16;
                        if (!isctx) {
                            const f32x4 g = *(const f32x4*)(gate_x + (size_t)(r >> 13) * gate_bstride + c);
                            const f32x4 b = *(const f32x4*)(xbase + (size_t)r * 1024 + c);
                            *(f32x4*)(xout + (size_t)r * 1024 + c) = b + g * acc[ai][bj][m][n];
                        } else {
                            const f32x4 g = *(const f32x4*)(gate_c + c);
                            const f32x4 b = *(const f32x4*)(cbase + (size_t)(r - 16384) * 1024 + c);
                            *(f32x4*)(cstream + (size_t)(r - 16384) * 1024 + c) = b + g * acc[ai][bj][m][n];
                        }
                    }
            }
    }
};
struct CtxOrder {
    int c;
    __host__ __device__ bool next(int i, Unit& u) const { if (i != 0 || c >= 8) return false; u.pm = 64 + (c >> 2); u.pn = c & 3; u.koff = 0; u.ks = 0; return true; }
    __device__ __forceinline__ void a_ready(const Unit&) const {}
    __device__ __forceinline__ void done(const Unit&) const {}
};
struct SplitOrder {
    int c, nsplit, kc;
    __host__ __device__ bool next(int i, Unit& u) const { if (i != 0 || c >= 8 * nsplit) return false; const int t = c / nsplit; u.pm = 64 + (t >> 2); u.pn = t & 3; u.ks = c % nsplit; u.koff = u.ks * kc * 2; return true; }
    __device__ __forceinline__ void a_ready(const Unit&) const {}
    __device__ __forceinline__ void done(const Unit&) const {}
};
struct EpiSlab {
    static constexpr bool PERM = false, AFTER_DRAIN = false;
    float* slab; int nsplit;
    __device__ __forceinline__ void operator()(const f32x4 (&acc)[2][2][4][2], const Unit& u, int wr, int wc, int fr, int fq) const {
        float* base = slab + (size_t)((((u.pm - 64) * 4 + u.pn) * nsplit + u.ks)) * 65536;
        const int row0 = wr * 64 + fr, col0 = wc * 32 + 4 * fq;
#pragma unroll
        for (int bj = 0; bj < 2; ++bj)
#pragma unroll
            for (int n = 0; n < 2; ++n)
#pragma unroll
                for (int ai = 0; ai < 2; ++ai)
#pragma unroll
                    for (int m = 0; m < 4; ++m) *(f32x4*)(base + (size_t)(row0 + ai * HALF + m * 16) * 256 + col0 + bj * HALF + n * 16) = acc[ai][bj][m][n];
    }
};
template <class Epi, class Sched, bool ALIGN_EPI = false, bool SP2 = false>
__device__ __forceinline__ void gemm_phase(PG8_LAS unsigned char* lds, const Gemm g, const Sched& S, const Epi& E, const int tid) {
    const int wid = __builtin_amdgcn_readfirstlane(tid >> 6), lane = tid & 63, wr = wid >> 2, wc = wid & 3, fr = lane & 15, fq = lane >> 4;
    const int K = g.K, nt = K / BK, ld = g.ld;
    unsigned voffA[2], voffB[2];
#pragma unroll
    for (int i = 0; i < 2; ++i) { int R, C; stage_rc(tid * 16 + i * 8192, R, C); const int Rb = Epi::PERM ? ((R & ~31) + perm32(R & 31)) : R;
        voffA[i] = (unsigned)(R * ld + C) * 2u; voffB[i] = (unsigned)(Rb * ld + C) * 2u; }
    const size_t kstep = (size_t)(BK * 2);
    const size_t hstep = (size_t)HALF * ld * 2;
    const size_t tstep = 2 * hstep;
    const unsigned ldsw = (unsigned)wid * 1024u;
    const int aoff = lds_byte(wr * 64 + fr, fq * 8), boff = lds_byte(wc * 32 + fr, fq * 8);
#define PG8_SA(b, h) (((b) * 2 + (h)) * HTB)
#define PG8_SB(b, h) ((4 + (b) * 2 + (h)) * HTB)
#define PG8_STAGE(bufoff, gbase, voff) do { _Pragma("unroll") for (int _i = 0; _i < 2; ++_i) \
        __builtin_amdgcn_global_load_lds((const unsigned*)((const char*)(gbase) + (voff)[_i]), (PG8_LAS unsigned*)(lds + (bufoff) + ldsw + _i * 8192), 16, 0, 0); } while (0)
#define PG8_LDA(dst, b, h) do { _Pragma("unroll") for (int m = 0; m < 4; ++m) _Pragma("unroll") for (int k = 0; k < 2; ++k) dst[m][k] = *(const PG8_LAS bf16x8*)(lds + PG8_SA(b, h) + aoff + m * 2048 + k * 1024); } while (0)
#define PG8_LDB(dst, b, h) do { _Pragma("unroll") for (int n = 0; n < 2; ++n) _Pragma("unroll") for (int k = 0; k < 2; ++k) dst[n][k] = *(const PG8_LAS bf16x8*)(lds + PG8_SB(b, h) + boff + n * 2048 + k * 1024); } while (0)
#define PG8_MMA(ai, bj, At, Bt) do { __builtin_amdgcn_s_setprio(1); _Pragma("unroll") for (int m = 0; m < 4; ++m) _Pragma("unroll") for (int n = 0; n < 2; ++n) _Pragma("unroll") for (int k = 0; k < 2; ++k) \
        acc[ai][bj][m][n] = __builtin_amdgcn_mfma_f32_16x16x32_bf16(Bt[n][k], At[m][k], acc[ai][bj][m][n], 0, 0, 0); __builtin_amdgcn_s_setprio(0); } while (0)
#define PG8_WAIT_V(n) asm volatile("s_waitcnt vmcnt(" #n ")" ::: "memory")
#define PG8_WAIT_L(n) asm volatile("s_waitcnt lgkmcnt(" #n ")" ::: "memory")
#define PG8_BAR __builtin_amdgcn_s_barrier()
#define PG8_SCHED __builtin_amdgcn_sched_barrier(0)
    Unit cur, nxt; int ui = 0;
    if (!S.next(0, cur)) return;
    f32x4 acc[2][2][4][2];
#pragma unroll
    for (int a = 0; a < 2; ++a)
#pragma unroll
        for (int b = 0; b < 2; ++b)
#pragma unroll
            for (int m = 0; m < 4; ++m)
#pragma unroll
                for (int n = 0; n < 2; ++n) acc[a][b][m][n] = (f32x4){0.f, 0.f, 0.f, 0.f};
    bf16x8 At[4][2], B0[2][2], B1[2][2];
    const char* cA = (const char*)g.A + (size_t)cur.pm * tstep + cur.koff; const char* cB = (const char*)g.Bt + (size_t)cur.pn * tstep + cur.koff;
    S.a_ready(cur);
    if constexpr (SP2) {
        PG8_STAGE(PG8_SB(0, 0), cB, voffB); PG8_STAGE(PG8_SB(0, 1), cB + hstep, voffB); PG8_STAGE(PG8_SA(0, 0), cA, voffA); PG8_STAGE(PG8_SA(0, 1), cA + hstep, voffA);
        if (wr == 1) PG8_BAR;
        PG8_WAIT_V(2); PG8_BAR;
        PG8_STAGE(PG8_SB(1, 0), cB + kstep, voffB); PG8_STAGE(PG8_SA(1, 0), cA + kstep, voffA); PG8_STAGE(PG8_SB(1, 1), cB + hstep + kstep, voffB);
        PG8_WAIT_V(6); PG8_BAR;
    } else {
        PG8_STAGE(PG8_SB(0, 0), cB, voffB); PG8_STAGE(PG8_SA(0, 0), cA, voffA); PG8_STAGE(PG8_SB(0, 1), cB + hstep, voffB); PG8_STAGE(PG8_SA(0, 1), cA + hstep, voffA);
        if (wr == 1) PG8_BAR;
        PG8_WAIT_V(4); PG8_BAR;
        PG8_STAGE(PG8_SB(1, 0), cB + kstep, voffB); PG8_STAGE(PG8_SA(1, 0), cA + kstep, voffA); PG8_STAGE(PG8_SB(1, 1), cB + hstep + kstep, voffB);
        PG8_WAIT_V(6); PG8_BAR;
    }
    for (;;) {
        const bool has_next = S.next(ui + 1, nxt);
        const char* nA = has_next ? (const char*)g.A + (size_t)nxt.pm * tstep + nxt.koff : cA; const char* nB = has_next ? (const char*)g.Bt + (size_t)nxt.pn * tstep + nxt.koff : cB;
        for (int t = 0; t < nt; t += 2) {
            const bool last = (t == nt - 2);
            const char* a1 = cA + (size_t)(t + 1) * kstep;
            const char* a2 = last ? nA : cA + (size_t)(t + 2) * kstep; const char* b2 = last ? nB : cB + (size_t)(t + 2) * kstep;
            const char* a3 = a2 + kstep; const char* b3 = b2 + kstep;
            if (last && has_next) S.a_ready(nxt);
            if constexpr (SP2) {
            PG8_LDB(B0, 0, 0); PG8_LDB(B1, 0, 1); PG8_SCHED; PG8_LDA(At, 0, 0); PG8_STAGE(PG8_SA(1, 1), a1 + hstep, voffA);
            PG8_WAIT_V(8); PG8_WAIT_L(0); PG8_BAR; PG8_MMA(0, 0, At, B0); PG8_MMA(0, 1, At, B1); PG8_BAR; PG8_SCHED;
            PG8_LDA(At, 0, 1); PG8_STAGE(PG8_SB(0, 0), b2, voffB); PG8_STAGE(PG8_SB(0, 1), b2 + hstep, voffB); PG8_STAGE(PG8_SA(0, 0), a2, voffA);
            PG8_WAIT_V(8); PG8_WAIT_L(0); PG8_BAR; PG8_MMA(1, 0, At, B0); PG8_MMA(1, 1, At, B1); PG8_BAR; PG8_SCHED;
            PG8_LDB(B0, 1, 0); PG8_LDB(B1, 1, 1); PG8_SCHED; PG8_LDA(At, 1, 0); PG8_STAGE(PG8_SA(0, 1), a2 + hstep, voffA);
            PG8_WAIT_V(8); PG8_WAIT_L(0); PG8_BAR; PG8_MMA(0, 0, At, B0); PG8_MMA(0, 1, At, B1); PG8_BAR; PG8_SCHED;
            PG8_LDA(At, 1, 1); PG8_STAGE(PG8_SB(1, 0), b3, voffB); PG8_STAGE(PG8_SB(1, 1), b3 + hstep, voffB); PG8_STAGE(PG8_SA(1, 0), a3, voffA);
            PG8_WAIT_V(8); PG8_WAIT_L(0); PG8_BAR; PG8_MMA(1, 0, At, B0); PG8_MMA(1, 1, At, B1); PG8_BAR; PG8_SCHED;
            } else {
            PG8_LDB(B0, 0, 0); PG8_SCHED; PG8_LDA(At, 0, 0); PG8_STAGE(PG8_SA(1, 1), a1 + hstep, voffA);
            PG8_WAIT_L(8); PG8_BAR; PG8_WAIT_L(0); PG8_MMA(0, 0, At, B0); PG8_BAR; PG8_SCHED;
            PG8_LDB(B1, 0, 1); PG8_STAGE(PG8_SB(0, 0), b2, voffB);
            PG8_BAR; PG8_WAIT_L(0); PG8_MMA(0, 1, At, B1); PG8_BAR;
            PG8_LDA(At, 0, 1); PG8_STAGE(PG8_SA(0, 0), a2, voffA);
            PG8_BAR; PG8_WAIT_L(0); PG8_MMA(1, 0, At, B0); PG8_BAR; PG8_SCHED;
            PG8_STAGE(PG8_SB(0, 1), b2 + hstep, voffB);
            PG8_WAIT_V(6); PG8_BAR; PG8_MMA(1, 1, At, B1); PG8_BAR;
            PG8_LDB(B0, 1, 0); PG8_SCHED; PG8_LDA(At, 1, 0); PG8_STAGE(PG8_SA(0, 1), a2 + hstep, voffA);
            PG8_WAIT_L(8); PG8_BAR; PG8_WAIT_L(0); PG8_MMA(0, 0, At, B0); PG8_BAR; PG8_SCHED;
            PG8_LDB(B1, 1, 1); PG8_STAGE(PG8_SB(1, 0), b3, voffB);
            PG8_BAR; PG8_WAIT_L(0); PG8_MMA(0, 1, At, B1); PG8_BAR;
            PG8_LDA(At, 1, 1); PG8_STAGE(PG8_SA(1, 0), a3, voffA);
            PG8_BAR; PG8_WAIT_L(0); PG8_MMA(1, 0, At, B0); PG8_BAR; PG8_SCHED;
            PG8_STAGE(PG8_SB(1, 1), b3 + hstep, voffB);
            PG8_WAIT_V(6); PG8_BAR; PG8_MMA(1, 1, At, B1); PG8_BAR;
            }
        }
        if constexpr (ALIGN_EPI) { if (wr == 0) PG8_BAR; }
        if constexpr (!Epi::AFTER_DRAIN) { E(acc, cur, wr, wc, fr, fq); S.done(cur); }
        if (!has_next) break;
#pragma unroll
        for (int a = 0; a < 2; ++a)
#pragma unroll
            for (int b = 0; b < 2; ++b)
#pragma unroll
                for (int m = 0; m < 4; ++m)
#pragma unroll
                    for (int n = 0; n < 2; ++n) acc[a][b][m][n] = (f32x4){0.f, 0.f, 0.f, 0.f};
        cur = nxt; cA = nA; cB = nB; ++ui;
        if constexpr (ALIGN_EPI) { if (wr == 1) PG8_BAR; }
    }
    PG8_WAIT_V(0);
    if constexpr (!ALIGN_EPI) { if (wr == 0) PG8_BAR; }
    PG8_BAR;
    if constexpr (Epi::AFTER_DRAIN) { E.fused(acc, cur, wr, wc, fr, fq, lds, wid, lane); S.done(cur); }
#undef PG8_SA
#undef PG8_SB
#undef PG8_STAGE
#undef PG8_LDA
#undef PG8_LDB
#undef PG8_MMA
#undef PG8_WAIT_V
#undef PG8_WAIT_L
#undef PG8_BAR
#undef PG8_SCHED
}
}
#define GAS __attribute__((address_space(1)))
#define LAS __attribute__((address_space(3)))
typedef unsigned short bf16;
typedef unsigned v4u __attribute__((ext_vector_type(4)));
typedef float f32x4 __attribute__((ext_vector_type(4)));
typedef short bf16x8 __attribute__((ext_vector_type(8)));
typedef GAS unsigned gu32;
typedef GAS unsigned long long gu64;
#define RLX_AGENT __ATOMIC_RELAXED, __HIP_MEMORY_SCOPE_AGENT
#define LDS_WAIT() asm volatile("s_waitcnt lgkmcnt(0)" ::: "memory")
#define VM_WAIT() asm volatile("s_waitcnt vmcnt(0)" ::: "memory")
__device__ __forceinline__ unsigned long long rt() { return __builtin_amdgcn_s_memrealtime(); }
__device__ __forceinline__ unsigned f2bf(float f) { unsigned u = __builtin_bit_cast(unsigned, f); return (u + 0x7fffu + ((u >> 16) & 1u)) >> 16; }
__device__ __forceinline__ unsigned pk2(float lo, float hi) { return f2bf(lo) | (f2bf(hi) << 16); }

#define XB_TMO      128
#define XB_XCNT(j)  (256  + 64 * (j))
#define XB_XSUB(j)  (1280 + 64 * (j))
#define XB_XGEN(j)  (2304 + 64 * (j))
#define XB_TOP      3328
#define XB_TOPGEN   3392
#define XCD_BAR_WORDS 3456
#define XB_SPIN_CAP (1u << 18)

__device__ __forceinline__ unsigned xb_ld(unsigned* p)              { return __hip_atomic_load(p, __ATOMIC_RELAXED, __HIP_MEMORY_SCOPE_AGENT); }
__device__ __forceinline__ unsigned xb_add(unsigned* p, unsigned v) { return __hip_atomic_fetch_add(p, v, __ATOMIC_RELAXED, __HIP_MEMORY_SCOPE_AGENT); }
__device__ __forceinline__ unsigned xb_xcc_id() { return (unsigned)__builtin_amdgcn_s_getreg((3 << 11) | 20) & 0xFu; }
#define XB_SPIN(cond, bar) do { unsigned _sp = 0; while (cond) { __builtin_amdgcn_s_sleep(1); \
    if ((++_sp & 255u) == 0u) { if (xb_ld(&(bar)[XB_TMO])) break; if (_sp > XB_SPIN_CAP) { atomicAdd(&(bar)[XB_TMO], 1u); break; } } } } while (0)

struct XcdBarrier {
    unsigned* bar; unsigned x;
    volatile LAS unsigned* st;
};

__device__ __forceinline__ XcdBarrier xcd_barrier_post(unsigned* bar, volatile LAS unsigned* st) {
    XcdBarrier b; b.bar = bar; b.x = xb_xcc_id(); b.st = st;
    if (threadIdx.x == 0) (void)xb_add(&bar[XB_XCNT(b.x)], 1u);
    return b;
}
__device__ __forceinline__ void xcd_barrier_complete(unsigned* bar, unsigned x, unsigned& nloc, unsigned& nx) {
    const unsigned G = gridDim.x * gridDim.y * gridDim.z;
    unsigned sum, cnt, mine, sp = 0u;
    for (;;) {
        sum = 0u; cnt = 0u; mine = 0u;
#pragma unroll
        for (unsigned j = 0; j < 16; ++j) { const unsigned c = xb_ld(&bar[XB_XCNT(j)]); sum += c; cnt += (c > 0u) ? 1u : 0u; mine = (j == x) ? c : mine; }
        if (sum == G) break;
        __builtin_amdgcn_s_sleep(1);
        if ((++sp & 255u) == 0u) { if (xb_ld(&bar[XB_TMO])) break; if (sp > XB_SPIN_CAP) { atomicAdd(&bar[XB_TMO], 1u); break; } }
    }
    nloc = mine > 0u ? mine : 1u; nx = cnt > 0u ? cnt : 1u;
}

__device__ __forceinline__ void xcd_barrier(const XcdBarrier& b) {
    asm volatile("s_waitcnt vmcnt(0)" ::: "memory");
    __syncthreads();
    if (threadIdx.x == 0) {
        unsigned* bar = b.bar;
        __builtin_amdgcn_s_waitcnt(0);
        unsigned nloc = b.st[0], nx = b.st[1];
        if (nloc == 0u) { xcd_barrier_complete(bar, b.x, nloc, nx); b.st[0] = nloc; b.st[1] = nx; }
        const unsigned old = xb_add(&bar[XB_XSUB(b.x)], 1u);
        const unsigned gen = old / nloc;
        if (old + 1u == (gen + 1u) * nloc) {
            __builtin_amdgcn_fence(__ATOMIC_RELEASE, "agent");
            asm volatile("s_waitcnt vmcnt(0)" ::: "memory");
            const unsigned og = xb_add(&bar[XB_TOP], 1u);
            const unsigned tg = og / nx;
            if (og + 1u == (tg + 1u) * nx) xb_add(&bar[XB_TOPGEN], 1u);
            else XB_SPIN(xb_ld(&bar[XB_TOPGEN]) == tg, bar);
            __builtin_amdgcn_fence(__ATOMIC_ACQUIRE, "agent");
            xb_add(&bar[XB_XGEN(b.x)], 1u);
            asm volatile("s_waitcnt vmcnt(0)" ::: "memory");
        } else {
            XB_SPIN(xb_ld(&bar[XB_XGEN(b.x)]) == gen, bar);
            __builtin_amdgcn_fence(__ATOMIC_ACQUIRE, "agent");
            asm volatile("s_waitcnt vmcnt(0)" ::: "memory");
        }
    }
    __syncthreads();
}
constexpr int NWAVES = 8, NTHR = 512;
constexpr int LX = 8192, LC = 256, DM = 1024, MXR = 16384, MROWS = 16896, NINP = 3840, DFF = 2816;
constexpr float EPS = 1e-6f;
constexpr size_t MiB = 1u << 20, KiB = 1u << 10;
constexpr size_t WS_CTL = 0, CTL_ZERO_BYTES = 64 * KiB;
constexpr size_t WS_MODS = 1 * MiB;
constexpr size_t WS_TW = 1 * MiB + 512 * KiB;
constexpr size_t WS_CTXS = 2 * MiB;
constexpr size_t WS_H2 = 4 * MiB;
constexpr size_t WS_H2C = 8 * MiB;
constexpr size_t WS_SSQ = 8 * MiB + 64 * KiB;
constexpr size_t WS_DTS = 8 * MiB + 640 * KiB;
constexpr size_t WS_DTH = 8 * MiB + 704 * KiB;
constexpr size_t WS_UDT = 9 * MiB;
constexpr size_t WS_WIN = 11 * MiB;
constexpr size_t WS_WOUT = 18 * MiB + 512 * KiB;
constexpr size_t WS_HN = 21 * MiB;
constexpr size_t WS_UHG = 54 * MiB;
constexpr size_t WS_UHY = 96 * MiB;
constexpr size_t WS_UZ = 121 * MiB;
constexpr size_t WS_UXS = 138 * MiB;
constexpr size_t WS_UBC = 154 * MiB + 512 * KiB;
constexpr size_t WS_SST = 138 * MiB;
constexpr size_t WS_AXT = 171 * MiB;
constexpr size_t WS_ABC = 187 * MiB + 512 * KiB;
constexpr size_t WS_ABT = 204 * MiB;
constexpr size_t WS_HST = 213 * MiB;
constexpr size_t WS_MIX = 222 * MiB;
constexpr size_t WS_A = 54 * MiB;
constexpr size_t WS_UP = 145 * MiB;
constexpr size_t WS_WGU = 236 * MiB;
constexpr size_t WS_WD = 247 * MiB;
constexpr size_t WS_END = 256 * MiB;
constexpr int HSP = 8200;
constexpr int CW_BAR = 1024;
constexpr int RING_BYTES = 131072, SCR_OFF = 131072, LDS_BYTES = 147456, MISC_OFF = LDS_BYTES - 128;

typedef float f32x2 __attribute__((ext_vector_type(2)));
typedef unsigned u32x2 __attribute__((ext_vector_type(2)));
typedef unsigned u32x4 __attribute__((ext_vector_type(4)));
#define MFMA4(a, b, c) __builtin_amdgcn_mfma_f32_16x16x4f32((a), (b), (c), 0, 0, 0)

__device__ __forceinline__ float bflo(unsigned w) { return __builtin_bit_cast(float, w << 16); }
__device__ __forceinline__ float bfhi(unsigned w) { return __builtin_bit_cast(float, w & 0xffff0000u); }
__device__ __forceinline__ float bf2f(bf16 h) { return __builtin_bit_cast(float, (unsigned)h << 16); }
__device__ __forceinline__ float siluf(float x) { return x / (1.0f + __expf(-x)); }
__device__ __forceinline__ float sigmf(float x) { return 1.0f / (1.0f + __expf(-x)); }
__device__ __forceinline__ u32x4 pack8(const float (&o)[8]) { u32x4 u; u.x = pk2(o[0], o[1]); u.y = pk2(o[2], o[3]); u.z = pk2(o[4], o[5]); u.w = pk2(o[6], o[7]); return u; }
__device__ __forceinline__ float wave_sum(float v) {
#pragma unroll
    for (int o = 1; o < 64; o <<= 1) v += __shfl_xor(v, o);
    return v;
}
__device__ __forceinline__ void block_sum2(float& a, float& b, LAS float* red, int wave, int lane) {
    a = wave_sum(a); b = wave_sum(b);
    __syncthreads();
    if (lane == 0) { red[wave] = a; red[8 + wave] = b; }
    __syncthreads();
    float sa = 0.f, sb = 0.f;
#pragma unroll
    for (int w = 0; w < 8; ++w) { sa += red[w]; sb += red[8 + w]; }
    a = sa; b = sb;
    __syncthreads();
}

__device__ __forceinline__ void p0_mods_item(const float* c, const float* cctx, const float* w_ada, const float* b_ada, float* mods, LAS float* sm, int item, int tid, int wave, int lane) {
    for (int k = tid; k < 1024; k += NTHR) { sm[k] = siluf(c[k]); sm[1024 + k] = siluf(c[1024 + k]); sm[2048 + k] = siluf(cctx[k]); }
    __syncthreads();
    const int l = item / 96, n0 = (item % 96) * 64;
    const float* W = w_ada + (size_t)l * 1024 * 6144 + n0 + lane;
    float a0 = 0.f, a1 = 0.f, a2 = 0.f;
#pragma unroll 32
    for (int kk = 0; kk < 128; ++kk) { const int k = wave * 128 + kk; const float w = W[(size_t)k * 6144]; a0 += sm[k] * w; a1 += sm[1024 + k] * w; a2 += sm[2048 + k] * w; }
    LAS float* red = sm + 3072;
    red[(wave * 3 + 0) * 64 + lane] = a0; red[(wave * 3 + 1) * 64 + lane] = a1; red[(wave * 3 + 2) * 64 + lane] = a2;
    __syncthreads();
    if (tid < 192) { const int v = tid >> 6, ln = tid & 63; float s = 0.f;
#pragma unroll
        for (int w = 0; w < 8; ++w) s += red[(w * 3 + v) * 64 + ln];
        mods[(size_t)(l * 3 + v) * 6144 + n0 + ln] = s + b_ada[(size_t)l * 6144 + n0 + ln]; }
    __syncthreads();
}
__device__ __forceinline__ void p0_h2_rows(const float* w1, const float* b1, const float* f1, const float* w2, const float* b2, const float* f2, float* out, bf16* outb, int slen, int first, int step, int lane) {
    float w1c[33], w2c[64];
#pragma unroll
    for (int i = 0; i < 33; ++i) w1c[i] = w1[i * 64 + lane];
#pragma unroll
    for (int i = 0; i < 64; ++i) w2c[i] = w2[i * 64 + lane];
    const float bb1 = b1[lane], ff1 = f1[lane], bb2 = b2[lane], ff2 = f2[lane];
#pragma unroll 1
    for (int t = first; t < slen; t += step) {
        const float tl = (float)t / (float)(slen - 1);
        const float w = (6.283185307179586f * (float)t) / (float)slen;
        float z = 0.f;
        if (lane == 0) z = tl;
        else if (lane <= 16) { const float band = 1e-4f + (float)(lane - 1) * ((15.0f - 1e-4f) / 15.0f); z = __cosf(band * w); }
        else if (lane <= 32) { const float band = 1e-4f + (float)(lane - 17) * ((15.0f - 1e-4f) / 15.0f); z = -__sinf(band * w); }
        float pre = bb1;
#pragma unroll
        for (int i = 0; i < 33; ++i) pre += __builtin_bit_cast(float, __builtin_amdgcn_readlane(__builtin_bit_cast(int, z), i)) * w1c[i];
        const float h1 = __sinf(ff1 * pre);
        float pre2 = bb2;
#pragma unroll
        for (int i = 0; i < 64; ++i) pre2 += __builtin_bit_cast(float, __builtin_amdgcn_readlane(__builtin_bit_cast(int, h1), i)) * w2c[i];
        const float hv = __sinf(ff2 * pre2);
        if (outb) outb[(size_t)t * 64 + lane] = (bf16)f2bf(hv); else out[(size_t)t * 64 + lane] = hv;
    }
}
__device__ __forceinline__ void transpose_item(const float* W, int K, int N, int Nvalid, bf16* WT, LAS float* scr, int item, int lane) {
    const int nblk = N / 32, kb = item / nblk, nb = item % nblk, k0 = 64 * kb, n0 = 32 * nb;
    const int n4 = (lane & 7) * 4, nn = n0 + n4;
    f32x4 ld[8];
#pragma unroll
    for (int i = 0; i < 8; ++i) { const int kk = 8 * i + (lane >> 3); ld[i] = nn < Nvalid ? *(const f32x4*)(W + (size_t)(k0 + kk) * Nvalid + nn) : (f32x4){0.f, 0.f, 0.f, 0.f}; }
#pragma unroll
    for (int i = 0; i < 8; ++i) { const int kk = 8 * i + (lane >> 3); LAS float* d = scr + kk * 33 + n4; d[0] = ld[i].x; d[1] = ld[i].y; d[2] = ld[i].z; d[3] = ld[i].w; }
    LDS_WAIT(); asm volatile("" ::: "memory");
    const int c = lane & 7;
#pragma unroll
    for (int j = 0; j < 4; ++j) { const int n = (lane >> 3) + 8 * j; const LAS float* s = scr + (8 * c) * 33 + n;
        v4u o; o.x = pk2(s[0 * 33], s[1 * 33]); o.y = pk2(s[2 * 33], s[3 * 33]); o.z = pk2(s[4 * 33], s[5 * 33]); o.w = pk2(s[6 * 33], s[7 * 33]);
        *(GAS v4u*)(WT + (size_t)(n0 + n) * K + k0 + 8 * c) = o; }
    LDS_WAIT(); asm volatile("" ::: "memory");
}
__device__ __forceinline__ void convert_weight(const float* W, int K, int N, int Nvalid, bf16* WT, LAS float* scr, int gw, int ngw, int lane) {
    const int nitems = (K / 64) * (N / 32);
#pragma unroll 1
    for (int it = gw; it < nitems; it += ngw) transpose_item(W, K, N, Nvalid, WT, scr, it, lane);
}

__device__ __forceinline__ void norm_rows(const float* xsrc, const float* csrc, int nrows, const float* g, const float* mods_l, int kshift, int kscale, bf16* hn, int gw, int ngw, int lane,
                                          const float* pend = nullptr, int pnsplit = 0, const float* pgate = nullptr, float* cdst = nullptr) {
    f32x4 gv[4];
#pragma unroll
    for (int j = 0; j < 4; ++j) gv[j] = *(const f32x4*)(g + 4 * lane + 256 * j);
    f32x4 x[4];
    if (gw < nrows) { const float* src = gw < MXR ? xsrc + (size_t)gw * DM : csrc + (size_t)(gw - MXR) * DM;
#pragma unroll
        for (int j = 0; j < 4; ++j) x[j] = *(const f32x4*)(src + 4 * lane + 256 * j); }
#pragma unroll 1
    for (int m = gw; m < nrows; m += ngw) {
        const int v = m < MXR ? (m >> 13) : 2;
        const float* sh = mods_l + (size_t)v * 6144 + kshift * 1024; const float* sc = mods_l + (size_t)v * 6144 + kscale * 1024;
        float ss = 0.f;
        f32x4 xn[4];
        { const int mn = m + ngw; if (mn < nrows) { const float* srcn = mn < MXR ? xsrc + (size_t)mn * DM : csrc + (size_t)(mn - MXR) * DM;
#pragma unroll
            for (int j = 0; j < 4; ++j) xn[j] = *(const f32x4*)(srcn + 4 * lane + 256 * j); } }
        if (pend && m >= MXR) {
            const int rl = m - MXR;
#pragma unroll
            for (int j = 0; j < 4; ++j) {
                const float* sp = pend + (size_t)(((rl >> 8) * 4 + j) * pnsplit) * 65536 + (size_t)(rl & 255) * 256 + 4 * lane;
                f32x4 sum = (f32x4){0.f, 0.f, 0.f, 0.f};
                for (int ks = 0; ks < pnsplit; ++ks) sum += *(const f32x4*)(sp + (size_t)ks * 65536);
                x[j] += *(const f32x4*)(pgate + 4 * lane + 256 * j) * sum;
                *(f32x4*)(cdst + (size_t)rl * DM + 4 * lane + 256 * j) = x[j];
            }
        }
#pragma unroll
        for (int j = 0; j < 4; ++j) ss += (x[j].x * x[j].x + x[j].y * x[j].y) + (x[j].z * x[j].z + x[j].w * x[j].w);
        const float rstd = 1.0f / sqrtf(wave_sum(ss) * (1.0f / DM) + EPS);
#pragma unroll
        for (int j = 0; j < 4; ++j) {
            const f32x4 s4 = *(const f32x4*)(sc + 4 * lane + 256 * j), h4 = *(const f32x4*)(sh + 4 * lane + 256 * j);
            const f32x4 y = x[j] * rstd * gv[j] * (s4 + 1.0f) + h4;
            u32x2 o; o.x = pk2(y.x, y.y); o.y = pk2(y.z, y.w);
            *(u32x2*)(hn + (size_t)m * DM + 4 * lane + 256 * j) = o;
        }
#pragma unroll
        for (int j = 0; j < 4; ++j) x[j] = xn[j];
    }
}
__device__ __forceinline__ void final_norm_rows(float* x, const float* g, int gw, int ngw, int lane) {
    f32x4 gv[4];
#pragma unroll
    for (int j = 0; j < 4; ++j) gv[j] = *(const f32x4*)(g + 4 * lane + 256 * j);
    f32x4 v[4];
    if (gw < MXR) {
#pragma unroll
        for (int j = 0; j < 4; ++j) v[j] = *(const f32x4*)(x + (size_t)gw * DM + 4 * lane + 256 * j); }
#pragma unroll 1
    for (int m = gw; m < MXR; m += ngw) {
        float* src = x + (size_t)m * DM;
        float ss = 0.f;
        f32x4 vn[4];
        if (m + ngw < MXR) {
#pragma unroll
            for (int j = 0; j < 4; ++j) vn[j] = *(const f32x4*)(x + (size_t)(m + ngw) * DM + 4 * lane + 256 * j); }
#pragma unroll
        for (int j = 0; j < 4; ++j) ss += (v[j].x * v[j].x + v[j].y * v[j].y) + (v[j].z * v[j].z + v[j].w * v[j].w);
        const float rstd = 1.0f / sqrtf(wave_sum(ss) * (1.0f / DM) + EPS);
#pragma unroll
        for (int j = 0; j < 4; ++j) *(f32x4*)(src + 4 * lane + 256 * j) = v[j] * rstd * gv[j];
#pragma unroll
        for (int j = 0; j < 4; ++j) v[j] = vn[j];
    }
}

__device__ __forceinline__ void cv_unpack(const u32x4 v, float (&o)[8]) { o[0] = bflo(v.x); o[1] = bfhi(v.x); o[2] = bflo(v.y); o[3] = bfhi(v.y); o[4] = bflo(v.z); o[5] = bfhi(v.z); o[6] = bflo(v.w); o[7] = bfhi(v.w); }
__device__ __forceinline__ void ffn_conv_phase(const bf16* a, bf16* up, const float* cw  , const float* cb, int row_first, int nrows, int gtid, int ngt, bf16* outp, long out_row_delta) {
    constexpr int ncg = DFF / 8, SEG = 16;
    const int nseg = nrows / SEG, tpc = ngt / ncg;
    if (gtid >= tpc * ncg) return;
    const int cgi = gtid % ncg, c = cgi * 8;
    float w[9][8], bias[8];
#pragma unroll
    for (int k = 0; k < 9; ++k) { const f32x4 w0 = *(const f32x4*)(cw + (size_t)k * DFF + c), w1 = *(const f32x4*)(cw + (size_t)k * DFF + c + 4);
        w[k][0] = w0.x; w[k][1] = w0.y; w[k][2] = w0.z; w[k][3] = w0.w; w[k][4] = w1.x; w[k][5] = w1.y; w[k][6] = w1.z; w[k][7] = w1.w; }
    { const f32x4 b0 = *(const f32x4*)(cb + c), b1 = *(const f32x4*)(cb + c + 4); bias[0] = b0.x; bias[1] = b0.y; bias[2] = b0.z; bias[3] = b0.w; bias[4] = b1.x; bias[5] = b1.y; bias[6] = b1.z; bias[7] = b1.w; }
#pragma unroll 1
    for (int seg = gtid / ncg; seg < nseg; seg += tpc) {
        const int row0 = row_first + seg * SEG;
        int rr, ww0, nr, nw;
        if (row0 < MXR) { const int t = row0 & 8191; rr = t >> 6; ww0 = t & 63; nr = 128; nw = 64; } else { const int t = (row0 - MXR) & 255; rr = 0; ww0 = t; nr = 1; nw = 256; }
        const bool has_up = rr > 0, has_dn = rr < nr - 1;
        const u32x4 zero = (u32x4){0u, 0u, 0u, 0u};
        u32x4 win[3][3];
        const bf16* pm = a + (size_t)row0 * DFF + c;
#pragma unroll
        for (int ky = 0; ky < 3; ++ky) {
            const bool okr = ky == 0 ? has_up : (ky == 2 ? has_dn : true);
            const bf16* pr = pm + (ptrdiff_t)(ky - 1) * nw * DFF;
            win[ky][0] = (okr && ww0 > 0) ? *(const u32x4*)(pr - DFF) : zero;
            win[ky][1] = okr ? *(const u32x4*)pr : zero;
        }
#pragma unroll 4
        for (int i = 0; i < SEG; ++i) {
            const int wcur = ww0 + i;
            const bool okn = wcur + 1 < nw;
#pragma unroll
            for (int ky = 0; ky < 3; ++ky) {
                const bool okr = ky == 0 ? has_up : (ky == 2 ? has_dn : true);
                win[ky][2] = (okr && okn) ? *(const u32x4*)(pm + (ptrdiff_t)((ky - 1) * nw + i + 1) * DFF) : zero;
            }
            const u32x4 uv = *(const u32x4*)(up + (size_t)(row0 + i) * DFF + c);
            float acc[8];
#pragma unroll
            for (int j = 0; j < 8; ++j) acc[j] = bias[j];
#pragma unroll
            for (int ky = 0; ky < 3; ++ky)
#pragma unroll
                for (int kx = 0; kx < 3; ++kx) { float v[8]; cv_unpack(win[ky][kx], v);
#pragma unroll
                    for (int j = 0; j < 8; ++j) acc[j] += w[ky * 3 + kx][j] * v[j]; }
            float u[8]; cv_unpack(uv, u);
            u32x4 o;
            o.x = pk2(siluf(acc[0]) * u[0], siluf(acc[1]) * u[1]); o.y = pk2(siluf(acc[2]) * u[2], siluf(acc[3]) * u[3]);
            o.z = pk2(siluf(acc[4]) * u[4], siluf(acc[5]) * u[5]); o.w = pk2(siluf(acc[6]) * u[6], siluf(acc[7]) * u[7]);
            *(u32x4*)(outp + (size_t)(row0 + i + out_row_delta) * DFF + c) = o;
#pragma unroll
            for (int ky = 0; ky < 3; ++ky) { win[ky][0] = win[ky][1]; win[ky][1] = win[ky][2]; }
        }
    }
}
constexpr int FN = 16384, FNP = FN + (FN >> 6) * 4;
constexpr int FFT_SCR = FNP * 8;
__device__ __forceinline__ int DI(int i) { return i + ((i >> 6) << 2); }
__device__ __forceinline__ f32x2 cmul(f32x2 a, f32x2 b) { return (f32x2){a.x * b.x - a.y * b.y, a.x * b.y + a.y * b.x}; }
__device__ __forceinline__ f32x2 cmulc(f32x2 a, f32x2 b) { return (f32x2){a.x * b.x + a.y * b.y, a.y * b.x - a.x * b.y}; }
__device__ __forceinline__ int rev4(int p) {
    unsigned r = __brev((unsigned)p) >> 18;
    return (int)(((r & 0x1555u) << 1) | ((r >> 1) & 0x1555u));
}
#define BF4F(x0, x1, x2, x3) do { const f32x2 a_ = x0 + x2, b_ = x0 - x2, c_ = x1 + x3, d_ = x1 - x3; x0 = a_ + c_; x2 = a_ - c_; x1 = (f32x2){b_.x + d_.y, b_.y - d_.x}; x3 = (f32x2){b_.x - d_.y, b_.y + d_.x}; } while (0)
#define BF4I(x0, x1, x2, x3) do { const f32x2 a_ = x0 + x2, b_ = x0 - x2, c_ = x1 + x3, d_ = x1 - x3; x0 = a_ + c_; x2 = a_ - c_; x1 = (f32x2){b_.x - d_.y, b_.y + d_.x}; x3 = (f32x2){b_.x + d_.y, b_.y - d_.x}; } while (0)
#define W16_C1 0.92387953251128674f
#define W16_S1 0.38268343236508977f
#define W16_H 0.70710678118654752f
__device__ __forceinline__ f32x2 w16(int e) {
    switch (e) { case 1: return (f32x2){W16_C1, -W16_S1}; case 2: return (f32x2){W16_H, -W16_H}; case 3: return (f32x2){W16_S1, -W16_C1}; case 4: return (f32x2){0.f, -1.f};
                 case 6: return (f32x2){-W16_H, -W16_H}; default: return (f32x2){-W16_C1, W16_S1}; }
}
template <bool INV> __device__ __forceinline__ void fft_pass16(LAS f32x2* D, int lgm, int tid) {
    const int m = 1 << lgm; const float rn = 1.0f / (float)(16 << lgm);
#pragma unroll 1
    for (int it = 0; it < 2; ++it) {
        const int bf = tid + NTHR * it, j0 = bf & (m - 1), base = ((bf >> lgm) << (lgm + 4)) + j0;
        f32x2 v[16];
#pragma unroll
        for (int r = 0; r < 16; ++r) v[r] = D[DI(base + r * m)];
        const float rev = (float)j0 * rn;
        const f32x2 w1 = (f32x2){__builtin_amdgcn_cosf(rev), -__builtin_amdgcn_sinf(rev)}, w2 = cmul(w1, w1), w3 = cmul(w2, w1);
        const f32x2 u1 = cmul(w2, w2), u2 = cmul(u1, u1), u3 = cmul(u2, u1);
        if (!INV) {
#pragma unroll
            for (int a = 0; a < 4; ++a) {
                BF4F(v[a], v[a + 4], v[a + 8], v[a + 12]);
                if (a > 0) { v[a + 4] = cmul(v[a + 4], w16(a)); v[a + 8] = cmul(v[a + 8], w16(2 * a)); v[a + 12] = cmul(v[a + 12], w16(3 * a)); }
                v[a + 4] = cmul(v[a + 4], w1); v[a + 8] = cmul(v[a + 8], w2); v[a + 12] = cmul(v[a + 12], w3);
            }
#pragma unroll
            for (int q = 0; q < 4; ++q) {
                BF4F(v[4 * q], v[4 * q + 1], v[4 * q + 2], v[4 * q + 3]);
                v[4 * q + 1] = cmul(v[4 * q + 1], u1); v[4 * q + 2] = cmul(v[4 * q + 2], u2); v[4 * q + 3] = cmul(v[4 * q + 3], u3);
            }
        } else {
#pragma unroll
            for (int q = 0; q < 4; ++q) {
                v[4 * q + 1] = cmulc(v[4 * q + 1], u1); v[4 * q + 2] = cmulc(v[4 * q + 2], u2); v[4 * q + 3] = cmulc(v[4 * q + 3], u3);
                BF4I(v[4 * q], v[4 * q + 1], v[4 * q + 2], v[4 * q + 3]);
            }
#pragma unroll
            for (int a = 0; a < 4; ++a) {
                v[a + 4] = cmulc(v[a + 4], w1); v[a + 8] = cmulc(v[a + 8], w2); v[a + 12] = cmulc(v[a + 12], w3);
                if (a > 0) { v[a + 4] = cmulc(v[a + 4], w16(a)); v[a + 8] = cmulc(v[a + 8], w16(2 * a)); v[a + 12] = cmulc(v[a + 12], w16(3 * a)); }
                BF4I(v[a], v[a + 4], v[a + 8], v[a + 12]);
            }
        }
#pragma unroll
        for (int r = 0; r < 16; ++r) D[DI(base + r * m)] = v[r];
    }
    __syncthreads();
}
template <bool INV> __device__ __forceinline__ void fft_pass4(LAS f32x2* D, int tid) {
#pragma unroll 2
    for (int it = 0; it < 8; ++it) {
        const int i0 = DI(4 * (tid + NTHR * it));
        f32x4 p01 = *(LAS f32x4*)(D + i0), p23 = *(LAS f32x4*)(D + i0 + 2);
        f32x2 x0 = (f32x2){p01.x, p01.y}, x1 = (f32x2){p01.z, p01.w}, x2 = (f32x2){p23.x, p23.y}, x3 = (f32x2){p23.z, p23.w};
        if (!INV) BF4F(x0, x1, x2, x3); else BF4I(x0, x1, x2, x3);
        *(LAS f32x4*)(D + i0) = (f32x4){x0.x, x0.y, x1.x, x1.y}; *(LAS f32x4*)(D + i0 + 2) = (f32x4){x2.x, x2.y, x3.x, x3.y};
    }
    __syncthreads();
}
__device__ __forceinline__ void fft_fwd(LAS f32x2* D, int tid) { fft_pass16<false>(D, 10, tid); fft_pass16<false>(D, 6, tid); fft_pass16<false>(D, 2, tid); fft_pass4<false>(D, tid); }
__device__ __forceinline__ void fft_inv(LAS f32x2* D, int tid) { fft_pass4<true>(D, tid); fft_pass16<true>(D, 2, tid); fft_pass16<true>(D, 6, tid); fft_pass16<true>(D, 10, tid); }
__device__ __forceinline__ void spec_mul(LAS f32x2* D, const f32x2* H, int tid) {
#pragma unroll 8
    for (int i = 0; i < 32; ++i) {
        const int p = tid + NTHR * i, k = rev4(p);
        f32x2 h;
        if (k <= 8192) h = H[k]; else { h = H[FN - k]; h.y = -h.y; }
        D[DI(p)] = cmul(D[DI(p)], h);
    }
    __syncthreads();
}

__device__ __forceinline__ f32x2 spec_at(const f32x2* H, int k) { f32x2 h; if (k <= 8192) h = H[k]; else { h = H[FN - k]; h.y = -h.y; } return h; }
__device__ __forceinline__ void fft_mid(LAS f32x2* D, const f32x2* H, int tid) {
#pragma unroll 4
    for (int it = 0; it < 8; ++it) {
        const int p = 4 * (tid + NTHR * it), i0 = DI(p);
        const f32x2 h0 = spec_at(H, rev4(p)), h1 = spec_at(H, rev4(p + 1)), h2 = spec_at(H, rev4(p + 2)), h3 = spec_at(H, rev4(p + 3));
        f32x4 p01 = *(LAS f32x4*)(D + i0), p23 = *(LAS f32x4*)(D + i0 + 2);
        f32x2 x0 = (f32x2){p01.x, p01.y}, x1 = (f32x2){p01.z, p01.w}, x2 = (f32x2){p23.x, p23.y}, x3 = (f32x2){p23.z, p23.w};
        BF4F(x0, x1, x2, x3);
        x0 = cmul(x0, h0); x1 = cmul(x1, h1); x2 = cmul(x2, h2); x3 = cmul(x3, h3);
        BF4I(x0, x1, x2, x3);
        *(LAS f32x4*)(D + i0) = (f32x4){x0.x, x0.y, x1.x, x1.y}; *(LAS f32x4*)(D + i0 + 2) = (f32x4){x2.x, x2.y, x3.x, x3.y};
    }
    __syncthreads();
}
__device__ __forceinline__ void fft_conv(LAS f32x2* D, const f32x2* H, int tid) {
    fft_pass16<false>(D, 10, tid); fft_pass16<false>(D, 6, tid); fft_pass16<false>(D, 2, tid);
    fft_mid(D, H, tid);
    fft_pass16<true>(D, 2, tid); fft_pass16<true>(D, 6, tid); fft_pass16<true>(D, 10, tid);
}

__device__ __forceinline__ void hy_spectrum_item(LAS unsigned char* lds, const bf16* h2l  , const float* w3l  , const float* hbias  , f32x2* Hs, int c, int tid, int wave, int lane) {
    LAS f32x2* D = (LAS f32x2*)lds;
    LAS f32x4* W3 = (LAS f32x4*)(lds + FFT_SCR);
    LAS float* red = (LAS float*)(lds + FFT_SCR + 2048);
    __syncthreads();
    if (tid < 64) { const float* wr = w3l + (size_t)tid * 1024 + c; W3[tid] = (f32x4){wr[0], wr[256], wr[512], wr[768]}; }
    __syncthreads();
    const float delta = fabsf(-3.0701134573253946f + (float)c * ((-15.350567286626973f + 3.0701134573253946f) / 255.0f));
    float s0 = 0.f, s1 = 0.f;
#pragma unroll 1
    for (int ib = 0; ib < 4; ++ib) {
        asm volatile("" ::: "memory");
        f32x4 acc[4];
#pragma unroll
        for (int u = 0; u < 4; ++u) acc[u] = (f32x4){0.f, 0.f, 0.f, 0.f};
#pragma unroll 2
        for (int j8 = 0; j8 < 8; ++j8) {
            f32x4 w[8];
#pragma unroll
            for (int e = 0; e < 8; ++e) w[e] = W3[8 * j8 + e];
#pragma unroll
            for (int u = 0; u < 4; ++u) {
                const int t = tid + NTHR * (4 * ib + u);
                const u32x4 hv = *(const u32x4*)(h2l + (size_t)t * 64 + 8 * j8);
                acc[u] += w[0] * bflo(hv.x) + w[1] * bfhi(hv.x) + w[2] * bflo(hv.y) + w[3] * bfhi(hv.y) + w[4] * bflo(hv.z) + w[5] * bfhi(hv.z) + w[6] * bflo(hv.w) + w[7] * bfhi(hv.w);
            }
        }
#pragma unroll
        for (int u = 0; u < 4; ++u) {
            const int t = tid + NTHR * (4 * ib + u);
            const f32x4 a = acc[u] * __expf(-((float)t / 8191.0f) * delta);
            D[DI(t)] = (f32x2){a.x, a.y};
            s0 += fabsf(a.x); s1 += fabsf(a.y);
            if (t >= 1) { D[DI(FN - t)] = (f32x2){a.z, a.w}; s0 += fabsf(a.z); s1 += fabsf(a.w); }
            if (t == 0) D[DI(8192)] = (f32x2){0.f, 0.f};
        }
    }
    block_sum2(s0, s1, red, wave, lane);
    fft_fwd(D, tid);
    const float i0 = 0.5f / s0, i1 = 0.5f / s1, bias0 = hbias[c], bias1 = hbias[256 + c];
#pragma unroll 1
    for (int i = 0; i < 17; ++i) {
        const int k = tid + NTHR * i;
        if (k <= 8192) {
            const f32x2 zk = D[DI(rev4(k))], zn = D[DI(rev4((FN - k) & (FN - 1)))];
            Hs[(size_t)(c * 2 + 0) * HSP + k] = (f32x2){(zk.x + zn.x) * i0 + bias0, (zk.y - zn.y) * i0};
            Hs[(size_t)(c * 2 + 1) * HSP + k] = (f32x2){(zk.y + zn.y) * i1 + bias1, -(zk.x - zn.x) * i1};
        }
    }
    __syncthreads();
}

__device__ __forceinline__ float hy_conv3(const bf16* row, int t, int len, float w0, float w1, float w2, float bias) {
    const float um = t > 0 ? bf2f(row[t - 1]) : 0.f, u0 = bf2f(row[t]), up = t < len - 1 ? bf2f(row[t + 1]) : 0.f;
    return w0 * um + w1 * u0 + w2 * up + bias;
}
__device__ __forceinline__ void hy_conv8(const bf16* row, int t0, int len, float w0, float w1, float w2, float bias, float (&o)[8]) {
    const u32x4 v = *(const u32x4*)(row + t0);
    const float um = t0 > 0 ? bf2f(row[t0 - 1]) : 0.f, un = t0 + 8 < len ? bf2f(row[t0 + 8]) : 0.f;
    float x[10]; x[0] = um; x[1] = bflo(v.x); x[2] = bfhi(v.x); x[3] = bflo(v.y); x[4] = bfhi(v.y); x[5] = bflo(v.z); x[6] = bfhi(v.z); x[7] = bflo(v.w); x[8] = bfhi(v.w); x[9] = un;
#pragma unroll
    for (int e = 0; e < 8; ++e) o[e] = w0 * x[e] + w1 * x[e + 1] + w2 * x[e + 2] + bias;
}
__device__ __forceinline__ void hy_fft_item(LAS unsigned char* lds, const bf16* uhyT, const float* cw  , const float* cb  , const f32x2* Hs, bf16* hyoT, int c, int tid) {
    LAS f32x2* D = (LAS f32x2*)lds;
    const bf16* rv = uhyT + (size_t)c * MROWS; const bf16* r1 = uhyT + (size_t)(256 + c) * MROWS; const bf16* r2 = uhyT + (size_t)(512 + c) * MROWS;
    const float vw0 = cw[c], vw1 = cw[768 + c], vw2 = cw[1536 + c], vb = cb[c];
    const float aw0 = cw[256 + c], aw1 = cw[768 + 256 + c], aw2 = cw[1536 + 256 + c], ab = cb[256 + c];
    const float bw0 = cw[512 + c], bw1 = cw[768 + 512 + c], bw2 = cw[1536 + 512 + c], bb = cb[512 + c];
    const float inv = 1.0f / (float)FN;
    __syncthreads();
#pragma unroll
    for (int i = 0; i < 2; ++i) { const int t0 = 8 * (tid + NTHR * i);
        float a[8], b[8]; hy_conv8(rv, t0, LX, vw0, vw1, vw2, vb, a); hy_conv8(rv + LX, t0, LX, vw0, vw1, vw2, vb, b);
#pragma unroll
        for (int e = 0; e < 8; ++e) { D[DI(t0 + e)] = (f32x2){a[e], b[e]}; D[DI(t0 + e + LX)] = (f32x2){0.f, 0.f}; } }
    __syncthreads();
    fft_conv(D, Hs + (size_t)(c * 2 + 0) * HSP, tid);
#pragma unroll
    for (int i = 0; i < 2; ++i) { const int t0 = 8 * (tid + NTHR * i);
        float a[8], b[8]; hy_conv8(r1, t0, LX, aw0, aw1, aw2, ab, a); hy_conv8(r1 + LX, t0, LX, aw0, aw1, aw2, ab, b);
#pragma unroll
        for (int e = 0; e < 8; ++e) { const f32x2 cv = D[DI(t0 + e)]; D[DI(t0 + e)] = (f32x2){a[e] * cv.x * inv, b[e] * cv.y * inv}; D[DI(t0 + e + LX)] = (f32x2){0.f, 0.f}; } }
    __syncthreads();
    fft_conv(D, Hs + (size_t)(c * 2 + 1) * HSP, tid);
#pragma unroll
    for (int i = 0; i < 2; ++i) { const int t0 = 8 * (tid + NTHR * i);
        float a[8], b[8], oa[8], ob[8]; hy_conv8(r2, t0, LX, bw0, bw1, bw2, bb, a); hy_conv8(r2 + LX, t0, LX, bw0, bw1, bw2, bb, b);
#pragma unroll
        for (int e = 0; e < 8; ++e) { const f32x2 cv = D[DI(t0 + e)]; oa[e] = a[e] * cv.x * inv; ob[e] = b[e] * cv.y * inv; }
        *(u32x4*)(hyoT + (size_t)c * MROWS + t0) = pack8(oa);
        *(u32x4*)(hyoT + (size_t)c * MROWS + LX + t0) = pack8(ob); }
    __syncthreads();
}

__device__ __forceinline__ void hy_ctx_conv(const LAS float* Gn, const LAS float* Yb, LAS float* Rb, int t0) {
    const LAS float* Gp = Gn + 255 + t0;
    float a0 = 0.f, a1 = 0.f, a2 = 0.f, a3 = 0.f, g0 = Gp[0], g1 = Gp[1], g2 = Gp[2], g3 = Gp[3];
#pragma unroll 4
    for (int s = 0; s < 256; ++s) {
        const float y = Yb[s];
        a0 += y * g0; a1 += y * g1; a2 += y * g2; a3 += y * g3;
        g3 = g2; g2 = g1; g1 = g0; g0 = Gp[-(s + 1)];
    }
    Rb[t0] = a0; Rb[t0 + 1] = a1; Rb[t0 + 2] = a2; Rb[t0 + 3] = a3;
}
__device__ __forceinline__ void hy_ctx_item(LAS unsigned char* lds, const bf16* uhyT, const float* cw, const float* cb, const float* hbias, const float* h2c  , const float* w3l, bf16* mix, int c, int tid, int wave, int lane) {
    LAS float* G = (LAS float*)lds + 4;
    LAS float* Y = G + 1024;
    LAS float* R = Y + 512;
    LAS f32x4* W3 = (LAS f32x4*)((LAS float*)lds + 2064);
    LAS float* red = (LAS float*)lds + 2064 + 256;
    __syncthreads();
    if (tid < 64) { const float* wr = w3l + (size_t)tid * 1024 + c; W3[tid] = (f32x4){wr[0], wr[256], wr[512], wr[768]}; }
    if (tid < 2) G[tid * 512 + 511] = 0.f;
    __syncthreads();
    const float delta = fabsf(-3.0701134573253946f + (float)c * ((-15.350567286626973f + 3.0701134573253946f) / 255.0f));
    float s0 = 0.f, s1 = 0.f;
    if (tid < 256) {
        const f32x4* hr = (const f32x4*)(h2c + (size_t)tid * 64);
        f32x4 acc = (f32x4){0.f, 0.f, 0.f, 0.f};
#pragma unroll
        for (int j4 = 0; j4 < 16; ++j4) { const f32x4 hv = hr[j4];
            acc += W3[4 * j4 + 0] * hv.x; acc += W3[4 * j4 + 1] * hv.y; acc += W3[4 * j4 + 2] * hv.z; acc += W3[4 * j4 + 3] * hv.w; }
        acc *= __expf(-((float)tid / 255.0f) * delta);
        G[255 + tid] = acc.x; G[512 + 255 + tid] = acc.y;
        if (tid >= 1) { G[255 - tid] = acc.z; G[512 + 255 - tid] = acc.w; }
        s0 = fabsf(acc.x) + (tid >= 1 ? fabsf(acc.z) : 0.f); s1 = fabsf(acc.y) + (tid >= 1 ? fabsf(acc.w) : 0.f);
    }
    block_sum2(s0, s1, red, wave, lane);
    const float n0 = 1.0f / s0, n1 = 1.0f / s1;
    const int b = tid >> 8, t = tid & 255;
    const bf16* rv = uhyT + (size_t)c * MROWS + MXR + b * LC; const bf16* r1 = uhyT + (size_t)(256 + c) * MROWS + MXR + b * LC; const bf16* r2 = uhyT + (size_t)(512 + c) * MROWS + MXR + b * LC;
    const float v = hy_conv3(rv, t, LC, cw[c], cw[768 + c], cw[1536 + c], cb[c]);
    const float g1 = hy_conv3(r1, t, LC, cw[256 + c], cw[768 + 256 + c], cw[1536 + 256 + c], cb[256 + c]);
    const float g2 = hy_conv3(r2, t, LC, cw[512 + c], cw[768 + 512 + c], cw[1536 + 512 + c], cb[512 + c]);
    Y[b * 256 + t] = v;
    __syncthreads();
    if (tid < 128) hy_ctx_conv(G, Y + (tid >> 6) * 256, R + (tid >> 6) * 256, 4 * (tid & 63));
    __syncthreads();
    const float y1 = g1 * (R[b * 256 + t] * n0 + v * hbias[c]);
    Y[b * 256 + t] = y1;
    __syncthreads();
    if (tid < 128) hy_ctx_conv(G + 512, Y + (tid >> 6) * 256, R + (tid >> 6) * 256, 4 * (tid & 63));
    __syncthreads();
    const float o = g2 * (R[b * 256 + t] * n1 + y1 * hbias[256 + c]);
    mix[(size_t)(MXR + b * LC + t) * DM + 256 + c] = (bf16)f2bf(o);
    __syncthreads();
}
typedef short s16x4 __attribute__((ext_vector_type(4)));
#define LBAR() do { asm volatile("s_waitcnt lgkmcnt(0)" ::: "memory"); __builtin_amdgcn_s_barrier(); asm volatile("" ::: "memory"); } while (0)
#define MFMA32(a, b, c) __builtin_amdgcn_mfma_f32_16x16x32_bf16((a), (b), (c), 0, 0, 0)
__device__ __forceinline__ bf16x8 frag16(const LAS bf16* p) { return *(const LAS bf16x8*)p; }
__device__ __forceinline__ bf16x8 frag2x8(const LAS bf16* p0, const LAS bf16* p1) { const s16x4 a = *(const LAS s16x4*)p0, b = *(const LAS s16x4*)p1; return __builtin_shufflevector(a, b, 0, 1, 2, 3, 4, 5, 6, 7); }
__device__ __forceinline__ bf16x8 pack_acc2(const f32x4 a, const f32x4 b) { u32x4 u; u.x = pk2(a[0], a[1]); u.y = pk2(a[2], a[3]); u.z = pk2(b[0], b[1]); u.w = pk2(b[2], b[3]); return __builtin_bit_cast(bf16x8, u); }

__device__ __forceinline__ void ssd_prepass(const bf16* uxs, const bf16* ubc, const float* cw  , const float* cb  , bf16* axt, bf16* abc, bf16* abt, int gw, int ngw, int lane) {
    const int wpc = ngw / 96;
    if (gw < wpc * 96) {
    const int cg = gw % 96, xcol = cg < 64 ? 8 * cg : 512 + 8 * (cg - 64);
    float tw0[8], tw1[8], tw2[8], tb[8];
#pragma unroll
    for (int j = 0; j < 8; ++j) { tw0[j] = cw[xcol + j]; tw1[j] = cw[1024 + xcol + j]; tw2[j] = cw[2048 + xcol + j]; tb[j] = cb[xcol + j]; }
#pragma unroll 2
    for (int C = gw / 96; C < 264; C += wpc) {
        const int row = 64 * C + lane;
        const int t = row < MXR ? (row & 8191) : ((row - MXR) & 255), len = row < MXR ? LX : LC;
        const bf16* src = cg < 64 ? uxs + (size_t)row * 512 + 8 * cg : ubc + (size_t)row * 512 + 8 * (cg - 64);
        const u32x4 u0 = *(const u32x4*)src;
        const u32x4 um = t > 0 ? *(const u32x4*)(src - 512) : (u32x4){0u, 0u, 0u, 0u};
        const u32x4 un = t < len - 1 ? *(const u32x4*)(src + 512) : (u32x4){0u, 0u, 0u, 0u};
        float a[8], c0[8], c2[8], o[8];
        cv_unpack(um, a); cv_unpack(u0, c0); cv_unpack(un, c2);
#pragma unroll
        for (int j = 0; j < 8; ++j) o[j] = siluf(tw0[j] * a[j] + tw1[j] * c0[j] + tw2[j] * c2[j] + tb[j]);
        bf16* dst = cg < 64 ? axt + ((size_t)(C * 8 + (cg >> 3)) * 64 + 8 * (cg & 7)) * 64 + lane : abt + ((size_t)(C * 2 + ((cg - 64) >> 4)) * 128 + 8 * ((cg - 64) & 15)) * 64 + lane;
#pragma unroll
        for (int j = 0; j < 8; ++j) dst[j * 64] = (bf16)f2bf(o[j]);
    }
    }
    {
        float w0[8], w1[8], w2[8], bi[8];
#pragma unroll
        for (int j = 0; j < 8; ++j) { const int xcol = 512 + 8 * lane + j; w0[j] = cw[xcol]; w1[j] = cw[1024 + xcol]; w2[j] = cw[2048 + xcol]; bi[j] = cb[xcol]; }
#pragma unroll 1
        for (int it = gw; it < MROWS / 16; it += ngw) {
            const int r0 = 16 * it;
            const int t0 = r0 < MXR ? (r0 & 8191) : ((r0 - MXR) & 255), len = r0 < MXR ? LX : LC;
            const bf16* src = ubc + (size_t)r0 * 512 + 8 * lane;
            u32x4 pm = t0 > 0 ? *(const u32x4*)(src - 512) : (u32x4){0u, 0u, 0u, 0u};
            u32x4 pc = *(const u32x4*)src;
#pragma unroll 4
            for (int i = 0; i < 16; ++i) {
                const u32x4 pn = (t0 + i < len - 1) ? *(const u32x4*)(src + (size_t)(i + 1) * 512) : (u32x4){0u, 0u, 0u, 0u};
                float a[8], c0[8], c2[8], o[8];
                cv_unpack(pm, a); cv_unpack(pc, c0); cv_unpack(pn, c2);
#pragma unroll
                for (int j = 0; j < 8; ++j) o[j] = siluf(w0[j] * a[j] + w1[j] * c0[j] + w2[j] * c2[j] + bi[j]);
                *(u32x4*)(abc + (size_t)(r0 + i) * 512 + 8 * lane) = pack8(o);
                pm = pc; pc = pn;
            }
        }
    }
}

struct SsdArgs {
    const bf16* axt; const bf16* abc; const bf16* abt; const bf16* uz; const float* udt; const float* dtb; const float* alog; const float* dvec;
    float* sst; float* dts; bf16* mix; float* ssq;
};
constexpr int XP = 72, BP = 136;

__device__ __forceinline__ void ssd_state_item(LAS unsigned char* lds, const SsdArgs& A, int b, int sc, int h, int tid, int wave, int lane) {
    LAS bf16* XsT = (LAS bf16*)lds;
    LAS bf16* BtT = XsT + 4 * 64 * XP;
    LAS float* wv = (LAS float*)(BtT + 4 * 128 * XP);
    LAS float* aend = wv + 512;
    const int g = h >> 2;
    const int row0 = sc == 32 ? MXR + b * LC : b * LX, tok0 = sc == 32 ? 0 : sc * 256;
    const int pt = wave & 3, half = wave >> 2, l15 = lane & 15, l4 = lane >> 4;
    const int Cg0 = (row0 + tok0) >> 6;
    u32x4 raw[4][3];
#pragma unroll
    for (int ci = 0; ci < 4; ++ci) {
        raw[ci][0] = *(const u32x4*)(A.axt + ((size_t)((Cg0 + ci) * 8 + h) * 64 + (tid >> 3)) * 64 + 8 * (tid & 7));
#pragma unroll
        for (int k = 0; k < 2; ++k) { const int e = tid + NTHR * k; raw[ci][1 + k] = *(const u32x4*)(A.abt + ((size_t)((Cg0 + ci) * 2 + g) * 128 + (e >> 3)) * 64 + 8 * (e & 7)); }
    }
    {
        const int dir = wave >> 2, ci = wave & 3, tok = dir ? 63 - lane : lane;
        const float rawv = A.udt[(size_t)(row0 + tok0 + 64 * ci + tok) * 16 + dir * 8 + h] + A.dtb[dir * 8 + h];
        const float dt = rawv > 20.f ? rawv : log1pf(__expf(rawv));
        float x = dt * (-__expf(A.alog[dir * 8 + h]));
#pragma unroll
        for (int off = 1; off < 64; off <<= 1) { const float y = __shfl_up(x, off); if (lane >= off) x += y; }
        const float ae = __shfl(x, 63);
        __syncthreads();
        wv[(dir * 4 + ci) * 64 + tok] = dt * __expf(ae - x);
        if (lane == 0) aend[dir * 4 + ci] = ae;
    }
#pragma unroll
    for (int ci = 0; ci < 4; ++ci) {
        *(LAS u32x4*)(XsT + (ci * 64 + (tid >> 3)) * XP + 8 * (tid & 7)) = raw[ci][0];
#pragma unroll
        for (int k = 0; k < 2; ++k) { const int e = tid + NTHR * k; *(LAS u32x4*)(BtT + (ci * 128 + (e >> 3)) * XP + 8 * (e & 7)) = raw[ci][1 + k]; }
    }
    __syncthreads();
#pragma unroll 1
    for (int dir = 0; dir < 2; ++dir) {
        f32x4 ST[4];
#pragma unroll
        for (int nt = 0; nt < 4; ++nt) ST[nt] = (f32x4){0.f, 0.f, 0.f, 0.f};
#pragma unroll 1
        for (int step = 0; step < 4; ++step) {
            const int ci = dir ? 3 - step : step;
            const float ea = __expf(aend[dir * 4 + ci]);
            bf16x8 xw[2];
#pragma unroll
            for (int kk = 0; kk < 2; ++kk) {
                const u32x4 xu = *(const LAS u32x4*)(XsT + (ci * 64 + 16 * pt + l15) * XP + 32 * kk + 8 * l4);
                const LAS float* wp = wv + (dir * 4 + ci) * 64 + 32 * kk + 8 * l4;
                const f32x4 w0 = *(const LAS f32x4*)wp, w1 = *(const LAS f32x4*)(wp + 4);
                u32x4 u; u.x = pk2(bflo(xu.x) * w0.x, bfhi(xu.x) * w0.y); u.y = pk2(bflo(xu.y) * w0.z, bfhi(xu.y) * w0.w); u.z = pk2(bflo(xu.z) * w1.x, bfhi(xu.z) * w1.y); u.w = pk2(bflo(xu.w) * w1.z, bfhi(xu.w) * w1.w);
                xw[kk] = __builtin_bit_cast(bf16x8, u);
            }
#pragma unroll
            for (int nt = 0; nt < 4; ++nt) {
                f32x4 acc = ST[nt] * ea;
                const LAS bf16* pa = BtT + (ci * 128 + 16 * (4 * half + nt) + l15) * XP + 8 * l4;
#pragma unroll
                for (int kk = 0; kk < 2; ++kk) acc = MFMA32(frag16(pa + 32 * kk), xw[kk], acc);
                ST[nt] = acc;
            }
        }
        float* slot = A.sst + ((size_t)(((b * 2 + dir) * 33 + sc) * 8 + h)) * 8192;
#pragma unroll
        for (int nt = 0; nt < 4; ++nt) *(f32x4*)(slot + (size_t)(16 * pt + l15) * 128 + 16 * (4 * half + nt) + 4 * l4) = ST[nt];
    }
    if (tid < 2) A.dts[((b * 2 + tid) * 33 + sc) * 8 + h] = __expf((aend[tid * 4] + aend[tid * 4 + 1]) + (aend[tid * 4 + 2] + aend[tid * 4 + 3]));
}

template <int MODE>
__device__ __forceinline__ void ssd_item(LAS unsigned char* lds, const SsdArgs& A, int b, int sc, int hp, int dir, int tid, int wave, int lane) {
    LAS bf16* Bt = (LAS bf16*)lds;
    LAS bf16* BtT = Bt + 64 * BP;
    LAS bf16* Ct = BtT + 128 * XP;
    LAS bf16* XsT0 = Ct + 64 * BP;
    LAS bf16* Mt0 = XsT0 + 2 * 64 * XP;
    LAS float* vec0 = (LAS float*)(Mt0 + 2 * 64 * XP);
    LAS float* SQ0 = vec0 + 2 * 272;
    const int hh = wave >> 2, pt = wave & 3, h = 2 * hp + hh, g = hp >> 1, l15 = lane & 15, l4 = lane >> 4;
    LAS bf16* XsT = XsT0 + hh * 64 * XP; LAS bf16* Mt = Mt0 + hh * 64 * XP;
    LAS float* dtv = vec0 + hh * 272, *acs = dtv + 64, *wv = dtv + 128, *eacs = dtv + 192, *misc = dtv + 256;
    LAS float* SQ = SQ0 + hh * 256;
    const int row0 = sc == 32 ? MXR + b * LC : b * LX, tok0 = sc == 32 ? 0 : sc * 256;
    const int Cg0 = (row0 + tok0) >> 6;
    const float* slot = A.sst + ((size_t)(((b * 2 + dir) * 33 + sc) * 8 + h)) * 8192;
    f32x4 ST[8];
#pragma unroll
    for (int nt = 0; nt < 8; ++nt) {
        if (sc == 32) ST[nt] = (f32x4){0.f, 0.f, 0.f, 0.f};
        else ST[nt] = *(const f32x4*)(slot + (size_t)(16 * pt + l15) * 128 + 16 * nt + 4 * l4);
    }
    const float a_h = -__expf(A.alog[dir * 8 + h]), dtb_h = A.dtb[dir * 8 + h], d_h = A.dvec[h];
    u32x4 raw[8]; float dtraw = 0.f;
#define SSD_ISSUE(ci) do { const int Cg = Cg0 + (ci); const size_t rb = (size_t)(row0 + tok0 + 64 * (ci)); \
        _Pragma("unroll") for (int k = 0; k < 2; ++k) { const int e = tid + NTHR * k; \
            raw[k] = *(const u32x4*)(A.axt + ((size_t)(Cg * 8 + 2 * hp + k) * 64 + (tid >> 3)) * 64 + 8 * (tid & 7)); \
            raw[2 + k] = *(const u32x4*)(A.abt + ((size_t)(Cg * 2 + g) * 128 + (e >> 3)) * 64 + 8 * (e & 7)); \
            raw[4 + k] = *(const u32x4*)(A.abc + (rb + (e >> 4)) * 512 + g * 128 + 8 * (e & 15)); \
            raw[6 + k] = *(const u32x4*)(A.abc + (rb + (e >> 4)) * 512 + 256 + g * 128 + 8 * (e & 15)); } \
        if (pt == 0) dtraw = A.udt[(rb + (dir ? 63 - lane : lane)) * 16 + dir * 8 + h]; } while (0)
    SSD_ISSUE(dir ? 3 : 0);
    __syncthreads();
#pragma unroll 1
    for (int i = 0; i < 4; ++i) {
        const int ci = dir ? 3 - i : i, tokc = tok0 + 64 * ci;
#pragma unroll
        for (int k = 0; k < 2; ++k) { const int e = tid + NTHR * k;
            *(LAS u32x4*)(XsT0 + (k * 64 + (tid >> 3)) * XP + 8 * (tid & 7)) = raw[k];
            *(LAS u32x4*)(BtT + (e >> 3) * XP + 8 * (e & 7)) = raw[2 + k];
            *(LAS u32x4*)(Bt + (e >> 4) * BP + 8 * (e & 15)) = raw[4 + k];
            *(LAS u32x4*)(Ct + (e >> 4) * BP + 8 * (e & 15)) = raw[6 + k]; }
        if (pt == 0) {
            const int tok = dir ? 63 - lane : lane;
            const float rawv = dtraw + dtb_h;
            const float dt = rawv > 20.f ? rawv : log1pf(__expf(rawv));
            float x = dt * a_h;
#pragma unroll
            for (int off = 1; off < 64; off <<= 1) { const float y = __shfl_up(x, off); if (lane >= off) x += y; }
            const float aend = __shfl(x, 63);
            dtv[tok] = dt; acs[tok] = x; wv[tok] = dt * __expf(aend - x); eacs[tok] = __expf(x);
            if (lane == 0) misc[0] = __expf(aend);
        }
        if (i < 3) SSD_ISSUE(dir ? 2 - i : i + 1);
        u32x2 pm_[4], pz_[4];
        if (MODE == 2) {
#pragma unroll
            for (int tt2 = 0; tt2 < 4; ++tt2) {
                const int t = tokc + 16 * tt2 + l15;
                pm_[tt2] = *(const u32x2*)(A.mix + (unsigned)((row0 + t) * DM + 512 + h * 64 + 16 * pt + 4 * l4));
                pz_[tt2] = *(const u32x2*)(A.uz + (unsigned)((row0 + t) * 512 + h * 64 + 16 * pt + 4 * l4));
            }
        }
        LBAR();
        {
            const int tt = wave >> 1;
#pragma unroll
            for (int j = 0; j < 2; ++j) {
                const int st = 2 * (wave & 1) + j;
                const bool live = dir ? st >= tt : st <= tt;
                f32x4 acc = (f32x4){0.f, 0.f, 0.f, 0.f};
                if (live) {
                    const LAS bf16* pa = Ct + (16 * tt + l15) * BP + 8 * l4; const LAS bf16* pb = Bt + (16 * st + l15) * BP + 8 * l4;
                    bf16x8 fa_[4], fb_[4];
#pragma unroll
                    for (int kk = 0; kk < 4; ++kk) { fa_[kk] = frag16(pa + 32 * kk); fb_[kk] = frag16(pb + 32 * kk); }
#pragma unroll
                    for (int kk = 0; kk < 4; ++kk) acc = MFMA32(fa_[kk], fb_[kk], acc);
                }
                const int sI = 16 * st + l15;
#pragma unroll
                for (int q = 0; q < 2; ++q) {
                    const LAS float* dq = vec0 + q * 272; const float as = dq[64 + sI], ds = dq[sI];
#pragma unroll
                    for (int r = 0; r < 4; ++r) { const int tI = 16 * tt + 4 * l4 + r;
                        const bool ok = live && (dir ? sI >= tI : sI <= tI);
                        Mt0[(q * 64 + tI) * XP + sI] = (bf16)f2bf(ok ? acc[r] * __expf(dq[64 + tI] - as) * ds : 0.f); }
                }
            }
            LBAR();
            bf16x8 STf[4];
#pragma unroll
            for (int m = 0; m < 4; ++m) STf[m] = pack_acc2(ST[2 * m], ST[2 * m + 1]);
            const bf16x8 xf0 = frag16(XsT + (16 * pt + l15) * XP + 8 * l4), xf1 = frag16(XsT + (16 * pt + l15) * XP + 32 + 8 * l4);
#pragma unroll
            for (int tt2 = 0; tt2 < 4; ++tt2) {
                const int tI = 16 * tt2 + l15;
                f32x4 accS = (f32x4){0.f, 0.f, 0.f, 0.f}, accI = (f32x4){0.f, 0.f, 0.f, 0.f};
                bf16x8 cf_[4]; const bf16x8 mf0 = frag16(Mt + tI * XP + 8 * l4), mf1 = frag16(Mt + tI * XP + 32 + 8 * l4);
#pragma unroll
                for (int m = 0; m < 4; ++m) { const LAS bf16* pc = Ct + tI * BP + 32 * m + 4 * l4; cf_[m] = frag2x8(pc, pc + 16); }
#pragma unroll
                for (int m = 0; m < 4; ++m) accS = MFMA32(STf[m], cf_[m], accS);
                if (dir ? (1 >= tt2) : true) accI = MFMA32(xf0, mf0, accI);
                if (dir ? true : (2 <= tt2)) accI = MFMA32(xf1, mf1, accI);
                f32x4 yv = accI + accS * eacs[tI];
                const int t = tokc + tI;
                bf16* mp = A.mix + (unsigned)((row0 + t) * DM + 512 + h * 64 + 16 * pt + 4 * l4);
                if (MODE == 2) {
                    const LAS bf16* xp = XsT + (16 * pt + 4 * l4) * XP + tI;
                    yv[0] = (yv[0] + bflo(pm_[tt2].x) + d_h * bf2f(xp[0])) * siluf(bflo(pz_[tt2].x)); yv[1] = (yv[1] + bfhi(pm_[tt2].x) + d_h * bf2f(xp[XP])) * siluf(bfhi(pz_[tt2].x));
                    yv[2] = (yv[2] + bflo(pm_[tt2].y) + d_h * bf2f(xp[2 * XP])) * siluf(bflo(pz_[tt2].y)); yv[3] = (yv[3] + bfhi(pm_[tt2].y) + d_h * bf2f(xp[3 * XP])) * siluf(bfhi(pz_[tt2].y));
                    float qq = (yv[0] * yv[0] + yv[1] * yv[1]) + (yv[2] * yv[2] + yv[3] * yv[3]);
                    qq += __shfl_xor(qq, 16); qq += __shfl_xor(qq, 32);
                    if (l4 == 0) SQ[pt * 64 + tI] = qq;
                }
                u32x2 o; o.x = pk2(yv[0], yv[1]); o.y = pk2(yv[2], yv[3]);
                *(u32x2*)mp = o;
            }
        }
        {
            const float ea = misc[0];
            bf16x8 xw[2];
#pragma unroll
            for (int kk = 0; kk < 2; ++kk) {
                const u32x4 xu = *(const LAS u32x4*)(XsT + (16 * pt + l15) * XP + 32 * kk + 8 * l4);
                const f32x4 w0 = *(const LAS f32x4*)(wv + 32 * kk + 8 * l4), w1 = *(const LAS f32x4*)(wv + 32 * kk + 8 * l4 + 4);
                u32x4 u; u.x = pk2(bflo(xu.x) * w0.x, bfhi(xu.x) * w0.y); u.y = pk2(bflo(xu.y) * w0.z, bfhi(xu.y) * w0.w); u.z = pk2(bflo(xu.z) * w1.x, bfhi(xu.z) * w1.y); u.w = pk2(bflo(xu.w) * w1.z, bfhi(xu.w) * w1.w);
                xw[kk] = __builtin_bit_cast(bf16x8, u);
            }
            bf16x8 af_[8][2];
#pragma unroll
            for (int nt = 0; nt < 8; ++nt) { const LAS bf16* pa = BtT + (16 * nt + l15) * XP + 8 * l4; af_[nt][0] = frag16(pa); af_[nt][1] = frag16(pa + 32); }
#pragma unroll
            for (int nt = 0; nt < 8; ++nt) ST[nt] = MFMA32(af_[nt][1], xw[1], MFMA32(af_[nt][0], xw[0], ST[nt] * ea));
        }
        LBAR();
        if (MODE == 2 && tid < 128) { const int q = tid >> 6, tI = tid & 63; const LAS float* sq = SQ0 + q * 256 + tI;
            A.ssq[(size_t)(row0 + tokc + tI) * 8 + 2 * hp + q] = (sq[0] + sq[64]) + (sq[128] + sq[192]); }
    }
#undef SSD_ISSUE
    __syncthreads();
}

struct HgArgs {
    const bf16* uhg; const float* lb0; const float* lb1; const float* normg; int layer;
    float* hst; float* dth; bf16* mix;
};
constexpr int HP = 72, PP = 40, HG_LDS_BYTES = (3 * 32 * HP + 2 * 64 * PP + 32 * PP) * 2 + (256 + 64 + 128 + 32) * 4;
template <int MODE>
__device__ __forceinline__ void hg_item(LAS unsigned char* lds, const HgArgs& A, int b, int sc, int hp, int dir, int tid, int lane) {
    const int hgp = tid >> 8, tg = tid & 255, hw = (tid >> 6) & 3, h = 2 * hp + hgp;
    LAS bf16* Qt = (LAS bf16*)(lds + hgp * HG_LDS_BYTES);
    LAS bf16* Kt = Qt + 32 * HP;
    LAS bf16* Qh = Kt + 32 * HP;
    LAS bf16* KhT = Qh + 32 * HP;
    LAS bf16* VtT = KhT + 64 * PP;
    LAS bf16* Pm = VtT + 64 * PP;
    LAS float* tot = (LAS float*)(Pm + 32 * PP);
    LAS float* ebend = tot + 256;
    LAS float* SQ = ebend + 64;
    LAS float* rstd = SQ + 128;
    const int row0 = sc == 32 ? MXR + b * LC : b * LX, tok0 = sc == 32 ? 0 : sc * 256;
    const int l15 = lane & 15, l4 = lane >> 4, vt = hw;
    float* slot = A.hst + ((size_t)(((b * 2 + dir) * 33 + sc) * 4 + h)) * 4096;
    f32x4 S[4];
#pragma unroll
    for (int kt = 0; kt < 4; ++kt) {
        if (MODE == 0 || sc == 32) S[kt] = (f32x4){0.f, 0.f, 0.f, 0.f};
        else S[kt] = *(const f32x4*)(slot + (size_t)(16 * vt + l15) * 64 + 16 * kt + 4 * l4);
    }
    const int tau = tg >> 3, kg = tg & 7;
    float lbv[8], sumb[8];
#pragma unroll
    for (int j = 0; j < 8; ++j) { const int k = h * 64 + 8 * kg + j; lbv[j] = A.layer == 0 ? 0.f : sigmf(A.lb1[k] - A.lb0[k]); sumb[j] = 0.f; }
    u32x4 qv, fv, vv;
#define HG_ISSUE(ci) do { const int s_ = 32 * (ci) + tau, t_ = dir ? tok0 + 255 - s_ : tok0 + s_; \
        const bf16* up_ = A.uhg + (size_t)(row0 + t_) * 1280 + h * 64 + 8 * kg; \
        qv = *(const u32x4*)up_; fv = *(const u32x4*)(up_ + 256 + dir * 256); vv = *(const u32x4*)(up_ + 768); } while (0)
    HG_ISSUE(0);
    __syncthreads();
#pragma unroll 1
    for (int i = 0; i < 8; ++i) {
        float q[8], f[8], v[8], kk[8], bb[8];
        q[0] = bflo(qv.x); q[1] = bfhi(qv.x); q[2] = bflo(qv.y); q[3] = bfhi(qv.y); q[4] = bflo(qv.z); q[5] = bfhi(qv.z); q[6] = bflo(qv.w); q[7] = bfhi(qv.w);
        f[0] = bflo(fv.x); f[1] = bfhi(fv.x); f[2] = bflo(fv.y); f[3] = bfhi(fv.y); f[4] = bflo(fv.z); f[5] = bfhi(fv.z); f[6] = bflo(fv.w); f[7] = bfhi(fv.w);
        v[0] = bflo(vv.x); v[1] = bfhi(vv.x); v[2] = bflo(vv.y); v[3] = bfhi(vv.y); v[4] = bflo(vv.z); v[5] = bfhi(vv.z); v[6] = bflo(vv.w); v[7] = bfhi(vv.w);
        if (i < 7) HG_ISSUE(i + 1);
#pragma unroll
        for (int j = 0; j < 8; ++j) {
            const float sg = sigmf(f[j]);
            const float fj = lbv[j] + (1.0f - lbv[j]) * sg;
            kk[j] = (1.0f - lbv[j]) * (1.0f - sg);
            float x = lbv[j] == 0.f ? fminf(f[j], 0.f) - __logf(1.0f + __expf(-fabsf(f[j]))) : __logf(fj);
#pragma unroll
            for (int off = 8; off < 64; off <<= 1) { const float y = __shfl_up(x, off); if (lane >= off) x += y; }
            bb[j] = x;
        }
        if (lane >= 56) {
#pragma unroll
            for (int j = 0; j < 8; ++j) tot[hw * 64 + 8 * kg + j] = bb[j];
        }
        LBAR();
        {
            float oq[8], ok[8], oh[8];
#pragma unroll
            for (int j = 0; j < 8; ++j) {
                const int k = 8 * kg + j;
                const float t0 = tot[k], t1 = tot[64 + k], t2 = tot[128 + k], t3 = tot[192 + k];
                const float off = hw == 0 ? 0.f : (hw == 1 ? t0 : (hw == 2 ? t0 + t1 : t0 + t1 + t2));
                const float bj = bb[j] + off, bmid = t0 + t1, bend = (t0 + t1) + (t2 + t3);
                oq[j] = q[j] * 0.125f * __expf(bj - bmid); ok[j] = kk[j] * __expf(bmid - bj); oh[j] = q[j] * 0.125f * __expf(bj);
                KhT[k * PP + tau] = (bf16)f2bf(kk[j] * __expf(bend - bj)); VtT[k * PP + tau] = (bf16)f2bf(v[j]);
                if (tau == 0) { ebend[k] = __expf(bend); sumb[j] += bend; }
            }
            if (MODE != 0) { *(LAS u32x4*)(Qt + tau * HP + 8 * kg) = pack8(oq); *(LAS u32x4*)(Kt + tau * HP + 8 * kg) = pack8(ok); *(LAS u32x4*)(Qh + tau * HP + 8 * kg) = pack8(oh); }
        }
        LBAR();
        u32x2 pv_[2], gz[2];
        if (MODE == 2) {
#pragma unroll
            for (int tt = 0; tt < 2; ++tt) { const int tI = 16 * tt + l15, s2 = 32 * i + tI, t2 = dir ? tok0 + 255 - s2 : tok0 + s2;
                pv_[tt] = *(const u32x2*)(A.mix + (unsigned)((row0 + t2) * DM + h * 64 + 16 * vt + 4 * l4));
                gz[tt] = *(const u32x2*)(A.uhg + (unsigned)((row0 + t2) * 1280 + 1024 + h * 64 + 16 * vt + 4 * l4)); }
        }
        if (MODE != 0) {
            {
                const int tt = hw >> 1, st = hw & 1;
                f32x4 acc = (f32x4){0.f, 0.f, 0.f, 0.f};
                if (st <= tt) {
                    const LAS bf16* pa = Qt + (16 * tt + l15) * HP + 8 * l4; const LAS bf16* pb = Kt + (16 * st + l15) * HP + 8 * l4;
                    acc = MFMA32(frag16(pa), frag16(pb), acc); acc = MFMA32(frag16(pa + 32), frag16(pb + 32), acc);
                }
#pragma unroll
                for (int r = 0; r < 4; ++r) { const int tI = 16 * tt + 4 * l4 + r, sI = 16 * st + l15; Pm[tI * PP + sI] = (bf16)f2bf((st <= tt && sI <= tI) ? acc[r] : 0.f); }
            }
            LBAR();
            bf16x8 Sf[2];
#pragma unroll
            for (int m = 0; m < 2; ++m) Sf[m] = pack_acc2(S[2 * m], S[2 * m + 1]);
            const bf16x8 vf = frag16(VtT + (16 * vt + l15) * PP + 8 * l4);
            f32x4 oacc[2];
#pragma unroll
            for (int tt = 0; tt < 2; ++tt) {
                f32x4 acc = (f32x4){0.f, 0.f, 0.f, 0.f};
                acc = MFMA32(vf, frag16(Pm + (16 * tt + l15) * PP + 8 * l4), acc);
#pragma unroll
                for (int m = 0; m < 2; ++m) { const LAS bf16* pq = Qh + (16 * tt + l15) * HP + 32 * m + 4 * l4;
                    acc = MFMA32(Sf[m], frag2x8(pq, pq + 16), acc); }
                oacc[tt] = acc;
            }
            if (MODE == 1) {
#pragma unroll
                for (int tt = 0; tt < 2; ++tt) { const int tI = 16 * tt + l15, s2 = 32 * i + tI, t2 = dir ? tok0 + 255 - s2 : tok0 + s2;
                    u32x2 o; o.x = pk2(oacc[tt][0], oacc[tt][1]); o.y = pk2(oacc[tt][2], oacc[tt][3]);
                    *(u32x2*)(A.mix + (unsigned)((row0 + t2) * DM + h * 64 + 16 * vt + 4 * l4)) = o; }
            } else {
#pragma unroll
                for (int tt = 0; tt < 2; ++tt) { const int tI = 16 * tt + l15; const u32x2 pv = pv_[tt];
                    oacc[tt][0] += bflo(pv.x); oacc[tt][1] += bfhi(pv.x); oacc[tt][2] += bflo(pv.y); oacc[tt][3] += bfhi(pv.y);
                    float qq = (oacc[tt][0] * oacc[tt][0] + oacc[tt][1] * oacc[tt][1]) + (oacc[tt][2] * oacc[tt][2] + oacc[tt][3] * oacc[tt][3]);
                    qq += __shfl_xor(qq, 16); qq += __shfl_xor(qq, 32);
                    if (l4 == 0) SQ[vt * 32 + tI] = qq; }
                LBAR();
                const f32x4 ng = *(const f32x4*)(A.normg + h * 64 + 16 * vt + 4 * l4);
#pragma unroll
                for (int tt = 0; tt < 2; ++tt) { const int tI = 16 * tt + l15, s2 = 32 * i + tI, t2 = dir ? tok0 + 255 - s2 : tok0 + s2;
                    const float rs = 1.0f / sqrtf(((SQ[tI] + SQ[32 + tI]) + (SQ[64 + tI] + SQ[96 + tI])) * (1.0f / 64.0f) + EPS);
                    u32x2 o; o.x = pk2(oacc[tt][0] * rs * ng.x * siluf(bflo(gz[tt].x)), oacc[tt][1] * rs * ng.y * siluf(bfhi(gz[tt].x)));
                    o.y = pk2(oacc[tt][2] * rs * ng.z * siluf(bflo(gz[tt].y)), oacc[tt][3] * rs * ng.w * siluf(bfhi(gz[tt].y)));
                    *(u32x2*)(A.mix + (unsigned)((row0 + t2) * DM + h * 64 + 16 * vt + 4 * l4)) = o; }
            }
        }
        {
            const bf16x8 vf2 = frag16(VtT + (16 * vt + l15) * PP + 8 * l4);
#pragma unroll
            for (int kt = 0; kt < 4; ++kt) {
                f32x4 acc;
#pragma unroll
                for (int r = 0; r < 4; ++r) acc[r] = S[kt][r] * ebend[16 * kt + 4 * l4 + r];
                S[kt] = MFMA32(frag16(KhT + (16 * kt + l15) * PP + 8 * l4), vf2, acc);
            }
        }
        LBAR();
    }
#undef HG_ISSUE
    if (MODE == 0) {
#pragma unroll
        for (int kt = 0; kt < 4; ++kt) *(f32x4*)(slot + (size_t)(16 * vt + l15) * 64 + 16 * kt + 4 * l4) = S[kt];
        if (tau == 0) {
#pragma unroll
            for (int j = 0; j < 8; ++j) A.dth[((size_t)(((b * 2 + dir) * 33 + sc) * 4 + h)) * 64 + 8 * kg + j] = __expf(sumb[j]);
        }
    }
    __syncthreads();
}


constexpr int SP = 264;
__device__ __forceinline__ void hg_state_item(LAS unsigned char* lds, const HgArgs& A, int b, int sc, int h, int tid, int wave, int lane) {
    LAS bf16* KfT = (LAS bf16*)lds;
    LAS bf16* KbT = KfT + 64 * SP;
    LAS bf16* VtT = KbT + 64 * SP;
    const int row0 = sc == 32 ? MXR + b * LC : b * LX, tok0 = sc == 32 ? 0 : sc * 256;
    const int kg = wave, l15 = lane & 15, l4 = lane >> 4;
    u32x4 fa[4], fb[4], va[4];
#pragma unroll
    for (int e = 0; e < 4; ++e) { const bf16* up = A.uhg + (size_t)(row0 + tok0 + 4 * lane + e) * 1280 + h * 64 + 8 * kg;
        fa[e] = *(const u32x4*)(up + 256); fb[e] = *(const u32x4*)(up + 512); va[e] = *(const u32x4*)(up + 768); }
    float lbv[8];
#pragma unroll
    for (int j = 0; j < 8; ++j) { const int k = h * 64 + 8 * kg + j; lbv[j] = A.layer == 0 ? 0.f : sigmf(A.lb1[k] - A.lb0[k]); }
    __syncthreads();
#pragma unroll
    for (int dir = 0; dir < 2; ++dir) {
        float lf[4][8], kk[4][8];
#pragma unroll
        for (int e = 0; e < 4; ++e) { float f[8]; cv_unpack(dir ? fb[e] : fa[e], f);
#pragma unroll
            for (int j = 0; j < 8; ++j) { const float sg = sigmf(f[j]); kk[e][j] = (1.0f - lbv[j]) * (1.0f - sg);
                lf[e][j] = lbv[j] == 0.f ? fminf(f[j], 0.f) - __logf(1.0f + __expf(-fabsf(f[j]))) : __logf(lbv[j] + (1.0f - lbv[j]) * sg); } }
#pragma unroll
        for (int j = 0; j < 8; ++j) {
            const float tsum = (lf[0][j] + lf[1][j]) + (lf[2][j] + lf[3][j]);
            float x = tsum;
            if (!dir) {
#pragma unroll
                for (int off = 1; off < 64; off <<= 1) { const float y = __shfl_up(x, off); if (lane >= off) x += y; }
            } else {
#pragma unroll
                for (int off = 1; off < 64; off <<= 1) { const float y = __shfl_down(x, off); if (lane + off < 64) x += y; }
            }
            const float total = __shfl(x, dir ? 0 : 63);
            const float rest = total - x;
            float aft[4];
            if (!dir) { aft[3] = rest; aft[2] = aft[3] + lf[3][j]; aft[1] = aft[2] + lf[2][j]; aft[0] = aft[1] + lf[1][j]; }
            else { aft[0] = rest; aft[1] = aft[0] + lf[0][j]; aft[2] = aft[1] + lf[1][j]; aft[3] = aft[2] + lf[2][j]; }
            LAS bf16* d = (dir ? KbT : KfT) + (8 * kg + j) * SP + 4 * lane;
            u32x2 o; o.x = pk2(kk[0][j] * __expf(aft[0]), kk[1][j] * __expf(aft[1])); o.y = pk2(kk[2][j] * __expf(aft[2]), kk[3][j] * __expf(aft[3]));
            *(LAS u32x2*)d = o;
            if (lane == 0) A.dth[((size_t)(((b * 2 + dir) * 33 + sc) * 4 + h)) * 64 + 8 * kg + j] = __expf(total);
        }
    }
    {
        float v[4][8];
#pragma unroll
        for (int e = 0; e < 4; ++e) cv_unpack(va[e], v[e]);
#pragma unroll
        for (int j = 0; j < 8; ++j) { u32x2 o; o.x = pk2(v[0][j], v[1][j]); o.y = pk2(v[2][j], v[3][j]); *(LAS u32x2*)(VtT + (8 * kg + j) * SP + 4 * lane) = o; }
    }
    __syncthreads();
    const int kt = wave & 3, vt0 = 2 * (wave >> 2);
#pragma unroll
    for (int dir = 0; dir < 2; ++dir) {
        f32x4 S0 = (f32x4){0.f, 0.f, 0.f, 0.f}, S1 = S0;
        const LAS bf16* pa = (dir ? KbT : KfT) + (16 * kt + l15) * SP + 8 * l4;
        const LAS bf16* pb0 = VtT + (16 * vt0 + l15) * SP + 8 * l4; const LAS bf16* pb1 = pb0 + 16 * SP;
#pragma unroll
        for (int kk8 = 0; kk8 < 8; ++kk8) { const bf16x8 af = frag16(pa + 32 * kk8); S0 = MFMA32(af, frag16(pb0 + 32 * kk8), S0); S1 = MFMA32(af, frag16(pb1 + 32 * kk8), S1); }
        float* slot = A.hst + ((size_t)(((b * 2 + dir) * 33 + sc) * 4 + h)) * 4096;
        *(f32x4*)(slot + (size_t)(16 * vt0 + l15) * 64 + 16 * kt + 4 * l4) = S0;
        *(f32x4*)(slot + (size_t)(16 * (vt0 + 1) + l15) * 64 + 16 * kt + 4 * l4) = S1;
    }
}
__device__ __forceinline__ void state_scan(float* sst, const float* dts, float* hst, const float* dth, int gid) {
    if (gid < 65536) {
        const int bd = gid >> 14, e = gid & 16383, h = e >> 11, dir = bd & 1;
        float* base = sst + ((size_t)(bd * 33) * 8 + h) * 8192 + (size_t)(e & 2047) * 4;
        f32x4 carry = *(const f32x4*)(base + (size_t)32 * 8 * 8192);
        float* p = base + (size_t)(dir ? 31 : 0) * 8 * 8192; const long pstep = dir ? -(long)(8 * 8192) : (long)(8 * 8192);
        const float* dp = dts + (bd * 33 + (dir ? 31 : 0)) * 8 + h; const int dstep = dir ? -8 : 8;
#pragma unroll 4
        for (int jj = 0; jj < 32; ++jj) {
            const f32x4 loc = *(const f32x4*)p; *(f32x4*)p = carry;
            carry = carry * (*dp) + loc; p += pstep; dp += dstep; }
    } else if (gid < 65536 + 16384) {
        const int g2 = gid - 65536, bd = g2 >> 12, e = g2 & 4095, h = e >> 10, dir = bd & 1, k0 = (e & 15) * 4;
        float* base = hst + ((size_t)(bd * 33) * 4 + h) * 4096 + (size_t)(e & 1023) * 4;
        f32x4 carry = *(const f32x4*)(base + (size_t)32 * 4 * 4096);
        float* p = base + (size_t)(dir ? 31 : 0) * 4 * 4096; const long pstep = dir ? -(long)(4 * 4096) : (long)(4 * 4096);
        const float* dp = dth + ((size_t)((bd * 33 + (dir ? 31 : 0)) * 4 + h)) * 64 + k0; const int dstep = dir ? -256 : 256;
#pragma unroll 4
        for (int jj = 0; jj < 32; ++jj) {
            const f32x4 loc = *(const f32x4*)p; *(f32x4*)p = carry;
            const f32x4 d = *(const f32x4*)dp;
            carry = carry * d + loc; p += pstep; dp += dstep; }
    }
}

__device__ __forceinline__ void mf_hy_tile(LAS unsigned char* lds, const bf16* hyoT, bf16* mix, int tile, int tid) {
    LAS bf16* T = (LAS bf16*)lds;
    __syncthreads();
    { const int ch = tid >> 1, hf = tid & 1; const u32x4* src = (const u32x4*)(hyoT + (size_t)ch * MROWS + tile * 64 + hf * 32);
#pragma unroll
      for (int j = 0; j < 4; ++j) *(LAS u32x4*)(T + ch * 72 + hf * 32 + 8 * j) = src[j]; }
    __syncthreads();
    { const int tok = tid >> 3, cgp = tid & 7;
      bf16* dst = mix + (size_t)(tile * 64 + tok) * DM + 256 + cgp * 32;
#pragma unroll
      for (int j = 0; j < 4; ++j) { u32x4 o;
          unsigned w[4];
#pragma unroll
          for (int e = 0; e < 4; ++e) { const int c0 = cgp * 32 + 8 * j + 2 * e; w[e] = (unsigned)T[c0 * 72 + tok] | ((unsigned)T[(c0 + 1) * 72 + tok] << 16); }
          o.x = w[0]; o.y = w[1]; o.z = w[2]; o.w = w[3];
          *(u32x4*)(dst + 8 * j) = o; } }
    __syncthreads();
}
__device__ __forceinline__ void mf_ssd_rows(bf16* mix, const float* ssq, const float* ng, int row_first, int nrows, int gw, int ngw, int lane) {
    const f32x4 g0 = *(const f32x4*)(ng + 8 * lane), g1 = *(const f32x4*)(ng + 8 * lane + 4);
    const int grp = lane >> 5;
#pragma unroll 1
    for (int m = row_first + gw; m < row_first + nrows; m += ngw) {
        const f32x4 q = *(const f32x4*)(ssq + (size_t)m * 8 + 4 * grp);
        const float r = 1.0f / sqrtf(((q.x + q.y) + (q.z + q.w)) * (1.0f / 256.0f) + EPS);
        bf16* p = mix + (size_t)m * DM + 512 + 8 * lane;
        const u32x4 v = *(const u32x4*)p; u32x4 o;
        o.x = pk2(bflo(v.x) * r * g0.x, bfhi(v.x) * r * g0.y); o.y = pk2(bflo(v.y) * r * g0.z, bfhi(v.y) * r * g0.w);
        o.z = pk2(bflo(v.z) * r * g1.x, bfhi(v.z) * r * g1.y); o.w = pk2(bflo(v.w) * r * g1.z, bfhi(v.w) * r * g1.w);
        *(u32x4*)p = o;
    }
}
__device__ __forceinline__ void mf_ctx_rows(const bf16* mix, const float* ssq, const float* ng, int row_first, bf16* priv, int wave, int lane) {
    const f32x4 g0 = *(const f32x4*)(ng + 8 * lane), g1 = *(const f32x4*)(ng + 8 * lane + 4);
    const int grp = lane >> 5;
#pragma unroll 2
    for (int i = wave; i < 256; i += NWAVES) {
        const int m = row_first + i;
        const f32x4 q = *(const f32x4*)(ssq + (size_t)m * 8 + 4 * grp);
        const float r = 1.0f / sqrtf(((q.x + q.y) + (q.z + q.w)) * (1.0f / 256.0f) + EPS);
        const u32x4 lo = *(const u32x4*)(mix + (size_t)m * DM + 8 * lane);
        const u32x4 v = *(const u32x4*)(mix + (size_t)m * DM + 512 + 8 * lane); u32x4 o;
        o.x = pk2(bflo(v.x) * r * g0.x, bfhi(v.x) * r * g0.y); o.y = pk2(bflo(v.y) * r * g0.z, bfhi(v.y) * r * g0.w);
        o.z = pk2(bflo(v.z) * r * g1.x, bfhi(v.z) * r * g1.y); o.w = pk2(bflo(v.w) * r * g1.z, bfhi(v.w) * r * g1.w);
        *(u32x4*)(priv + (size_t)i * DM + 8 * lane) = lo;
        *(u32x4*)(priv + (size_t)i * DM + 512 + 8 * lane) = o;
    }
}
#ifndef MK_PER_PHASE
#define MK_PER_PHASE 0
#endif
#ifndef SPLITK_CTX
#define SPLITK_CTX 1
#endif
constexpr int PH_PER_LAYER = 13, NPHASES = 1 + 2 * PH_PER_LAYER + 1;
struct Args { const float* in[34]; float* out; unsigned char* ws; int ph_lo, ph_hi; };

__global__ void __launch_bounds__(NTHR, 2) hybrid_fwd(Args args) {
    extern __shared__ __attribute__((aligned(16))) unsigned char lds_raw[];
    LAS unsigned char* lds = (LAS unsigned char*)lds_raw;
    volatile LAS unsigned* MISC = (volatile LAS unsigned*)(lds + MISC_OFF);
    const int tid0 = threadIdx.x;
    const int G = gridDim.x, bid = blockIdx.x;
    const int ngw = G * NWAVES, ngt = G * NTHR;
    unsigned char* ws = args.ws;
    for (int u = tid0; u < 32; u += NTHR) MISC[u] = 0u;
    __syncthreads();
    XcdBarrier bar; bar.bar = (unsigned*)(ws + WS_CTL) + CW_BAR; bar.x = 0; bar.st = nullptr;
    if (!MK_PER_PHASE) bar = xcd_barrier_post((unsigned*)(ws + WS_CTL) + CW_BAR, MISC + 8);
    const int lo = args.ph_lo, hi = args.ph_hi;
#ifndef PHMASK
#define PHMASK 0xFFFF
#endif
#define ENA(b) (((PHMASK) >> (b)) & 1)
#ifndef SUBMASK
#define SUBMASK 0xFF
#endif
#define SUB(b) (((SUBMASK) >> (b)) & 1)
#define IN(k) (lo <= (k) && (k) < hi)
#ifndef TIME_MASK
#define TIME_MASK 0u
#endif
#ifndef TIME_MULT
#define TIME_MULT 8
#endif
#ifndef TIME_KIND
#define TIME_KIND 0
#endif
    unsigned long long tsum = 0ull, tbeg = 0ull;
#define SEAM(k) do { if (IN(k) && IN((k) + 1)) xcd_barrier(bar); if (TIME_MASK) { const unsigned long long tnow = __builtin_amdgcn_s_memrealtime(); if ((TIME_MASK >> (k)) & 1u) tsum += tnow - tbeg; tbeg = tnow; } } while (0)
#define NEXT_ITEM(qidx) ({ __syncthreads(); if (tid0 == 0) MISC[16] = __hip_atomic_fetch_add((unsigned*)(ws + WS_CTL) + 8192 + 64 * (qidx), 1u, __ATOMIC_RELAXED, __HIP_MEMORY_SCOPE_AGENT); __syncthreads(); (int)MISC[16]; })
#define FRESH_IDS() int tid_ = tid0; asm volatile("" : "+v"(tid_)); const int tid = tid_, lane = tid & 63, wave = __builtin_amdgcn_readfirstlane(tid >> 6); const int gw = bid * NWAVES + wave, gtid = bid * NTHR + tid; LAS float* wscr = (LAS float*)(lds + wave * 16384); (void)lane; (void)gw; (void)gtid; (void)wscr

    const float* x_in = args.in[0]; const float* c_in = args.in[1]; const float* ctx_in = args.in[2]; const float* cctx_in = args.in[3];
    const float* w_ada = args.in[4]; const float* b_ada = args.in[5]; const float* norm1_g = args.in[6]; const float* norm2_g = args.in[7];
    const float* w_in = args.in[8]; const float* w_out = args.in[9]; const float* hg_lb = args.in[10]; const float* hg_norm_g = args.in[11];
    const float* hy_conv_w = args.in[12]; const float* hy_conv_b = args.in[13]; const float* hy_w1 = args.in[14]; const float* hy_b1 = args.in[15]; const float* hy_f1 = args.in[16];
    const float* hy_w2 = args.in[17]; const float* hy_b2 = args.in[18]; const float* hy_f2 = args.in[19]; const float* hy_w3 = args.in[20]; const float* hy_bias = args.in[21];
    const float* ssd_conv_w = args.in[22]; const float* ssd_conv_b = args.in[23]; const float* ssd_dt_bias = args.in[24]; const float* ssd_a_log = args.in[25]; const float* ssd_d = args.in[26];
    const float* ssd_norm_g = args.in[27]; const float* ffn_w_gate = args.in[28]; const float* ffn_w_up = args.in[29]; const float* ffn_conv_w = args.in[30]; const float* ffn_conv_b = args.in[31];
    const float* ffn_w_down = args.in[32]; const float* final_norm_g = args.in[33];
    float* xs_out = args.out;
    float* mods = (float*)(ws + WS_MODS); float* ctxs = (float*)(ws + WS_CTXS); bf16* h2b = (bf16*)(ws + WS_H2); float* h2c = (float*)(ws + WS_H2C);
    float* ssq = (float*)(ws + WS_SSQ); float* dts = (float*)(ws + WS_DTS); float* dth = (float*)(ws + WS_DTH); float* udt = (float*)(ws + WS_UDT);
    bf16* Win = (bf16*)(ws + WS_WIN); bf16* Wout = (bf16*)(ws + WS_WOUT); bf16* hn = (bf16*)(ws + WS_HN); f32x2* Hs = (f32x2*)(ws + WS_HN);
    bf16* uhg = (bf16*)(ws + WS_UHG); bf16* uhyT = (bf16*)(ws + WS_UHY); bf16* uz = (bf16*)(ws + WS_UZ); bf16* uxs = (bf16*)(ws + WS_UXS); bf16* ubc = (bf16*)(ws + WS_UBC); bf16* axt = (bf16*)(ws + WS_AXT); bf16* abc = (bf16*)(ws + WS_ABC); bf16* abt = (bf16*)(ws + WS_ABT); float* sst = (float*)(ws + WS_SST); float* hst = (float*)(ws + WS_HST);
    float* slabO = (float*)(ws + WS_UHG); float* slabF = (float*)(ws + WS_A);
    bf16* mix = (bf16*)(ws + WS_MIX); bf16* fa = (bf16*)(ws + WS_A); bf16* fup = (bf16*)(ws + WS_UP); bf16* Wgu = (bf16*)(ws + WS_WGU); bf16* Wd = (bf16*)(ws + WS_WD);

    if (TIME_MASK) tbeg = __builtin_amdgcn_s_memrealtime();
    if (ENA(14) && IN(0)) {
        FRESH_IDS();
#pragma unroll 1
        for (int it = bid; it < 192; it += G) if (SUB(4)) p0_mods_item(c_in, cctx_in, w_ada, b_ada, mods, (LAS float*)lds, it, tid, wave, lane);
#pragma unroll 1
        for (int v = 0; v < 3; ++v) {
            const int hl = v == 1 ? 1 : 0;
            if (SUB(6)) p0_h2_rows(hy_w1 + hl * 33 * 64, hy_b1 + hl * 64, hy_f1 + hl * 64, hy_w2 + hl * 64 * 64, hy_b2 + hl * 64, hy_f2 + hl * 64, h2c, v == 2 ? (bf16*)nullptr : h2b + (size_t)hl * LX * 64, v == 2 ? LC : LX, gw, ngw, lane);
        }
        __syncthreads();
        if (SUB(7)) { convert_weight(w_in, 1024, NINP, 3600, Win, wscr, gw, ngw, lane);
        convert_weight(w_out, 1024, 1024, 1024, Wout, wscr, gw, ngw, lane); }
    }
    SEAM(0);

    for (int l = 0; l < 2; ++l) {
        const int P = 1 + l * PH_PER_LAYER;
        const float* mods_l = mods + (size_t)l * 3 * 6144;
        const int nrows = l == 0 ? MROWS : MXR;
        if (ENA(0) && IN(P + 0)) {
            FRESH_IDS();
            if (l == 1) { __syncthreads();
                convert_weight(w_in + (size_t)1024 * 3600, 1024, NINP, 3600, Win, wscr, gw, ngw, lane);
                convert_weight(w_out + (size_t)1024 * 1024, 1024, 1024, 1024, Wout, wscr, gw, ngw, lane); }
            if (SPLITK_CTX && l == 1) norm_rows(xs_out, ctxs, MROWS, norm1_g + l * DM, mods_l, 0, 1, hn, gw, ngw, lane, slabF, 11, mods + 2 * 6144 + 5 * 1024, ctxs);
            else norm_rows(l == 0 ? x_in : xs_out, l == 0 ? ctx_in : ctxs, MROWS, norm1_g + l * DM, mods_l, 0, 1, hn, gw, ngw, lane);
        }
        SEAM(P + 0);
        if (ENA(1) && IN(P + 1)) {
            FRESH_IDS();
            pg8::Gemm g{hn, Win, MROWS, NINP, DM, DM}; pg8::StaticOrder S; S.init(MROWS, NINP, G, bid);
            pg8::EpiInProj E{uhg, uhyT, uz, (long)((WS_UXS - WS_UZ) / 2), (long)((WS_UBC - WS_UZ) / 2), udt, MROWS};
            pg8::gemm_phase<pg8::EpiInProj, pg8::StaticOrder, true, true>(lds, g, S, E, tid);
        }
        SEAM(P + 1);
        SsdArgs SA{axt, abc, abt, uz, udt, ssd_dt_bias + l * 16, ssd_a_log + l * 16, ssd_d + l * 8, sst, dts, mix, ssq};
        HgArgs HA{uhg, hg_lb, hg_lb + 256, hg_norm_g + l * 256, l, hst, dth, mix};
        const float* hcw = hy_conv_w + (size_t)l * 3 * 768; const float* hcb = hy_conv_b + l * 768; const float* hbias = hy_bias + l * 512; const float* w3l = hy_w3 + (size_t)l * 64 * 1024;
        if (ENA(2) && IN(P + 2)) {
            FRESH_IDS();
            ssd_prepass(uxs, ubc, ssd_conv_w + (size_t)l * 3 * 1024, ssd_conv_b + l * 1024, axt, abc, abt, gw, ngw, lane);
        }
        SEAM(P + 2);
        if (ENA(3) && IN(P + 3)) {
            FRESH_IDS();
            const int n_spec = 256, n_hg = 2 * 33 * 4, n_hyc = l == 0 ? 256 : 0, n_ssd = 2 * 33 * 8, total = n_spec + n_hg + n_hyc + n_ssd;
#pragma unroll 1
            for (;;) {
                const int id = NEXT_ITEM(P + 3);
                if (id >= total) break;
                FRESH_IDS();
                if (id < n_spec) { if (SUB(0)) hy_spectrum_item(lds, h2b + (size_t)l * LX * 64, w3l, hbias, Hs, id, tid, wave, lane); }
                else if (id < n_spec + n_hg) { if (SUB(2)) { int r = id - n_spec; const int h = r & 3; r >>= 2; hg_state_item(lds, HA, r / 33, r % 33, h, tid, wave, lane); } }
                else if (id < n_spec + n_hg + n_hyc) { if (SUB(3)) hy_ctx_item(lds, uhyT, hcw, hcb, hbias, h2c, w3l, mix, id - n_spec - n_hg, tid, wave, lane); }
                else if (SUB(1)) { int r = id - n_spec - n_hg - n_hyc; const int h = r & 7; r >>= 3; ssd_state_item(lds, SA, r / 33, r % 33, h, tid, wave, lane); }
            }
        }
        SEAM(P + 3);
        if (ENA(4) && IN(P + 4)) {
            FRESH_IDS();
            state_scan(sst, dts, hst, dth, gtid);
            #pragma unroll 1
            for (int id = bid; id < 256; id += G) { FRESH_IDS(); hy_fft_item(lds, uhyT, hcw, hcb, Hs, uhyT, id, tid); }
        }
        SEAM(P + 4);
        const int nsc = l == 0 ? 33 : 32;
        if (ENA(5) && IN(P + 5)) {
            FRESH_IDS();
            const int n_ssd = 2 * nsc * 4, n_hg = 2 * nsc * 2;
#pragma unroll 1
            for (;;) {
                const int id = NEXT_ITEM(P + 5);
                if (id >= n_ssd + n_hg) break;
                FRESH_IDS();
                unsigned long long tk0 = 0ull; const int kind_ = id >= n_hg ? 6 : 5; if (TIME_KIND && l == 0 && kind_ == TIME_KIND) tk0 = __builtin_amdgcn_s_memrealtime();
                if (id >= n_hg) { if (SUB(1)) { int r = id - n_hg; const int hp = r & 3; r >>= 2; ssd_item<1>(lds, SA, r / nsc, r % nsc, hp, 0, tid, wave, lane); } }
                else if (SUB(2)) { int r = id; const int hp = r & 1; r >>= 1; hg_item<1>(lds, HA, r / nsc, r % nsc, hp, 0, tid, lane); }
                if (TIME_KIND && l == 0 && kind_ == TIME_KIND) tsum += __builtin_amdgcn_s_memrealtime() - tk0;
            }
        }
        SEAM(P + 5);
        if (ENA(6) && IN(P + 6)) {
            FRESH_IDS();
            const int n_ssd = 2 * nsc * 4, n_hg = 2 * nsc * 2;
#pragma unroll 1
            for (;;) {
                const int id = NEXT_ITEM(P + 6);
                if (id >= n_ssd + n_hg + 256) break;
                FRESH_IDS();
                if (id >= n_ssd + n_hg) mf_hy_tile(lds, uhyT, mix, id - n_ssd - n_hg, tid);
                else if (id >= n_hg) { if (SUB(1)) { int r = id - n_hg; const int hp = r & 3; r >>= 2; ssd_item<2>(lds, SA, r / nsc, r % nsc, hp, 1, tid, wave, lane); } }
                else if (SUB(2)) { int r = id; const int hp = r & 1; r >>= 1; hg_item<2>(lds, HA, r / nsc, r % nsc, hp, 1, tid, lane); }
            }
        }
        SEAM(P + 6);
#ifndef CTX_ASIDE
#define CTX_ASIDE 0
#endif
        const bool ctx_cu = CTX_ASIDE && (l == 0) && bid < 8;
        const int xb = (CTX_ASIDE && l == 0) ? bid - 8 : bid, xG = (CTX_ASIDE && l == 0) ? G - 8 : G;
        const int nrows3 = (CTX_ASIDE || SPLITK_CTX) ? MXR : nrows;
        const int nrows2 = CTX_ASIDE ? MXR : nrows;
        if (ENA(7) && IN(P + 7)) {
            FRESH_IDS();
            if (ctx_cu) {
                bf16* priv = hn + (size_t)bid * 256 * DM;
                mf_ctx_rows(mix, ssq, ssd_norm_g + l * 512, MXR + 256 * (bid >> 2), priv, wave, lane);
                asm volatile("s_waitcnt vmcnt(0)" ::: "memory"); __syncthreads();
                if (tid == 0) { __builtin_amdgcn_fence(__ATOMIC_ACQUIRE, "agent"); asm volatile("s_waitcnt vmcnt(0)" ::: "memory"); }
                __syncthreads();
                pg8::Gemm g{priv - (size_t)(64 + (bid >> 2)) * 256 * DM, Wout, MROWS, DM, DM, DM}; pg8::CtxOrder S{bid};
                pg8::EpiResid E{x_in, xs_out, ctxs, ctx_in, mods_l + 2 * 1024, 6144, mods_l + 2 * 6144 + 2 * 1024};
                pg8::gemm_phase<pg8::EpiResid, pg8::CtxOrder, false, true>(lds, g, S, E, tid);
            } else {
                mf_ssd_rows(mix, ssq, ssd_norm_g + l * 512, 0, nrows2, xb * NWAVES + wave, xG * NWAVES, lane);
            }
        }
        SEAM(P + 7);
        if (ENA(8) && IN(P + 8)) {
            FRESH_IDS();
            pg8::Gemm g{mix, Wout, nrows3, DM, DM, DM}; pg8::StaticOrder S; S.init(nrows3, DM, G, bid);
            pg8::EpiResid E{l == 0 ? x_in : xs_out, xs_out, ctxs, l == 0 ? ctx_in : ctxs, mods_l + 2 * 1024, 6144, mods_l + 2 * 6144 + 2 * 1024};
            pg8::gemm_phase<pg8::EpiResid, pg8::StaticOrder, true, true>(lds, g, S, E, tid);
            if (SPLITK_CTX && l == 0) {
                pg8::Gemm g2{mix, Wout, MROWS, DM, 128, DM}; pg8::SplitOrder S2{bid, 8, 128}; pg8::EpiSlab E2{slabO, 8};
                pg8::gemm_phase<pg8::EpiSlab, pg8::SplitOrder, false, true>(lds, g2, S2, E2, tid);
            }
        }
        SEAM(P + 8);
        if (ENA(9) && IN(P + 9)) {
            FRESH_IDS();
            __syncthreads();
            convert_weight(ffn_w_gate + (size_t)l * 1024 * DFF, 1024, DFF, DFF, Wgu, wscr, gw, ngw, lane);
            convert_weight(ffn_w_up + (size_t)l * 1024 * DFF, 1024, DFF, DFF, Wgu + (size_t)DFF * 1024, wscr, gw, ngw, lane);
            convert_weight(ffn_w_down + (size_t)l * DFF * 1024, DFF, 1024, 1024, Wd, wscr, gw, ngw, lane);
            if (SPLITK_CTX && l == 0) norm_rows(xs_out, ctx_in, nrows, norm2_g + l * DM, mods_l, 3, 4, hn, gw, ngw, lane, slabO, 8, mods_l + 2 * 6144 + 2 * 1024, ctxs);
            else norm_rows(xs_out, ctxs, nrows, norm2_g + l * DM, mods_l, 3, 4, hn, gw, ngw, lane);
        }
        SEAM(P + 9);
        if (ENA(10) && IN(P + 10)) {
            FRESH_IDS();
            pg8::Gemm g{hn, Wgu, nrows, 2 * DFF, DM, DM}; pg8::StaticOrder S; S.init(nrows, 2 * DFF, G, bid);
            pg8::EpiGateUp E{fa, fup};
            pg8::gemm_phase<pg8::EpiGateUp, pg8::StaticOrder, true, true>(lds, g, S, E, tid);
        }
        SEAM(P + 10);
        if (ENA(11) && IN(P + 11)) {
            FRESH_IDS();
            if (ctx_cu) {
                bf16* priv = hn + (size_t)bid * 256 * DFF;
                ffn_conv_phase(fa, fup, ffn_conv_w + (size_t)l * 9 * DFF, ffn_conv_b + l * DFF, MXR + 256 * (bid >> 2), 256, tid, NTHR, priv, -(long)(MXR + 256 * (bid >> 2)));
                asm volatile("s_waitcnt vmcnt(0)" ::: "memory"); __syncthreads();
                if (tid == 0) { __builtin_amdgcn_fence(__ATOMIC_ACQUIRE, "agent"); asm volatile("s_waitcnt vmcnt(0)" ::: "memory"); }
                __syncthreads();
                pg8::Gemm g{priv - (size_t)(64 + (bid >> 2)) * 256 * DFF, Wd, MROWS, DM, DFF, DFF}; pg8::CtxOrder S{bid};
                pg8::EpiResid E{xs_out, xs_out, ctxs, ctxs, mods_l + 5 * 1024, 6144, mods_l + 2 * 6144 + 5 * 1024};
                pg8::gemm_phase<pg8::EpiResid, pg8::CtxOrder, false, true>(lds, g, S, E, tid);
            } else ffn_conv_phase(fa, fup, ffn_conv_w + (size_t)l * 9 * DFF, ffn_conv_b + l * DFF, 0, nrows2, xb * NTHR + tid, xG * NTHR, fup, 0);
        }
        SEAM(P + 11);
        if (ENA(12) && IN(P + 12)) {
            FRESH_IDS();
            pg8::Gemm g{fup, Wd, nrows3, DM, DFF, DFF}; pg8::StaticOrder S; S.init(nrows3, DM, G, bid);
            pg8::EpiResid E{xs_out, xs_out, ctxs, ctxs, mods_l + 5 * 1024, 6144, mods_l + 2 * 6144 + 5 * 1024};
            pg8::gemm_phase<pg8::EpiResid, pg8::StaticOrder, true, true>(lds, g, S, E, tid);
            if (SPLITK_CTX && l == 0) {
                pg8::Gemm g2{fup, Wd, MROWS, DM, 256, DFF}; pg8::SplitOrder S2{bid, 11, 256}; pg8::EpiSlab E2{slabF, 11};
                pg8::gemm_phase<pg8::EpiSlab, pg8::SplitOrder, false, true>(lds, g2, S2, E2, tid);
            }
        }
        SEAM(P + 12);
    }
    if (ENA(15) && IN(NPHASES - 1)) { FRESH_IDS(); final_norm_rows(xs_out, final_norm_g, gw, ngw, lane); }
    if (TIME_MASK || TIME_KIND) { const unsigned long long tnow = __builtin_amdgcn_s_memrealtime(); if ((TIME_MASK >> (NPHASES - 1)) & 1u) tsum += tnow - tbeg;
        if (bid == 0 && tid0 == 0) { while (__builtin_amdgcn_s_memrealtime() - tnow < (unsigned long long)TIME_MULT * tsum) __builtin_amdgcn_s_sleep(32); } }
#undef IN
#undef SEAM
}

extern "C" void kernel_launch(void* const* d_in, const int* in_sizes, int n_in, void* d_out, int out_size, void* d_ws, size_t ws_size, hipStream_t stream) {
    static int grid = 0;
    if (grid == 0) {
        if (n_in != 34 || out_size != MXR * DM || ws_size < WS_END) { fprintf(stderr, "kernel_launch: unexpected shapes (n_in %d out %d ws %zu)\n", n_in, out_size, ws_size); grid = -1; return; }
        int dev = 0, cus = 0, per_cu = 0;
        if (hipGetDevice(&dev) != hipSuccess || hipDeviceGetAttribute(&cus, hipDeviceAttributeMultiprocessorCount, dev) != hipSuccess) { grid = -1; return; }
        if (hipFuncSetAttribute((const void*)hybrid_fwd, hipFuncAttributeMaxDynamicSharedMemorySize, LDS_BYTES) != hipSuccess) { fprintf(stderr, "kernel_launch: hipFuncSetAttribute failed\n"); grid = -1; return; }
        if (hipOccupancyMaxActiveBlocksPerMultiprocessor(&per_cu, (const void*)hybrid_fwd, NTHR, LDS_BYTES) != hipSuccess || per_cu < 1)
            fprintf(stderr, "kernel_launch: note: occupancy query reports %d workgroups per CU\n", per_cu);
        (void)hipGetLastError();
        grid = cus;
    }
    if (grid < 0) return;
    if (hipMemsetAsync((char*)d_ws + WS_CTL, 0, CTL_ZERO_BYTES, stream) != hipSuccess) { fprintf(stderr, "kernel_launch: memset failed\n"); return; }
    Args a{};
    for (int i = 0; i < 34; ++i) a.in[i] = (const float*)d_in[i];
    a.out = (float*)d_out; a.ws = (unsigned char*)d_ws;
#if MK_PER_PHASE
    for (int p = 0; p < NPHASES; ++p) { a.ph_lo = p; a.ph_hi = p + 1; hipLaunchKernelGGL(hybrid_fwd, dim3(grid), dim3(NTHR), LDS_BYTES, stream, a); }
#else
    a.ph_lo = 0; a.ph_hi = NPHASES;
    hipLaunchKernelGGL(hybrid_fwd, dim3(grid), dim3(NTHR), LDS_BYTES, stream, a);
#endif
    const hipError_t le = hipPeekAtLastError();
    if (le != hipSuccess) fprintf(stderr, "kernel_launch: launch failed: %s\n", hipGetErrorName(le));
}
```

```cpp
#include <hip/hip_runtime.h>
#include <cstdio>
#include <cstdint>
namespace pg8 {
#define PG8_LAS __attribute__((address_space(3)))
typedef unsigned short bf16_t;
typedef short bf16x8 __attribute__((ext_vector_type(8)));
typedef float f32x4 __attribute__((ext_vector_type(4)));
typedef unsigned u32x4 __attribute__((ext_vector_type(4)));
constexpr int BM = 256, BK = 64, HALF = 128, HTB = HALF * BK * 2  , STAGE_BYTES = 8 * HTB, NXCD = 8, WGM = 8;

__host__ __device__ __forceinline__ int lds_byte(int r, int c) { const int st = (r >> 4) * 2 + (c >> 5), rr = r & 15, cc = c & 31, ob = rr * 64 + cc * 2; return st * 1024 + (ob ^ (((ob >> 9) & 1) << 5)); }
__host__ __device__ __forceinline__ void stage_rc(int b, int& R, int& C) { const int st = b / 1024, sb = b % 1024, swz = sb ^ (((sb >> 9) & 1) << 5); R = (st >> 1) * 16 + swz / 64; C = (st & 1) * 32 + (swz % 64) / 2; }
__host__ __device__ __forceinline__ int perm32(int rho) { const int n = rho >> 4, i = rho & 15; return 8 * (i >> 2) + 4 * n + (i & 3); }

struct Unit { int pm, pn, koff, ks; };
struct Gemm { const bf16_t* A; const bf16_t* Bt; int M, N, K, ld; };

struct StaticOrder {
    int nM, nN, nwg, G, c;
    __host__ __device__ void init(int M, int N, int G_, int c_) { nM = M / BM; nN = N / BM; nwg = nM * nN; G = G_; c = c_; }
    __host__ __device__ bool next(int i, Unit& u) const {
        const long L = (long)i * G + c; if (L >= nwg) return false;
        int wgid = (int)L; { const int q = nwg / NXCD, r = nwg % NXCD, xcd = wgid % NXCD, off = wgid / NXCD; wgid = (xcd < r ? xcd * (q + 1) : r * (q + 1) + (xcd - r) * q) + off; }
        const int nig = WGM * nN, gid = wgid / nig, fm = gid * WGM, gsz = (nM - fm) < WGM ? (nM - fm) : WGM;
        u.pm = fm + ((wgid % nig) % gsz); u.pn = (wgid % nig) / gsz; u.koff = 0; u.ks = 0; return true;
    }
    __device__ __forceinline__ void a_ready(const Unit&) const {}
    __device__ __forceinline__ void done(const Unit&) const {}
};

__device__ __forceinline__ unsigned cvt_pk_bf16(float lo, float hi) { unsigned r; asm volatile("v_cvt_pk_bf16_f32 %0, %1, %2" : "=v"(r) : "v"(lo), "v"(hi)); return r; }
typedef float f32x2 __attribute__((ext_vector_type(2)));

struct EpiInProj {
    static constexpr bool PERM = true, AFTER_DRAIN = false;
    bf16_t* uhg; bf16_t* uhyT; bf16_t* uz; long off_xs, off_bc; float* udt; int mrows;
    __device__ __forceinline__ void operator()(const f32x4 (&acc)[2][2][4][2], const Unit& u, int wr, int wc, int fr, int fq) const {
        const int row0 = u.pm * BM + wr * 64 + fr;
        const int colt = u.pn * BM + wc * 32 + 8 * fq;
#pragma unroll
        for (int ai = 0; ai < 2; ++ai)
#pragma unroll
            for (int m = 0; m < 4; ++m) {
                const int r = row0 + ai * HALF + m * 16;
#pragma unroll
                for (int bj = 0; bj < 2; ++bj) {
                    const f32x4 v0 = acc[ai][bj][m][0], v1 = acc[ai][bj][m][1];
                    const int c = colt + bj * HALF;
                    if (u.pn < 5) {
                        u32x4 w; w.x = cvt_pk_bf16(v0[0], v0[1]); w.y = cvt_pk_bf16(v0[2], v0[3]); w.z = cvt_pk_bf16(v1[0], v1[1]); w.w = cvt_pk_bf16(v1[2], v1[3]);
                        *(u32x4*)(uhg + (size_t)r * 1280 + c) = w;
                    } else if (u.pn < 8) {
                        const int cc = c - 1280;
                        const unsigned w0 = cvt_pk_bf16(v0[0], v0[1]), w1 = cvt_pk_bf16(v0[2], v0[3]), w2 = cvt_pk_bf16(v1[0], v1[1]), w3 = cvt_pk_bf16(v1[2], v1[3]);
                        bf16_t* d = uhyT + (size_t)cc * mrows + r;
                        d[0] = (bf16_t)(w0 & 0xffffu); d[(size_t)mrows] = (bf16_t)(w0 >> 16); d[(size_t)2 * mrows] = (bf16_t)(w1 & 0xffffu); d[(size_t)3 * mrows] = (bf16_t)(w1 >> 16);
                        d[(size_t)4 * mrows] = (bf16_t)(w2 & 0xffffu); d[(size_t)5 * mrows] = (bf16_t)(w2 >> 16); d[(size_t)6 * mrows] = (bf16_t)(w3 & 0xffffu); d[(size_t)7 * mrows] = (bf16_t)(w3 >> 16);
                    } else {
                        const int cc = c - 2048;
                        if (cc < 1536) {
                            u32x4 w; w.x = cvt_pk_bf16(v0[0], v0[1]); w.y = cvt_pk_bf16(v0[2], v0[3]); w.z = cvt_pk_bf16(v1[0], v1[1]); w.w = cvt_pk_bf16(v1[2], v1[3]);
                            bf16_t* dst = uz + (u.pn >= 10 ? off_xs : 0) + (u.pn >= 12 ? off_bc - off_xs : 0);
                            *(u32x4*)(dst + (size_t)r * 512 + (cc & 511)) = w;
                        } else if (cc < 1552) {
                            float* d = udt + (size_t)r * 16 + (cc - 1536);
                            *(f32x4*)d = v0; *(f32x4*)(d + 4) = v1;
                        }
                    }
                }
            }
    }
};
struct EpiGateUp {
    static constexpr bool PERM = true, AFTER_DRAIN = false;
    bf16_t* a; bf16_t* up;
    __device__ __forceinline__ void operator()(const f32x4 (&acc)[2][2][4][2], const Unit& u, int wr, int wc, int fr, int fq) const {
        const int row0 = u.pm * BM + wr * 64 + fr;
        int colt = u.pn * BM; bf16_t* base = a; if (u.pn >= 11) { base = up; colt -= 2816; }
        colt += wc * 32 + 8 * fq;
#pragma unroll
        for (int ai = 0; ai < 2; ++ai)
#pragma unroll
            for (int m = 0; m < 4; ++m) { bf16_t* rowp = base + (size_t)(row0 + ai * HALF + m * 16) * 2816 + colt;
#pragma unroll
                for (int bj = 0; bj < 2; ++bj) { const f32x4 v0 = acc[ai][bj][m][0], v1 = acc[ai][bj][m][1];
                    u32x4 w; w.x = cvt_pk_bf16(v0[0], v0[1]); w.y = cvt_pk_bf16(v0[2], v0[3]); w.z = cvt_pk_bf16(v1[0], v1[1]); w.w = cvt_pk_bf16(v1[2], v1[3]);
                    *(u32x4*)(rowp + bj * HALF) = w; } }
    }
};
struct EpiResid {
    static constexpr bool PERM = false, AFTER_DRAIN = false;
    const float* xbase; float* xout; float* cstream; const float* cbase; const float* gate_x; int gate_bstride; const float* gate_c;
    __device__ __forceinline__ void operator()(const f32x4 (&acc)[2][2][4][2], const Unit& u, int wr, int wc, int fr, int fq) const {
        const int row0 = u.pm * BM + wr * 64 + fr;
        const int col0 = u.pn * BM + wc * 32 + 4 * fq;
        const bool isctx = u.pm >= 64;
#pragma unroll
        for (int bj = 0; bj < 2; ++bj)
#pragma unroll
            for (int n = 0; n < 2; ++n) {
                const int c = col0 + bj * HALF + n * 16;
#pragma unroll
                for (int ai = 0; ai < 2; ++ai)
#pragma unroll
                    for (int m = 0; m < 4; ++m) {
                        const int r = row0 + ai * HALF + m * 16;
                        if (!isctx) {
                            const f32x4 g = *(const f32x4*)(gate_x + (size_t)(r >> 13) * gate_bstride + c);
                            const f32x4 b = *(const f32x4*)(xbase + (size_t)r * 1024 + c);
                            *(f32x4*)(xout + (size_t)r * 1024 + c) = b + g * acc[ai][bj][m][n];
                        } else {
                            const f32x4 g = *(const f32x4*)(gate_c + c);
                            const f32x4 b = *(const f32x4*)(cbase + (size_t)(r - 16384) * 1024 + c);
                            *(f32x4*)(cstream + (size_t)(r - 16384) * 1024 + c) = b + g * acc[ai][bj][m][n];
                        }
                    }
            }
    }
};
struct CtxOrder {
    int c;
    __host__ __device__ bool next(int i, Unit& u) const { if (i != 0 || c >= 8) return false; u.pm = 64 + (c >> 2); u.pn = c & 3; u.koff = 0; u.ks = 0; return true; }
    __device__ __forceinline__ void a_ready(const Unit&) const {}
    __device__ __forceinline__ void done(const Unit&) const {}
};
struct SplitOrder {
    int c, nsplit, kc;
    __host__ __device__ bool next(int i, Unit& u) const { if (i != 0 || c >= 8 * nsplit) return false; const int t = c / nsplit; u.pm = 64 + (t >> 2); u.pn = t & 3; u.ks = c % nsplit; u.koff = u.ks * kc * 2; return true; }
    __device__ __forceinline__ void a_ready(const Unit&) const {}
    __device__ __forceinline__ void done(const Unit&) const {}
};
struct EpiSlab {
    static constexpr bool PERM = false, AFTER_DRAIN = false;
    float* slab; int nsplit;
    __device__ __forceinline__ void operator()(const f32x4 (&acc)[2][2][4][2], const Unit& u, int wr, int wc, int fr, int fq) const {
        float* base = slab + (size_t)((((u.pm - 64) * 4 + u.pn) * nsplit + u.ks)) * 65536;
        const int row0 = wr * 64 + fr, col0 = wc * 32 + 4 * fq;
#pragma unroll
        for (int bj = 0; bj < 2; ++bj)
#pragma unroll
            for (int n = 0; n < 2; ++n)
#pragma unroll
                for (int ai = 0; ai < 2; ++ai)
#pragma unroll
                    for (int m = 0; m < 4; ++m) *(f32x4*)(base + (size_t)(row0 + ai * HALF + m * 16) * 256 + col0 + bj * HALF + n * 16) = acc[ai][bj][m][n];
    }
};
template <class Epi, class Sched, bool ALIGN_EPI = false, bool SP2 = false>
__device__ __forceinline__ void gemm_phase(PG8_LAS unsigned char* lds, const Gemm g, const Sched& S, const Epi& E, const int tid) {
    const int wid = __builtin_amdgcn_readfirstlane(tid >> 6), lane = tid & 63, wr = wid >> 2, wc = wid & 3, fr = lane & 15, fq = lane >> 4;
    const int K = g.K, nt = K / BK, ld = g.ld;
    unsigned voffA[2], voffB[2];
#pragma unroll
    for (int i = 0; i < 2; ++i) { int R, C; stage_rc(tid * 16 + i * 8192, R, C); const int Rb = Epi::PERM ? ((R & ~31) + perm32(R & 31)) : R;
        voffA[i] = (unsigned)(R * ld + C) * 2u; voffB[i] = (unsigned)(Rb * ld + C) * 2u; }
    const size_t kstep = (size_t)(BK * 2);
    const size_t hstep = (size_t)HALF * ld * 2;
    const size_t tstep = 2 * hstep;
    const unsigned ldsw = (unsigned)wid * 1024u;
    const int aoff = lds_byte(wr * 64 + fr, fq * 8), boff = lds_byte(wc * 32 + fr, fq * 8);
#define PG8_SA(b, h) (((b) * 2 + (h)) * HTB)
#define PG8_SB(b, h) ((4 + (b) * 2 + (h)) * HTB)
#define PG8_STAGE(bufoff, gbase, voff) do { _Pragma("unroll") for (int _i = 0; _i < 2; ++_i) \
        __builtin_amdgcn_global_load_lds((const unsigned*)((const char*)(gbase) + (voff)[_i]), (PG8_LAS unsigned*)(lds + (bufoff) + ldsw + _i * 8192), 16, 0, 0); } while (0)
#define PG8_LDA(dst, b, h) do { _Pragma("unroll") for (int m = 0; m < 4; ++m) _Pragma("unroll") for (int k = 0; k < 2; ++k) dst[m][k] = *(const PG8_LAS bf16x8*)(lds + PG8_SA(b, h) + aoff + m * 2048 + k * 1024); } while (0)
#define PG8_LDB(dst, b, h) do { _Pragma("unroll") for (int n = 0; n < 2; ++n) _Pragma("unroll") for (int k = 0; k < 2; ++k) dst[n][k] = *(const PG8_LAS bf16x8*)(lds + PG8_SB(b, h) + boff + n * 2048 + k * 1024); } while (0)
#define PG8_MMA(ai, bj, At, Bt) do { __builtin_amdgcn_s_setprio(1); _Pragma("unroll") for (int m = 0; m < 4; ++m) _Pragma("unroll") for (int n = 0; n < 2; ++n) _Pragma("unroll") for (int k = 0; k < 2; ++k) \
        acc[ai][bj][m][n] = __builtin_amdgcn_mfma_f32_16x16x32_bf16(Bt[n][k], At[m][k], acc[ai][bj][m][n], 0, 0, 0); __builtin_amdgcn_s_setprio(0); } while (0)
#define PG8_WAIT_V(n) asm volatile("s_waitcnt vmcnt(" #n ")" ::: "memory")
#define PG8_WAIT_L(n) asm volatile("s_waitcnt lgkmcnt(" #n ")" ::: "memory")
#define PG8_BAR __builtin_amdgcn_s_barrier()
#define PG8_SCHED __builtin_amdgcn_sched_barrier(0)
    Unit cur, nxt; int ui = 0;
    if (!S.next(0, cur)) return;
    f32x4 acc[2][2][4][2];
#pragma unroll
    for (int a = 0; a < 2; ++a)
#pragma unroll
        for (int b = 0; b < 2; ++b)
#pragma unroll
            for (int m = 0; m < 4; ++m)
#pragma unroll
                for (int n = 0; n < 2; ++n) acc[a][b][m][n] = (f32x4){0.f, 0.f, 0.f, 0.f};
    bf16x8 At[4][2], B0[2][2], B1[2][2];
    const char* cA = (const char*)g.A + (size_t)cur.pm * tstep + cur.koff; const char* cB = (const char*)g.Bt + (size_t)cur.pn * tstep + cur.koff;
    S.a_ready(cur);
    if constexpr (SP2) {
        PG8_STAGE(PG8_SB(0, 0), cB, voffB); PG8_STAGE(PG8_SB(0, 1), cB + hstep, voffB); PG8_STAGE(PG8_SA(0, 0), cA, voffA); PG8_STAGE(PG8_SA(0, 1), cA + hstep, voffA);
        if (wr == 1) PG8_BAR;
        PG8_WAIT_V(2); PG8_BAR;
        PG8_STAGE(PG8_SB(1, 0), cB + kstep, voffB); PG8_STAGE(PG8_SA(1, 0), cA + kstep, voffA); PG8_STAGE(PG8_SB(1, 1), cB + hstep + kstep, voffB);
        PG8_WAIT_V(6); PG8_BAR;
    } else {
        PG8_STAGE(PG8_SB(0, 0), cB, voffB); PG8_STAGE(PG8_SA(0, 0), cA, voffA); PG8_STAGE(PG8_SB(0, 1), cB + hstep, voffB); PG8_STAGE(PG8_SA(0, 1), cA + hstep, voffA);
        if (wr == 1) PG8_BAR;
        PG8_WAIT_V(4); PG8_BAR;
        PG8_STAGE(PG8_SB(1, 0), cB + kstep, voffB); PG8_STAGE(PG8_SA(1, 0), cA + kstep, voffA); PG8_STAGE(PG8_SB(1, 1), cB + hstep + kstep, voffB);
        PG8_WAIT_V(6); PG8_BAR;
    }
    for (;;) {
        const bool has_next = S.next(ui + 1, nxt);
        const char* nA = has_next ? (const char*)g.A + (size_t)nxt.pm * tstep + nxt.koff : cA; const char* nB = has_next ? (const char*)g.Bt + (size_t)nxt.pn * tstep + nxt.koff : cB;
        for (int t = 0; t < nt; t += 2) {
            const bool last = (t == nt - 2);
            const char* a1 = cA + (size_t)(t + 1) * kstep;
            const char* a2 = last ? nA : cA + (size_t)(t + 2) * kstep; const char* b2 = last ? nB : cB + (size_t)(t + 2) * kstep;
            const char* a3 = a2 + kstep; const char* b3 = b2 + kstep;
            if (last && has_next) S.a_ready(nxt);
            if constexpr (SP2) {
            PG8_LDB(B0, 0, 0); PG8_LDB(B1, 0, 1); PG8_SCHED; PG8_LDA(At, 0, 0); PG8_STAGE(PG8_SA(1, 1), a1 + hstep, voffA);
            PG8_WAIT_V(8); PG8_WAIT_L(0); PG8_BAR; PG8_MMA(0, 0, At, B0); PG8_MMA(0, 1, At, B1); PG8_BAR; PG8_SCHED;
            PG8_LDA(At, 0, 1); PG8_STAGE(PG8_SB(0, 0), b2, voffB); PG8_STAGE(PG8_SB(0, 1), b2 + hstep, voffB); PG8_STAGE(PG8_SA(0, 0), a2, voffA);
            PG8_WAIT_V(8); PG8_WAIT_L(0); PG8_BAR; PG8_MMA(1, 0, At, B0); PG8_MMA(1, 1, At, B1); PG8_BAR; PG8_SCHED;
            PG8_LDB(B0, 1, 0); PG8_LDB(B1, 1, 1); PG8_SCHED; PG8_LDA(At, 1, 0); PG8_STAGE(PG8_SA(0, 1), a2 + hstep, voffA);
            PG8_WAIT_V(8); PG8_WAIT_L(0); PG8_BAR; PG8_MMA(0, 0, At, B0); PG8_MMA(0, 1, At, B1); PG8_BAR; PG8_SCHED;
            PG8_LDA(At, 1, 1); PG8_STAGE(PG8_SB(1, 0), b3, voffB); PG8_STAGE(PG8_SB(1, 1), b3 + hstep, voffB); PG8_STAGE(PG8_SA(1, 0), a3, voffA);
            PG8_WAIT_V(8); PG8_WAIT_L(0); PG8_BAR; PG8_MMA(1, 0, At, B0); PG8_MMA(1, 1, At, B1); PG8_BAR; PG8_SCHED;
            } else {
            PG8_LDB(B0, 0, 0); PG8_SCHED; PG8_LDA(At, 0, 0); PG8_STAGE(PG8_SA(1, 1), a1 + hstep, voffA);
            PG8_WAIT_L(8); PG8_BAR; PG8_WAIT_L(0); PG8_MMA(0, 0, At, B0); PG8_BAR; PG8_SCHED;
            PG8_LDB(B1, 0, 1); PG8_STAGE(PG8_SB(0, 0), b2, voffB);
            PG8_BAR; PG8_WAIT_L(0); PG8_MMA(0, 1, At, B1); PG8_BAR;
            PG8_LDA(At, 0, 1); PG8_STAGE(PG8_SA(0, 0), a2, voffA);
            PG8_BAR; PG8_WAIT_L(0); PG8_MMA(1, 0, At, B0); PG8_BAR; PG8_SCHED;
            PG8_STAGE(PG8_SB(0, 1), b2 + hstep, voffB);
            PG8_WAIT_V(6); PG8_BAR; PG8_MMA(1, 1, At, B1); PG8_BAR;
            PG8_LDB(B0, 1, 0); PG8_SCHED; PG8_LDA(At, 1, 0); PG8_STAGE(PG8_SA(0, 1), a2 + hstep, voffA);
            PG8_WAIT_L(8); PG8_BAR; PG8_WAIT_L(0); PG8_MMA(0, 0, At, B0); PG8_BAR; PG8_SCHED;
            PG8_LDB(B1, 1, 1); PG8_STAGE(PG8_SB(1, 0), b3, voffB);
            PG8_BAR; PG8_WAIT_L(0); PG8_MMA(0, 1, At, B1); PG8_BAR;
            PG8_LDA(At, 1, 1); PG8_STAGE(PG8_SA(1, 0), a3, voffA);
            PG8_BAR; PG8_WAIT_L(0); PG8_MMA(1, 0, At, B0); PG8_BAR; PG8_SCHED;
            PG8_STAGE(PG8_SB(1, 1), b3 + hstep, voffB);
            PG8_WAIT_V(6); PG8_BAR; PG8_MMA(1, 1, At, B1); PG8_BAR;
            }
        }
        if constexpr (ALIGN_EPI) { if (wr == 0) PG8_BAR; }
        if constexpr (!Epi::AFTER_DRAIN) { E(acc, cur, wr, wc, fr, fq); S.done(cur); }
        if (!has_next) break;
#pragma unroll
        for (int a = 0; a < 2; ++a)
#pragma unroll
            for (int b = 0; b < 2; ++b)
#pragma unroll
                for (int m = 0; m < 4; ++m)
#pragma unroll
                    for (int n = 0; n < 2; ++n) acc[a][b][m][n] = (f32x4){0.f, 0.f, 0.f, 0.f};
        cur = nxt; cA = nA; cB = nB; ++ui;
        if constexpr (ALIGN_EPI) { if (wr == 1) PG8_BAR; }
    }
    PG8_WAIT_V(0);
    if constexpr (!ALIGN_EPI) { if (wr == 0) PG8_BAR; }
    PG8_BAR;
    if constexpr (Epi::AFTER_DRAIN) { E.fused(acc, cur, wr, wc, fr, fq, lds, wid, lane); S.done(cur); }
#undef PG8_SA
#undef PG8_SB
#undef PG8_STAGE
#undef PG8_LDA
#undef PG8_LDB
#undef PG8_MMA
#undef PG8_WAIT_V
#undef PG8_WAIT_L
#undef PG8_BAR
#undef PG8_SCHED
}
}
#define GAS __attribute__((address_space(1)))
#define LAS __attribute__((address_space(3)))
typedef unsigned short bf16;
typedef unsigned v4u __attribute__((ext_vector_type(4)));
typedef float f32x4 __attribute__((ext_vector_type(4)));
typedef short bf16x8 __attribute__((ext_vector_type(8)));
typedef GAS unsigned gu32;
typedef GAS unsigned long long gu64;
#define RLX_AGENT __ATOMIC_RELAXED, __HIP_MEMORY_SCOPE_AGENT
#define LDS_WAIT() asm volatile("s_waitcnt lgkmcnt(0)" ::: "memory")
#define VM_WAIT() asm volatile("s_waitcnt vmcnt(0)" ::: "memory")
__device__ __forceinline__ unsigned long long rt() { return __builtin_amdgcn_s_memrealtime(); }
__device__ __forceinline__ unsigned f2bf(float f) { unsigned u = __builtin_bit_cast(unsigned, f); return (u + 0x7fffu + ((u >> 16) & 1u)) >> 16; }
__device__ __forceinline__ unsigned pk2(float lo, float hi) { return f2bf(lo) | (f2bf(hi) << 16); }

#define XB_TMO      128
#define XB_XCNT(j)  (256  + 64 * (j))
#define XB_XSUB(j)  (1280 + 64 * (j))
#define XB_XGEN(j)  (2304 + 64 * (j))
#define XB_TOP      3328
#define XB_TOPGEN   3392
#define XCD_BAR_WORDS 3456
#define XB_SPIN_CAP (1u << 18)

__device__ __forceinline__ unsigned xb_ld(unsigned* p)              { return __hip_atomic_load(p, __ATOMIC_RELAXED, __HIP_MEMORY_SCOPE_AGENT); }
__device__ __forceinline__ unsigned xb_add(unsigned* p, unsigned v) { return __hip_atomic_fetch_add(p, v, __ATOMIC_RELAXED, __HIP_MEMORY_SCOPE_AGENT); }
__device__ __forceinline__ unsigned xb_xcc_id() { return (unsigned)__builtin_amdgcn_s_getreg((3 << 11) | 20) & 0xFu; }
#define XB_SPIN(cond, bar) do { unsigned _sp = 0; while (cond) { __builtin_amdgcn_s_sleep(1); \
    if ((++_sp & 255u) == 0u) { if (xb_ld(&(bar)[XB_TMO])) break; if (_sp > XB_SPIN_CAP) { atomicAdd(&(bar)[XB_TMO], 1u); break; } } } } while (0)

struct XcdBarrier {
    unsigned* bar; unsigned x;
    volatile LAS unsigned* st;
};

__device__ __forceinline__ XcdBarrier xcd_barrier_post(unsigned* bar, volatile LAS unsigned* st) {
    XcdBarrier b; b.bar = bar; b.x = xb_xcc_id(); b.st = st;
    if (threadIdx.x == 0) (void)xb_add(&bar[XB_XCNT(b.x)], 1u);
    return b;
}
__device__ __forceinline__ void xcd_barrier_complete(unsigned* bar, unsigned x, unsigned& nloc, unsigned& nx) {
    const unsigned G = gridDim.x * gridDim.y * gridDim.z;
    unsigned sum, cnt, mine, sp = 0u;
    for (;;) {
        sum = 0u; cnt = 0u; mine = 0u;
#pragma unroll
        for (unsigned j = 0; j < 16; ++j) { const unsigned c = xb_ld(&bar[XB_XCNT(j)]); sum += c; cnt += (c > 0u) ? 1u : 0u; mine = (j == x) ? c : mine; }
        if (sum == G) break;
        __builtin_amdgcn_s_sleep(1);
        if ((++sp & 255u) == 0u) { if (xb_ld(&bar[XB_TMO])) break; if (sp > XB_SPIN_CAP) { atomicAdd(&bar[XB_TMO], 1u); break; } }
    }
    nloc = mine > 0u ? mine : 1u; nx = cnt > 0u ? cnt : 1u;
}

__device__ __forceinline__ void xcd_barrier(const XcdBarrier& b) {
    asm volatile("s_waitcnt vmcnt(0)" ::: "memory");
    __syncthreads();
    if (threadIdx.x == 0) {
        unsigned* bar = b.bar;
        __builtin_amdgcn_s_waitcnt(0);
        unsigned nloc = b.st[0], nx = b.st[1];
        if (nloc == 0u) { xcd_barrier_complete(bar, b.x, nloc, nx); b.st[0] = nloc; b.st[1] = nx; }
        const unsigned old = xb_add(&bar[XB_XSUB(b.x)], 1u);
        const unsigned gen = old / nloc;
        if (old + 1u == (gen + 1u) * nloc) {
            __builtin_amdgcn_fence(__ATOMIC_RELEASE, "agent");
            asm volatile("s_waitcnt vmcnt(0)" ::: "memory");
            const unsigned og = xb_add(&bar[XB_TOP], 1u);
            const unsigned tg = og / nx;
            if (og + 1u == (tg + 1u) * nx) xb_add(&bar[XB_TOPGEN], 1u);
            else XB_SPIN(xb_ld(&bar[XB_TOPGEN]) == tg, bar);
            __builtin_amdgcn_fence(__ATOMIC_ACQUIRE, "agent");
            xb_add(&bar[XB_XGEN(b.x)], 1u);
            asm volatile("s_waitcnt vmcnt(0)" ::: "memory");
        } else {
            XB_SPIN(xb_ld(&bar[XB_XGEN(b.x)]) == gen, bar);
            __builtin_amdgcn_fence(__ATOMIC_ACQUIRE, "agent");
            asm volatile("s_waitcnt vmcnt(0)" ::: "memory");
        }
    }
    __syncthreads();
}
constexpr int NWAVES = 8, NTHR = 512;
constexpr int LX = 8192, LC = 256, DM = 1024, MXR = 16384, MROWS = 16896, NINP = 3840, DFF = 2816;
constexpr float EPS = 1e-6f;
constexpr size_t MiB = 1u << 20, KiB = 1u << 10;
constexpr size_t WS_CTL = 0, CTL_ZERO_BYTES = 64 * KiB;
constexpr size_t WS_MODS = 1 * MiB;
constexpr size_t WS_TW = 1 * MiB + 512 * KiB;
constexpr size_t WS_CTXS = 2 * MiB;
constexpr size_t WS_H2 = 4 * MiB;
constexpr size_t WS_H2C = 8 * MiB;
constexpr size_t WS_SSQ = 8 * MiB + 64 * KiB;
constexpr size_t WS_DTS = 8 * MiB + 640 * KiB;
constexpr size_t WS_DTH = 8 * MiB + 704 * KiB;
constexpr size_t WS_UDT = 9 * MiB;
constexpr size_t WS_WIN = 11 * MiB;
constexpr size_t WS_WOUT = 18 * MiB + 512 * KiB;
constexpr size_t WS_HN = 21 * MiB;
constexpr size_t WS_UHG = 54 * MiB;
constexpr size_t WS_UHY = 96 * MiB;
constexpr size_t WS_UZ = 121 * MiB;
constexpr size_t WS_UXS = 138 * MiB;
constexpr size_t WS_UBC = 154 * MiB + 512 * KiB;
constexpr size_t WS_SST = 138 * MiB;
constexpr size_t WS_AXT = 171 * MiB;
constexpr size_t WS_ABC = 187 * MiB + 512 * KiB;
constexpr size_t WS_ABT = 204 * MiB;
constexpr size_t WS_HST = 213 * MiB;
constexpr size_t WS_MIX = 222 * MiB;
constexpr size_t WS_A = 54 * MiB;
constexpr size_t WS_UP = 145 * MiB;
constexpr size_t WS_WGU = 236 * MiB;
constexpr size_t WS_WD = 247 * MiB;
constexpr size_t WS_END = 256 * MiB;
constexpr int HSP = 8200;
constexpr int CW_BAR = 1024;
constexpr int RING_BYTES = 131072, SCR_OFF = 131072, LDS_BYTES = 147456, MISC_OFF = LDS_BYTES - 128;

typedef float f32x2 __attribute__((ext_vector_type(2)));
typedef unsigned u32x2 __attribute__((ext_vector_type(2)));
typedef unsigned u32x4 __attribute__((ext_vector_type(4)));
#define MFMA4(a, b, c) __builtin_amdgcn_mfma_f32_16x16x4f32((a), (b), (c), 0, 0, 0)

__device__ __forceinline__ float bflo(unsigned w) { return __builtin_bit_cast(float, w << 16); }
__device__ __forceinline__ float bfhi(unsigned w) { return __builtin_bit_cast(float, w & 0xffff0000u); }
__device__ __forceinline__ float bf2f(bf16 h) { return __builtin_bit_cast(float, (unsigned)h << 16); }
__device__ __forceinline__ float siluf(float x) { return x / (1.0f + __expf(-x)); }
__device__ __forceinline__ float sigmf(float x) { return 1.0f / (1.0f + __expf(-x)); }
__device__ __forceinline__ u32x4 pack8(const float (&o)[8]) { u32x4 u; u.x = pk2(o[0], o[1]); u.y = pk2(o[2], o[3]); u.z = pk2(o[4], o[5]); u.w = pk2(o[6], o[7]); return u; }
__device__ __forceinline__ float wave_sum(float v) {
#pragma unroll
    for (int o = 1; o < 64; o <<= 1) v += __shfl_xor(v, o);
    return v;
}
__device__ __forceinline__ void block_sum2(float& a, float& b, LAS float* red, int wave, int lane) {
    a = wave_sum(a); b = wave_sum(b);
    __syncthreads();
    if (lane == 0) { red[wave] = a; red[8 + wave] = b; }
    __syncthreads();
    float sa = 0.f, sb = 0.f;
#pragma unroll
    for (int w = 0; w < 8; ++w) { sa += red[w]; sb += red[8 + w]; }
    a = sa; b = sb;
    __syncthreads();
}

__device__ __forceinline__ void p0_mods_item(const float* c, const float* cctx, const float* w_ada, const float* b_ada, float* mods, LAS float* sm, int item, int tid, int wave, int lane) {
    for (int k = tid; k < 1024; k += NTHR) { sm[k] = siluf(c[k]); sm[1024 + k] = siluf(c[1024 + k]); sm[2048 + k] = siluf(cctx[k]); }
    __syncthreads();
    const int l = item / 96, n0 = (item % 96) * 64;
    const float* W = w_ada + (size_t)l * 1024 * 6144 + n0 + lane;
    float a0 = 0.f, a1 = 0.f, a2 = 0.f;
#pragma unroll 32
    for (int kk = 0; kk < 128; ++kk) { const int k = wave * 128 + kk; const float w = W[(size_t)k * 6144]; a0 += sm[k] * w; a1 += sm[1024 + k] * w; a2 += sm[2048 + k] * w; }
    LAS float* red = sm + 3072;
    red[(wave * 3 + 0) * 64 + lane] = a0; red[(wave * 3 + 1) * 64 + lane] = a1; red[(wave * 3 + 2) * 64 + lane] = a2;
    __syncthreads();
    if (tid < 192) { const int v = tid >> 6, ln = tid & 63; float s = 0.f;
#pragma unroll
        for (int w = 0; w < 8; ++w) s += red[(w * 3 + v) * 64 + ln];
        mods[(size_t)(l * 3 + v) * 6144 + n0 + ln] = s + b_ada[(size_t)l * 6144 + n0 + ln]; }
    __syncthreads();
}
__device__ __forceinline__ void p0_h2_rows(const float* w1, const float* b1, const float* f1, const float* w2, const float* b2, const float* f2, float* out, bf16* outb, int slen, int first, int step, int lane) {
    float w1c[33], w2c[64];
#pragma unroll
    for (int i = 0; i < 33; ++i) w1c[i] = w1[i * 64 + lane];
#pragma unroll
    for (int i = 0; i < 64; ++i) w2c[i] = w2[i * 64 + lane];
    const float bb1 = b1[lane], ff1 = f1[lane], bb2 = b2[lane], ff2 = f2[lane];
#pragma unroll 1
    for (int t = first; t < slen; t += step) {
        const float tl = (float)t / (float)(slen - 1);
        const float w = (6.283185307179586f * (float)t) / (float)slen;
        float z = 0.f;
        if (lane == 0) z = tl;
        else if (lane <= 16) { const float band = 1e-4f + (float)(lane - 1) * ((15.0f - 1e-4f) / 15.0f); z = __cosf(band * w); }
        else if (lane <= 32) { const float band = 1e-4f + (float)(lane - 17) * ((15.0f - 1e-4f) / 15.0f); z = -__sinf(band * w); }
        float pre = bb1;
#pragma unroll
        for (int i = 0; i < 33; ++i) pre += __builtin_bit_cast(float, __builtin_amdgcn_readlane(__builtin_bit_cast(int, z), i)) * w1c[i];
        const float h1 = __sinf(ff1 * pre);
        float pre2 = bb2;
#pragma unroll
        for (int i = 0; i < 64; ++i) pre2 += __builtin_bit_cast(float, __builtin_amdgcn_readlane(__builtin_bit_cast(int, h1), i)) * w2c[i];
        const float hv = __sinf(ff2 * pre2);
        if (outb) outb[(size_t)t * 64 + lane] = (bf16)f2bf(hv); else out[(size_t)t * 64 + lane] = hv;
    }
}
__device__ __forceinline__ void transpose_item(const float* W, int K, int N, int Nvalid, bf16* WT, LAS float* scr, int item, int lane) {
    const int nblk = N / 32, kb = item / nblk, nb = item % nblk, k0 = 64 * kb, n0 = 32 * nb;
    const int n4 = (lane & 7) * 4, nn = n0 + n4;
    f32x4 ld[8];
#pragma unroll
    for (int i = 0; i < 8; ++i) { const int kk = 8 * i + (lane >> 3); ld[i] = nn < Nvalid ? *(const f32x4*)(W + (size_t)(k0 + kk) * Nvalid + nn) : (f32x4){0.f, 0.f, 0.f, 0.f}; }
#pragma unroll
    for (int i = 0; i < 8; ++i) { const int kk = 8 * i + (lane >> 3); LAS float* d = scr + kk * 33 + n4; d[0] = ld[i].x; d[1] = ld[i].y; d[2] = ld[i].z; d[3] = ld[i].w; }
    LDS_WAIT(); asm volatile("" ::: "memory");
    const int c = lane & 7;
#pragma unroll
    for (int j = 0; j < 4; ++j) { const int n = (lane >> 3) + 8 * j; const LAS float* s = scr + (8 * c) * 33 + n;
        v4u o; o.x = pk2(s[0 * 33], s[1 * 33]); o.y = pk2(s[2 * 33], s[3 * 33]); o.z = pk2(s[4 * 33], s[5 * 33]); o.w = pk2(s[6 * 33], s[7 * 33]);
        *(GAS v4u*)(WT + (size_t)(n0 + n) * K + k0 + 8 * c) = o; }
    LDS_WAIT(); asm volatile("" ::: "memory");
}
__device__ __forceinline__ void convert_weight(const float* W, int K, int N, int Nvalid, bf16* WT, LAS float* scr, int gw, int ngw, int lane) {
    const int nitems = (K / 64) * (N / 32);
#pragma unroll 1
    for (int it = gw; it < nitems; it += ngw) transpose_item(W, K, N, Nvalid, WT, scr, it, lane);
}

__device__ __forceinline__ void norm_rows(const float* xsrc, const float* csrc, int nrows, const float* g, const float* mods_l, int kshift, int kscale, bf16* hn, int gw, int ngw, int lane,
                                          const float* pend = nullptr, int pnsplit = 0, const float* pgate = nullptr, float* cdst = nullptr) {
    f32x4 gv[4];
#pragma unroll
    for (int j = 0; j < 4; ++j) gv[j] = *(const f32x4*)(g + 4 * lane + 256 * j);
    f32x4 x[4];
    if (gw < nrows) { const float* src = gw < MXR ? xsrc + (size_t)gw * DM : csrc + (size_t)(gw - MXR) * DM;
#pragma unroll
        for (int j = 0; j < 4; ++j) x[j] = *(const f32x4*)(src + 4 * lane + 256 * j); }
#pragma unroll 1
    for (int m = gw; m < nrows; m += ngw) {
        const int v = m < MXR ? (m >> 13) : 2;
        const float* sh = mods_l + (size_t)v * 6144 + kshift * 1024; const float* sc = mods_l + (size_t)v * 6144 + kscale * 1024;
        float ss = 0.f;
        f32x4 xn[4];
        { const int mn = m + ngw; if (mn < nrows) { const float* srcn = mn < MXR ? xsrc + (size_t)mn * DM : csrc + (size_t)(mn - MXR) * DM;
#pragma unroll
            for (int j = 0; j < 4; ++j) xn[j] = *(const f32x4*)(srcn + 4 * lane + 256 * j); } }
        if (pend && m >= MXR) {
            const int rl = m - MXR;
#pragma unroll
            for (int j = 0; j < 4; ++j) {
                const float* sp = pend + (size_t)(((rl >> 8) * 4 + j) * pnsplit) * 65536 + (size_t)(rl & 255) * 256 + 4 * lane;
                f32x4 sum = (f32x4){0.f, 0.f, 0.f, 0.f};
                for (int ks = 0; ks < pnsplit; ++ks) sum += *(const f32x4*)(sp + (size_t)ks * 65536);
                x[j] += *(const f32x4*)(pgate + 4 * lane + 256 * j) * sum;
                *(f32x4*)(cdst + (size_t)rl * DM + 4 * lane + 256 * j) = x[j];
            }
        }
#pragma unroll
        for (int j = 0; j < 4; ++j) ss += (x[j].x * x[j].x + x[j].y * x[j].y) + (x[j].z * x[j].z + x[j].w * x[j].w);
        const float rstd = 1.0f / sqrtf(wave_sum(ss) * (1.0f / DM) + EPS);
#pragma unroll
        for (int j = 0; j < 4; ++j) {
            const f32x4 s4 = *(const f32x4*)(sc + 4 * lane + 256 * j), h4 = *(const f32x4*)(sh + 4 * lane + 256 * j);
            const f32x4 y = x[j] * rstd * gv[j] * (s4 + 1.0f) + h4;
            u32x2 o; o.x = pk2(y.x, y.y); o.y = pk2(y.z, y.w);
            *(u32x2*)(hn + (size_t)m * DM + 4 * lane + 256 * j) = o;
        }
#pragma unroll
        for (int j = 0; j < 4; ++j) x[j] = xn[j];
    }
}
__device__ __forceinline__ void final_norm_rows(float* x, const float* g, int gw, int ngw, int lane) {
    f32x4 gv[4];
#pragma unroll
    for (int j = 0; j < 4; ++j) gv[j] = *(const f32x4*)(g + 4 * lane + 256 * j);
    f32x4 v[4];
    if (gw < MXR) {
#pragma unroll
        for (int j = 0; j < 4; ++j) v[j] = *(const f32x4*)(x + (size_t)gw * DM + 4 * lane + 256 * j); }
#pragma unroll 1
    for (int m = gw; m < MXR; m += ngw) {
        float* src = x + (size_t)m * DM;
        float ss = 0.f;
        f32x4 vn[4];
        if (m + ngw < MXR) {
#pragma unroll
            for (int j = 0; j < 4; ++j) vn[j] = *(const f32x4*)(x + (size_t)(m + ngw) * DM + 4 * lane + 256 * j); }
#pragma unroll
        for (int j = 0; j < 4; ++j) ss += (v[j].x * v[j].x + v[j].y * v[j].y) + (v[j].z * v[j].z + v[j].w * v[j].w);
        const float rstd = 1.0f / sqrtf(wave_sum(ss) * (1.0f / DM) + EPS);
#pragma unroll
        for (int j = 0; j < 4; ++j) *(f32x4*)(src + 4 * lane + 256 * j) = v[j] * rstd * gv[j];
#pragma unroll
        for (int j = 0; j < 4; ++j) v[j] = vn[j];
    }
}

__device__ __forceinline__ void cv_unpack(const u32x4 v, float (&o)[8]) { o[0] = bflo(v.x); o[1] = bfhi(v.x); o[2] = bflo(v.y); o[3] = bfhi(v.y); o[4] = bflo(v.z); o[5] = bfhi(v.z); o[6] = bflo(v.w); o[7] = bfhi(v.w); }
__device__ __forceinline__ void ffn_conv_phase(const bf16* a, bf16* up, const float* cw  , const float* cb, int row_first, int nrows, int gtid, int ngt, bf16* outp, long out_row_delta) {
    constexpr int ncg = DFF / 8, SEG = 16;
    const int nseg = nrows / SEG, tpc = ngt / ncg;
    if (gtid >= tpc * ncg) return;
    const int cgi = gtid % ncg, c = cgi * 8;
    float w[9][8], bias[8];
#pragma unroll
    for (int k = 0; k < 9; ++k) { const f32x4 w0 = *(const f32x4*)(cw + (size_t)k * DFF + c), w1 = *(const f32x4*)(cw + (size_t)k * DFF + c + 4);
        w[k][0] = w0.x; w[k][1] = w0.y; w[k][2] = w0.z; w[k][3] = w0.w; w[k][4] = w1.x; w[k][5] = w1.y; w[k][6] = w1.z; w[k][7] = w1.w; }
    { const f32x4 b0 = *(const f32x4*)(cb + c), b1 = *(const f32x4*)(cb + c + 4); bias[0] = b0.x; bias[1] = b0.y; bias[2] = b0.z; bias[3] = b0.w; bias[4] = b1.x; bias[5] = b1.y; bias[6] = b1.z; bias[7] = b1.w; }
#pragma unroll 1
    for (int seg = gtid / ncg; seg < nseg; seg += tpc) {
        const int row0 = row_first + seg * SEG;
        int rr, ww0, nr, nw;
        if (row0 < MXR) { const int t = row0 & 8191; rr = t >> 6; ww0 = t & 63; nr = 128; nw = 64; } else { const int t = (row0 - MXR) & 255; rr = 0; ww0 = t; nr = 1; nw = 256; }
        const bool has_up = rr > 0, has_dn = rr < nr - 1;
        const u32x4 zero = (u32x4){0u, 0u, 0u, 0u};
        u32x4 win[3][3];
        const bf16* pm = a + (size_t)row0 * DFF + c;
#pragma unroll
        for (int ky = 0; ky < 3; ++ky) {
            const bool okr = ky == 0 ? has_up : (ky == 2 ? has_dn : true);
            const bf16* pr = pm + (ptrdiff_t)(ky - 1) * nw * DFF;
            win[ky][0] = (okr && ww0 > 0) ? *(const u32x4*)(pr - DFF) : zero;
            win[ky][1] = okr ? *(const u32x4*)pr : zero;
        }
#pragma unroll 4
        for (int i = 0; i < SEG; ++i) {
            const int wcur = ww0 + i;
            const bool okn = wcur + 1 < nw;
#pragma unroll
            for (int ky = 0; ky < 3; ++ky) {
                const bool okr = ky == 0 ? has_up : (ky == 2 ? has_dn : true);
                win[ky][2] = (okr && okn) ? *(const u32x4*)(pm + (ptrdiff_t)((ky - 1) * nw + i + 1) * DFF) : zero;
            }
            const u32x4 uv = *(const u32x4*)(up + (size_t)(row0 + i) * DFF + c);
            float acc[8];
#pragma unroll
            for (int j = 0; j < 8; ++j) acc[j] = bias[j];
#pragma unroll
            for (int ky = 0; ky < 3; ++ky)
#pragma unroll
                for (int kx = 0; kx < 3; ++kx) { float v[8]; cv_unpack(win[ky][kx], v);
#pragma unroll
                    for (int j = 0; j < 8; ++j) acc[j] += w[ky * 3 + kx][j] * v[j]; }
            float u[8]; cv_unpack(uv, u);
            u32x4 o;
            o.x = pk2(siluf(acc[0]) * u[0], siluf(acc[1]) * u[1]); o.y = pk2(siluf(acc[2]) * u[2], siluf(acc[3]) * u[3]);
            o.z = pk2(siluf(acc[4]) * u[4], siluf(acc[5]) * u[5]); o.w = pk2(siluf(acc[6]) * u[6], siluf(acc[7]) * u[7]);
            *(u32x4*)(outp + (size_t)(row0 + i + out_row_delta) * DFF + c) = o;
#pragma unroll
            for (int ky = 0; ky < 3; ++ky) { win[ky][0] = win[ky][1]; win[ky][1] = win[ky][2]; }
        }
    }
}
constexpr int FN = 16384, FNP = FN + (FN >> 6) * 4;
constexpr int FFT_SCR = FNP * 8;
__device__ __forceinline__ int DI(int i) { return i + ((i >> 6) << 2); }
__device__ __forceinline__ f32x2 cmul(f32x2 a, f32x2 b) { return (f32x2){a.x * b.x - a.y * b.y, a.x * b.y + a.y * b.x}; }
__device__ __forceinline__ f32x2 cmulc(f32x2 a, f32x2 b) { return (f32x2){a.x * b.x + a.y * b.y, a.y * b.x - a.x * b.y}; }
__device__ __forceinline__ int rev4(int p) {
    unsigned r = __brev((unsigned)p) >> 18;
    return (int)(((r & 0x1555u) << 1) | ((r >> 1) & 0x1555u));
}
#define BF4F(x0, x1, x2, x3) do { const f32x2 a_ = x0 + x2, b_ = x0 - x2, c_ = x1 + x3, d_ = x1 - x3; x0 = a_ + c_; x2 = a_ - c_; x1 = (f32x2){b_.x + d_.y, b_.y - d_.x}; x3 = (f32x2){b_.x - d_.y, b_.y + d_.x}; } while (0)
#define BF4I(x0, x1, x2, x3) do { const f32x2 a_ = x0 + x2, b_ = x0 - x2, c_ = x1 + x3, d_ = x1 - x3; x0 = a_ + c_; x2 = a_ - c_; x1 = (f32x2){b_.x - d_.y, b_.y + d_.x}; x3 = (f32x2){b_.x + d_.y, b_.y - d_.x}; } while (0)
#define W16_C1 0.92387953251128674f
#define W16_S1 0.38268343236508977f
#define W16_H 0.70710678118654752f
__device__ __forceinline__ f32x2 w16(int e) {
    switch (e) { case 1: return (f32x2){W16_C1, -W16_S1}; case 2: return (f32x2){W16_H, -W16_H}; case 3: return (f32x2){W16_S1, -W16_C1}; case 4: return (f32x2){0.f, -1.f};
                 case 6: return (f32x2){-W16_H, -W16_H}; default: return (f32x2){-W16_C1, W16_S1}; }
}
template <bool INV> __device__ __forceinline__ void fft_pass16(LAS f32x2* D, int lgm, int tid) {
    const int m = 1 << lgm; const float rn = 1.0f / (float)(16 << lgm);
#pragma unroll 1
    for (int it = 0; it < 2; ++it) {
        const int bf = tid + NTHR * it, j0 = bf & (m - 1), base = ((bf >> lgm) << (lgm + 4)) + j0;
        f32x2 v[16];
#pragma unroll
        for (int r = 0; r < 16; ++r) v[r] = D[DI(base + r * m)];
        const float rev = (float)j0 * rn;
        const f32x2 w1 = (f32x2){__builtin_amdgcn_cosf(rev), -__builtin_amdgcn_sinf(rev)}, w2 = cmul(w1, w1), w3 = cmul(w2, w1);
        const f32x2 u1 = cmul(w2, w2), u2 = cmul(u1, u1), u3 = cmul(u2, u1);
        if (!INV) {
#pragma unroll
            for (int a = 0; a < 4; ++a) {
                BF4F(v[a], v[a + 4], v[a + 8], v[a + 12]);
                if (a > 0) { v[a + 4] = cmul(v[a + 4], w16(a)); v[a + 8] = cmul(v[a + 8], w16(2 * a)); v[a + 12] = cmul(v[a + 12], w16(3 * a)); }
                v[a + 4] = cmul(v[a + 4], w1); v[a + 8] = cmul(v[a + 8], w2); v[a + 12] = cmul(v[a + 12], w3);
            }
#pragma unroll
            for (int q = 0; q < 4; ++q) {
                BF4F(v[4 * q], v[4 * q + 1], v[4 * q + 2], v[4 * q + 3]);
                v[4 * q + 1] = cmul(v[4 * q + 1], u1); v[4 * q + 2] = cmul(v[4 * q + 2], u2); v[4 * q + 3] = cmul(v[4 * q + 3], u3);
            }
        } else {
#pragma unroll
            for (int q = 0; q < 4; ++q) {
                v[4 * q + 1] = cmulc(v[4 * q + 1], u1); v[4 * q + 2] = cmulc(v[4 * q + 2], u2); v[4 * q + 3] = cmulc(v[4 * q + 3], u3);
                BF4I(v[4 * q], v[4 * q + 1], v[4 * q + 2], v[4 * q + 3]);
            }
#pragma unroll
            for (int a = 0; a < 4; ++a) {
                v[a + 4] = cmulc(v[a + 4], w1); v[a + 8] = cmulc(v[a + 8], w2); v[a + 12] = cmulc(v[a + 12], w3);
                if (a > 0) { v[a + 4] = cmulc(v[a + 4], w16(a)); v[a + 8] = cmulc(v[a + 8], w16(2 * a)); v[a + 12] = cmulc(v[a + 12], w16(3 * a)); }
                BF4I(v[a], v[a + 4], v[a + 8], v[a + 12]);
            }
        }
#pragma unroll
        for (int r = 0; r < 16; ++r) D[DI(base + r * m)] = v[r];
    }
    __syncthreads();
}
template <bool INV> __device__ __forceinline__ void fft_pass4(LAS f32x2* D, int tid) {
#pragma unroll 2
    for (int it = 0; it < 8; ++it) {
        const int i0 = DI(4 * (tid + NTHR * it));
        f32x4 p01 = *(LAS f32x4*)(D + i0), p23 = *(LAS f32x4*)(D + i0 + 2);
        f32x2 x0 = (f32x2){p01.x, p01.y}, x1 = (f32x2){p01.z, p01.w}, x2 = (f32x2){p23.x, p23.y}, x3 = (f32x2){p23.z, p23.w};
        if (!INV) BF4F(x0, x1, x2, x3); else BF4I(x0, x1, x2, x3);
        *(LAS f32x4*)(D + i0) = (f32x4){x0.x, x0.y, x1.x, x1.y}; *(LAS f32x4*)(D + i0 + 2) = (f32x4){x2.x, x2.y, x3.x, x3.y};
    }
    __syncthreads();
}
__device__ __forceinline__ void fft_fwd(LAS f32x2* D, int tid) { fft_pass16<false>(D, 10, tid); fft_pass16<false>(D, 6, tid); fft_pass16<false>(D, 2, tid); fft_pass4<false>(D, tid); }
__device__ __forceinline__ void fft_inv(LAS f32x2* D, int tid) { fft_pass4<true>(D, tid); fft_pass16<true>(D, 2, tid); fft_pass16<true>(D, 6, tid); fft_pass16<true>(D, 10, tid); }
__device__ __forceinline__ void spec_mul(LAS f32x2* D, const f32x2* H, int tid) {
#pragma unroll 8
    for (int i = 0; i < 32; ++i) {
        const int p = tid + NTHR * i, k = rev4(p);
        f32x2 h;
        if (k <= 8192) h = H[k]; else { h = H[FN - k]; h.y = -h.y; }
        D[DI(p)] = cmul(D[DI(p)], h);
    }
    __syncthreads();
}

__device__ __forceinline__ void fft_mid(LAS f32x2* D, const unsigned* T, int tid) {
#pragma unroll 4
    for (int it = 0; it < 8; ++it) {
        const int bf = tid + NTHR * it, i0 = DI(4 * bf);
        const u32x4 hq = *(const u32x4*)(T + 4 * bf);
        f32x4 p01 = *(LAS f32x4*)(D + i0), p23 = *(LAS f32x4*)(D + i0 + 2);
        f32x2 x0 = (f32x2){p01.x, p01.y}, x1 = (f32x2){p01.z, p01.w}, x2 = (f32x2){p23.x, p23.y}, x3 = (f32x2){p23.z, p23.w};
        BF4F(x0, x1, x2, x3);
        x0 = cmul(x0, (f32x2){bflo(hq.x), bfhi(hq.x)}); x1 = cmul(x1, (f32x2){bflo(hq.y), bfhi(hq.y)}); x2 = cmul(x2, (f32x2){bflo(hq.z), bfhi(hq.z)}); x3 = cmul(x3, (f32x2){bflo(hq.w), bfhi(hq.w)});
        BF4I(x0, x1, x2, x3);
        *(LAS f32x4*)(D + i0) = (f32x4){x0.x, x0.y, x1.x, x1.y}; *(LAS f32x4*)(D + i0 + 2) = (f32x4){x2.x, x2.y, x3.x, x3.y};
    }
    __syncthreads();
}
__device__ __forceinline__ void fft_conv(LAS f32x2* D, const unsigned* H, int tid) {
    fft_pass16<false>(D, 10, tid); fft_pass16<false>(D, 6, tid); fft_pass16<false>(D, 2, tid);
    fft_mid(D, H, tid);
    fft_pass16<true>(D, 2, tid); fft_pass16<true>(D, 6, tid); fft_pass16<true>(D, 10, tid);
}

__device__ __forceinline__ void hy_spectrum_item(LAS unsigned char* lds, const bf16* h2l  , const float* w3l  , const float* hbias  , unsigned* Hs, int c, int tid, int wave, int lane) {
    LAS f32x2* D = (LAS f32x2*)lds;
    LAS f32x4* W3 = (LAS f32x4*)(lds + FFT_SCR);
    LAS float* red = (LAS float*)(lds + FFT_SCR + 2048);
    __syncthreads();
    if (tid < 64) { const float* wr = w3l + (size_t)tid * 1024 + c; W3[tid] = (f32x4){wr[0], wr[256], wr[512], wr[768]}; }
    __syncthreads();
    const float delta = fabsf(-3.0701134573253946f + (float)c * ((-15.350567286626973f + 3.0701134573253946f) / 255.0f));
    float s0 = 0.f, s1 = 0.f;
#pragma unroll 1
    for (int ib = 0; ib < 4; ++ib) {
        asm volatile("" ::: "memory");
        f32x4 acc[4];
#pragma unroll
        for (int u = 0; u < 4; ++u) acc[u] = (f32x4){0.f, 0.f, 0.f, 0.f};
#pragma unroll 2
        for (int j8 = 0; j8 < 8; ++j8) {
            f32x4 w[8];
#pragma unroll
            for (int e = 0; e < 8; ++e) w[e] = W3[8 * j8 + e];
#pragma unroll
            for (int u = 0; u < 4; ++u) {
                const int t = tid + NTHR * (4 * ib + u);
                const u32x4 hv = *(const u32x4*)(h2l + (size_t)t * 64 + 8 * j8);
                acc[u] += w[0] * bflo(hv.x) + w[1] * bfhi(hv.x) + w[2] * bflo(hv.y) + w[3] * bfhi(hv.y) + w[4] * bflo(hv.z) + w[5] * bfhi(hv.z) + w[6] * bflo(hv.w) + w[7] * bfhi(hv.w);
            }
        }
#pragma unroll
        for (int u = 0; u < 4; ++u) {
            const int t = tid + NTHR * (4 * ib + u);
            const f32x4 a = acc[u] * __expf(-((float)t / 8191.0f) * delta);
            D[DI(t)] = (f32x2){a.x, a.y};
            s0 += fabsf(a.x); s1 += fabsf(a.y);
            if (t >= 1) { D[DI(FN - t)] = (f32x2){a.z, a.w}; s0 += fabsf(a.z); s1 += fabsf(a.w); }
            if (t == 0) D[DI(8192)] = (f32x2){0.f, 0.f};
        }
    }
    block_sum2(s0, s1, red, wave, lane);
    fft_fwd(D, tid);
    const float i0 = 0.5f / s0, i1 = 0.5f / s1, bias0 = hbias[c], bias1 = hbias[256 + c];
    unsigned* T0 = Hs + (size_t)(c * 2 + 0) * FN; unsigned* T1 = Hs + (size_t)(c * 2 + 1) * FN;
#pragma unroll 4
    for (int i = 0; i < 32; ++i) {
        const int p = tid + NTHR * i, k = rev4(p);
        const f32x2 zk = D[DI(p)], zn = D[DI(rev4((FN - k) & (FN - 1)))];
        T0[p] = pk2((zk.x + zn.x) * i0 + bias0, (zk.y - zn.y) * i0);
        T1[p] = pk2((zk.y + zn.y) * i1 + bias1, -(zk.x - zn.x) * i1);
    }
    __syncthreads();
}

__device__ __forceinline__ float hy_conv3(const bf16* row, int t, int len, float w0, float w1, float w2, float bias) {
    const float um = t > 0 ? bf2f(row[t - 1]) : 0.f, u0 = bf2f(row[t]), up = t < len - 1 ? bf2f(row[t + 1]) : 0.f;
    return w0 * um + w1 * u0 + w2 * up + bias;
}
__device__ __forceinline__ void hy_conv8(const bf16* row, int t0, int len, float w0, float w1, float w2, float bias, float (&o)[8]) {
    const u32x4 v = *(const u32x4*)(row + t0);
    const float um = t0 > 0 ? bf2f(row[t0 - 1]) : 0.f, un = t0 + 8 < len ? bf2f(row[t0 + 8]) : 0.f;
    float x[10]; x[0] = um; x[1] = bflo(v.x); x[2] = bfhi(v.x); x[3] = bflo(v.y); x[4] = bfhi(v.y); x[5] = bflo(v.z); x[6] = bfhi(v.z); x[7] = bflo(v.w); x[8] = bfhi(v.w); x[9] = un;
#pragma unroll
    for (int e = 0; e < 8; ++e) o[e] = w0 * x[e] + w1 * x[e + 1] + w2 * x[e + 2] + bias;
}
__device__ __forceinline__ void hy_fft_item(LAS unsigned char* lds, const bf16* uhyT, const float* cw  , const float* cb  , const unsigned* Hs, bf16* hyoT, int c, int tid) {
    LAS f32x2* D = (LAS f32x2*)lds;
    const bf16* rv = uhyT + (size_t)c * MROWS; const bf16* r1 = uhyT + (size_t)(256 + c) * MROWS; const bf16* r2 = uhyT + (size_t)(512 + c) * MROWS;
    const float vw0 = cw[c], vw1 = cw[768 + c], vw2 = cw[1536 + c], vb = cb[c];
    const float aw0 = cw[256 + c], aw1 = cw[768 + 256 + c], aw2 = cw[1536 + 256 + c], ab = cb[256 + c];
    const float bw0 = cw[512 + c], bw1 = cw[768 + 512 + c], bw2 = cw[1536 + 512 + c], bb = cb[512 + c];
    const float inv = 1.0f / (float)FN;
    __syncthreads();
#pragma unroll
    for (int i = 0; i < 2; ++i) { const int t0 = 8 * (tid + NTHR * i);
        float a[8], b[8]; hy_conv8(rv, t0, LX, vw0, vw1, vw2, vb, a); hy_conv8(rv + LX, t0, LX, vw0, vw1, vw2, vb, b);
#pragma unroll
        for (int e = 0; e < 8; ++e) { D[DI(t0 + e)] = (f32x2){a[e], b[e]}; D[DI(t0 + e + LX)] = (f32x2){0.f, 0.f}; } }
    __syncthreads();
    fft_conv(D, Hs + (size_t)(c * 2 + 0) * FN, tid);
#pragma unroll
    for (int i = 0; i < 2; ++i) { const int t0 = 8 * (tid + NTHR * i);
        float a[8], b[8]; hy_conv8(r1, t0, LX, aw0, aw1, aw2, ab, a); hy_conv8(r1 + LX, t0, LX, aw0, aw1, aw2, ab, b);
#pragma unroll
        for (int e = 0; e < 8; ++e) { const f32x2 cv = D[DI(t0 + e)]; D[DI(t0 + e)] = (f32x2){a[e] * cv.x * inv, b[e] * cv.y * inv}; D[DI(t0 + e + LX)] = (f32x2){0.f, 0.f}; } }
    __syncthreads();
    fft_conv(D, Hs + (size_t)(c * 2 + 1) * FN, tid);
#pragma unroll
    for (int i = 0; i < 2; ++i) { const int t0 = 8 * (tid + NTHR * i);
        float a[8], b[8], oa[8], ob[8]; hy_conv8(r2, t0, LX, bw0, bw1, bw2, bb, a); hy_conv8(r2 + LX, t0, LX, bw0, bw1, bw2, bb, b);
#pragma unroll
        for (int e = 0; e < 8; ++e) { const f32x2 cv = D[DI(t0 + e)]; oa[e] = a[e] * cv.x * inv; ob[e] = b[e] * cv.y * inv; }
        *(u32x4*)(hyoT + (size_t)c * MROWS + t0) = pack8(oa);
        *(u32x4*)(hyoT + (size_t)c * MROWS + LX + t0) = pack8(ob); }
    __syncthreads();
}

__device__ __forceinline__ void hy_ctx_conv(const LAS float* Gn, const LAS float* Yb, LAS float* Rb, int t0) {
    const LAS float* Gp = Gn + 255 + t0;
    float a0 = 0.f, a1 = 0.f, a2 = 0.f, a3 = 0.f, g0 = Gp[0], g1 = Gp[1], g2 = Gp[2], g3 = Gp[3];
#pragma unroll 4
    for (int s = 0; s < 256; ++s) {
        const float y = Yb[s];
        a0 += y * g0; a1 += y * g1; a2 += y * g2; a3 += y * g3;
        g3 = g2; g2 = g1; g1 = g0; g0 = Gp[-(s + 1)];
    }
    Rb[t0] = a0; Rb[t0 + 1] = a1; Rb[t0 + 2] = a2; Rb[t0 + 3] = a3;
}
__device__ __forceinline__ void hy_ctx_item(LAS unsigned char* lds, const bf16* uhyT, const float* cw, const float* cb, const float* hbias, const float* h2c  , const float* w3l, bf16* mix, int c, int tid, int wave, int lane) {
    LAS float* G = (LAS float*)lds + 4;
    LAS float* Y = G + 1024;
    LAS float* R = Y + 512;
    LAS f32x4* W3 = (LAS f32x4*)((LAS float*)lds + 2064);
    LAS float* red = (LAS float*)lds + 2064 + 256;
    __syncthreads();
    if (tid < 64) { const float* wr = w3l + (size_t)tid * 1024 + c; W3[tid] = (f32x4){wr[0], wr[256], wr[512], wr[768]}; }
    if (tid < 2) G[tid * 512 + 511] = 0.f;
    __syncthreads();
    const float delta = fabsf(-3.0701134573253946f + (float)c * ((-15.350567286626973f + 3.0701134573253946f) / 255.0f));
    float s0 = 0.f, s1 = 0.f;
    if (tid < 256) {
        const f32x4* hr = (const f32x4*)(h2c + (size_t)tid * 64);
        f32x4 acc = (f32x4){0.f, 0.f, 0.f, 0.f};
#pragma unroll
        for (int j4 = 0; j4 < 16; ++j4) { const f32x4 hv = hr[j4];
            acc += W3[4 * j4 + 0] * hv.x; acc += W3[4 * j4 + 1] * hv.y; acc += W3[4 * j4 + 2] * hv.z; acc += W3[4 * j4 + 3] * hv.w; }
        acc *= __expf(-((float)tid / 255.0f) * delta);
        G[255 + tid] = acc.x; G[512 + 255 + tid] = acc.y;
        if (tid >= 1) { G[255 - tid] = acc.z; G[512 + 255 - tid] = acc.w; }
        s0 = fabsf(acc.x) + (tid >= 1 ? fabsf(acc.z) : 0.f); s1 = fabsf(acc.y) + (tid >= 1 ? fabsf(acc.w) : 0.f);
    }
    block_sum2(s0, s1, red, wave, lane);
    const float n0 = 1.0f / s0, n1 = 1.0f / s1;
    const int b = tid >> 8, t = tid & 255;
    const bf16* rv = uhyT + (size_t)c * MROWS + MXR + b * LC; const bf16* r1 = uhyT + (size_t)(256 + c) * MROWS + MXR + b * LC; const bf16* r2 = uhyT + (size_t)(512 + c) * MROWS + MXR + b * LC;
    const float v = hy_conv3(rv, t, LC, cw[c], cw[768 + c], cw[1536 + c], cb[c]);
    const float g1 = hy_conv3(r1, t, LC, cw[256 + c], cw[768 + 256 + c], cw[1536 + 256 + c], cb[256 + c]);
    const float g2 = hy_conv3(r2, t, LC, cw[512 + c], cw[768 + 512 + c], cw[1536 + 512 + c], cb[512 + c]);
    Y[b * 256 + t] = v;
    __syncthreads();
    if (tid < 128) hy_ctx_conv(G, Y + (tid >> 6) * 256, R + (tid >> 6) * 256, 4 * (tid & 63));
    __syncthreads();
    const float y1 = g1 * (R[b * 256 + t] * n0 + v * hbias[c]);
    Y[b * 256 + t] = y1;
    __syncthreads();
    if (tid < 128) hy_ctx_conv(G + 512, Y + (tid >> 6) * 256, R + (tid >> 6) * 256, 4 * (tid & 63));
    __syncthreads();
    const float o = g2 * (R[b * 256 + t] * n1 + y1 * hbias[256 + c]);
    mix[(size_t)(MXR + b * LC + t) * DM + 256 + c] = (bf16)f2bf(o);
    __syncthreads();
}
typedef short s16x4 __attribute__((ext_vector_type(4)));
#define LBAR() do { asm volatile("s_waitcnt lgkmcnt(0)" ::: "memory"); __builtin_amdgcn_s_barrier(); asm volatile("" ::: "memory"); } while (0)
#define MFMA32(a, b, c) __builtin_amdgcn_mfma_f32_16x16x32_bf16((a), (b), (c), 0, 0, 0)
__device__ __forceinline__ bf16x8 frag16(const LAS bf16* p) { return *(const LAS bf16x8*)p; }
__device__ __forceinline__ bf16x8 frag2x8(const LAS bf16* p0, const LAS bf16* p1) { const s16x4 a = *(const LAS s16x4*)p0, b = *(const LAS s16x4*)p1; return __builtin_shufflevector(a, b, 0, 1, 2, 3, 4, 5, 6, 7); }
__device__ __forceinline__ bf16x8 pack_acc2(const f32x4 a, const f32x4 b) { u32x4 u; u.x = pk2(a[0], a[1]); u.y = pk2(a[2], a[3]); u.z = pk2(b[0], b[1]); u.w = pk2(b[2], b[3]); return __builtin_bit_cast(bf16x8, u); }

__device__ __forceinline__ void ssd_prepass(const bf16* uxs, const bf16* ubc, const float* cw  , const float* cb  , bf16* axt, bf16* abc, bf16* abt, int gw, int ngw, int lane) {
    const int wpc = ngw / 96;
    if (gw < wpc * 96) {
    const int cg = gw % 96, xcol = cg < 64 ? 8 * cg : 512 + 8 * (cg - 64);
    float tw0[8], tw1[8], tw2[8], tb[8];
#pragma unroll
    for (int j = 0; j < 8; ++j) { tw0[j] = cw[xcol + j]; tw1[j] = cw[1024 + xcol + j]; tw2[j] = cw[2048 + xcol + j]; tb[j] = cb[xcol + j]; }
#pragma unroll 2
    for (int C = gw / 96; C < 264; C += wpc) {
        const int row = 64 * C + lane;
        const int t = row < MXR ? (row & 8191) : ((row - MXR) & 255), len = row < MXR ? LX : LC;
        const bf16* src = cg < 64 ? uxs + (size_t)row * 512 + 8 * cg : ubc + (size_t)row * 512 + 8 * (cg - 64);
        const u32x4 u0 = *(const u32x4*)src;
        const u32x4 um = t > 0 ? *(const u32x4*)(src - 512) : (u32x4){0u, 0u, 0u, 0u};
        const u32x4 un = t < len - 1 ? *(const u32x4*)(src + 512) : (u32x4){0u, 0u, 0u, 0u};
        float a[8], c0[8], c2[8], o[8];
        cv_unpack(um, a); cv_unpack(u0, c0); cv_unpack(un, c2);
#pragma unroll
        for (int j = 0; j < 8; ++j) o[j] = siluf(tw0[j] * a[j] + tw1[j] * c0[j] + tw2[j] * c2[j] + tb[j]);
        bf16* dst = cg < 64 ? axt + ((size_t)(C * 8 + (cg >> 3)) * 64 + 8 * (cg & 7)) * 64 + lane : abt + ((size_t)(C * 2 + ((cg - 64) >> 4)) * 128 + 8 * ((cg - 64) & 15)) * 64 + lane;
#pragma unroll
        for (int j = 0; j < 8; ++j) dst[j * 64] = (bf16)f2bf(o[j]);
    }
    }
    {
        float w0[8], w1[8], w2[8], bi[8];
#pragma unroll
        for (int j = 0; j < 8; ++j) { const int xcol = 512 + 8 * lane + j; w0[j] = cw[xcol]; w1[j] = cw[1024 + xcol]; w2[j] = cw[2048 + xcol]; bi[j] = cb[xcol]; }
#pragma unroll 1
        for (int it = gw; it < MROWS / 16; it += ngw) {
            const int r0 = 16 * it;
            const int t0 = r0 < MXR ? (r0 & 8191) : ((r0 - MXR) & 255), len = r0 < MXR ? LX : LC;
            const bf16* src = ubc + (size_t)r0 * 512 + 8 * lane;
            u32x4 pm = t0 > 0 ? *(const u32x4*)(src - 512) : (u32x4){0u, 0u, 0u, 0u};
            u32x4 pc = *(const u32x4*)src;
#pragma unroll 4
            for (int i = 0; i < 16; ++i) {
                const u32x4 pn = (t0 + i < len - 1) ? *(const u32x4*)(src + (size_t)(i + 1) * 512) : (u32x4){0u, 0u, 0u, 0u};
                float a[8], c0[8], c2[8], o[8];
                cv_unpack(pm, a); cv_unpack(pc, c0); cv_unpack(pn, c2);
#pragma unroll
                for (int j = 0; j < 8; ++j) o[j] = siluf(w0[j] * a[j] + w1[j] * c0[j] + w2[j] * c2[j] + bi[j]);
                *(u32x4*)(abc + (size_t)(r0 + i) * 512 + 8 * lane) = pack8(o);
                pm = pc; pc = pn;
            }
        }
    }
}

struct SsdArgs {
    const bf16* axt; const bf16* abc; const bf16* abt; const bf16* uz; const float* udt; const float* dtb; const float* alog; const float* dvec;
    float* sst; float* dts; bf16* mix; float* ssq;
};
constexpr int XP = 72, BP = 136;

__device__ __forceinline__ void ssd_state_item(LAS unsigned char* lds, const SsdArgs& A, int b, int sc, int h, int tid, int wave, int lane) {
    LAS bf16* XsT = (LAS bf16*)lds;
    LAS bf16* BtT = XsT + 4 * 64 * XP;
    LAS float* wv = (LAS float*)(BtT + 4 * 128 * XP);
    LAS float* aend = wv + 512;
    const int g = h >> 2;
    const int row0 = sc == 32 ? MXR + b * LC : b * LX, tok0 = sc == 32 ? 0 : sc * 256;
    const int pt = wave & 3, half = wave >> 2, l15 = lane & 15, l4 = lane >> 4;
    const int Cg0 = (row0 + tok0) >> 6;
    u32x4 raw[4][3];
#pragma unroll
    for (int ci = 0; ci < 4; ++ci) {
        raw[ci][0] = *(const u32x4*)(A.axt + ((size_t)((Cg0 + ci) * 8 + h) * 64 + (tid >> 3)) * 64 + 8 * (tid & 7));
#pragma unroll
        for (int k = 0; k < 2; ++k) { const int e = tid + NTHR * k; raw[ci][1 + k] = *(const u32x4*)(A.abt + ((size_t)((Cg0 + ci) * 2 + g) * 128 + (e >> 3)) * 64 + 8 * (e & 7)); }
    }
    {
        const int dir = wave >> 2, ci = wave & 3, tok = dir ? 63 - lane : lane;
        const float rawv = A.udt[(size_t)(row0 + tok0 + 64 * ci + tok) * 16 + dir * 8 + h] + A.dtb[dir * 8 + h];
        const float dt = rawv > 20.f ? rawv : log1pf(__expf(rawv));
        float x = dt * (-__expf(A.alog[dir * 8 + h]));
#pragma unroll
        for (int off = 1; off < 64; off <<= 1) { const float y = __shfl_up(x, off); if (lane >= off) x += y; }
        const float ae = __shfl(x, 63);
        __syncthreads();
        wv[(dir * 4 + ci) * 64 + tok] = dt * __expf(ae - x);
        if (lane == 0) aend[dir * 4 + ci] = ae;
    }
#pragma unroll
    for (int ci = 0; ci < 4; ++ci) {
        *(LAS u32x4*)(XsT + (ci * 64 + (tid >> 3)) * XP + 8 * (tid & 7)) = raw[ci][0];
#pragma unroll
        for (int k = 0; k < 2; ++k) { const int e = tid + NTHR * k; *(LAS u32x4*)(BtT + (ci * 128 + (e >> 3)) * XP + 8 * (e & 7)) = raw[ci][1 + k]; }
    }
    __syncthreads();
#pragma unroll 1
    for (int dir = 0; dir < 2; ++dir) {
        f32x4 ST[4];
#pragma unroll
        for (int nt = 0; nt < 4; ++nt) ST[nt] = (f32x4){0.f, 0.f, 0.f, 0.f};
#pragma unroll 1
        for (int step = 0; step < 4; ++step) {
            const int ci = dir ? 3 - step : step;
            const float ea = __expf(aend[dir * 4 + ci]);
            bf16x8 xw[2];
#pragma unroll
            for (int kk = 0; kk < 2; ++kk) {
                const u32x4 xu = *(const LAS u32x4*)(XsT + (ci * 64 + 16 * pt + l15) * XP + 32 * kk + 8 * l4);
                const LAS float* wp = wv + (dir * 4 + ci) * 64 + 32 * kk + 8 * l4;
                const f32x4 w0 = *(const LAS f32x4*)wp, w1 = *(const LAS f32x4*)(wp + 4);
                u32x4 u; u.x = pk2(bflo(xu.x) * w0.x, bfhi(xu.x) * w0.y); u.y = pk2(bflo(xu.y) * w0.z, bfhi(xu.y) * w0.w); u.z = pk2(bflo(xu.z) * w1.x, bfhi(xu.z) * w1.y); u.w = pk2(bflo(xu.w) * w1.z, bfhi(xu.w) * w1.w);
                xw[kk] = __builtin_bit_cast(bf16x8, u);
            }
#pragma unroll
            for (int nt = 0; nt < 4; ++nt) {
                f32x4 acc = ST[nt] * ea;
                const LAS bf16* pa = BtT + (ci * 128 + 16 * (4 * half + nt) + l15) * XP + 8 * l4;
#pragma unroll
                for (int kk = 0; kk < 2; ++kk) acc = MFMA32(frag16(pa + 32 * kk), xw[kk], acc);
                ST[nt] = acc;
            }
        }
        float* slot = A.sst + ((size_t)(((b * 2 + dir) * 33 + sc) * 8 + h)) * 8192;
#pragma unroll
        for (int nt = 0; nt < 4; ++nt) *(f32x4*)(slot + (size_t)(16 * pt + l15) * 128 + 16 * (4 * half + nt) + 4 * l4) = ST[nt];
    }
    if (tid < 2) A.dts[((b * 2 + tid) * 33 + sc) * 8 + h] = __expf((aend[tid * 4] + aend[tid * 4 + 1]) + (aend[tid * 4 + 2] + aend[tid * 4 + 3]));
}

template <int MODE>
__device__ __forceinline__ void ssd_item(LAS unsigned char* lds, const SsdArgs& A, int b, int sc, int hp, int dir, int tid, int wave, int lane) {
    LAS bf16* Bt = (LAS bf16*)lds;
    LAS bf16* BtT = Bt + 64 * BP;
    LAS bf16* Ct = BtT + 128 * XP;
    LAS bf16* XsT0 = Ct + 64 * BP;
    LAS bf16* Mt0 = XsT0 + 2 * 64 * XP;
    LAS float* vec0 = (LAS float*)(Mt0 + 2 * 64 * XP);
    LAS float* SQ0 = vec0 + 2 * 272;
    const int hh = wave >> 2, pt = wave & 3, h = 2 * hp + hh, g = hp >> 1, l15 = lane & 15, l4 = lane >> 4;
    LAS bf16* XsT = XsT0 + hh * 64 * XP; LAS bf16* Mt = Mt0 + hh * 64 * XP;
    LAS float* dtv = vec0 + hh * 272, *acs = dtv + 64, *wv = dtv + 128, *eacs = dtv + 192, *misc = dtv + 256;
    LAS float* SQ = SQ0 + hh * 256;
    const int row0 = sc == 32 ? MXR + b * LC : b * LX, tok0 = sc == 32 ? 0 : sc * 256;
    const int Cg0 = (row0 + tok0) >> 6;
    const float* slot = A.sst + ((size_t)(((b * 2 + dir) * 33 + sc) * 8 + h)) * 8192;
    f32x4 ST[8];
#pragma unroll
    for (int nt = 0; nt < 8; ++nt) {
        if (sc == 32) ST[nt] = (f32x4){0.f, 0.f, 0.f, 0.f};
        else ST[nt] = *(const f32x4*)(slot + (size_t)(16 * pt + l15) * 128 + 16 * nt + 4 * l4);
    }
    const float a_h = -__expf(A.alog[dir * 8 + h]), dtb_h = A.dtb[dir * 8 + h], d_h = A.dvec[h];
    u32x4 raw[8]; float dtraw = 0.f;
#define SSD_ISSUE(ci) do { const int Cg = Cg0 + (ci); const size_t rb = (size_t)(row0 + tok0 + 64 * (ci)); \
        _Pragma("unroll") for (int k = 0; k < 2; ++k) { const int e = tid + NTHR * k; \
            raw[k] = *(const u32x4*)(A.axt + ((size_t)(Cg * 8 + 2 * hp + k) * 64 + (tid >> 3)) * 64 + 8 * (tid & 7)); \
            raw[2 + k] = *(const u32x4*)(A.abt + ((size_t)(Cg * 2 + g) * 128 + (e >> 3)) * 64 + 8 * (e & 7)); \
            raw[4 + k] = *(const u32x4*)(A.abc + (rb + (e >> 4)) * 512 + g * 128 + 8 * (e & 15)); \
            raw[6 + k] = *(const u32x4*)(A.abc + (rb + (e >> 4)) * 512 + 256 + g * 128 + 8 * (e & 15)); } \
        if (pt == 0) dtraw = A.udt[(rb + (dir ? 63 - lane : lane)) * 16 + dir * 8 + h]; } while (0)
    SSD_ISSUE(dir ? 3 : 0);
    __syncthreads();
#pragma unroll 1
    for (int i = 0; i < 4; ++i) {
        const int ci = dir ? 3 - i : i, tokc = tok0 + 64 * ci;
#pragma unroll
        for (int k = 0; k < 2; ++k) { const int e = tid + NTHR * k;
            *(LAS u32x4*)(XsT0 + (k * 64 + (tid >> 3)) * XP + 8 * (tid & 7)) = raw[k];
            *(LAS u32x4*)(BtT + (e >> 3) * XP + 8 * (e & 7)) = raw[2 + k];
            *(LAS u32x4*)(Bt + (e >> 4) * BP + 8 * (e & 15)) = raw[4 + k];
            *(LAS u32x4*)(Ct + (e >> 4) * BP + 8 * (e & 15)) = raw[6 + k]; }
        if (pt == 0) {
            const int tok = dir ? 63 - lane : lane;
            const float rawv = dtraw + dtb_h;
            const float dt = rawv > 20.f ? rawv : log1pf(__expf(rawv));
            float x = dt * a_h;
#pragma unroll
            for (int off = 1; off < 64; off <<= 1) { const float y = __shfl_up(x, off); if (lane >= off) x += y; }
            const float aend = __shfl(x, 63);
            dtv[tok] = dt; acs[tok] = x; wv[tok] = dt * __expf(aend - x); eacs[tok] = __expf(x);
            if (lane == 0) misc[0] = __expf(aend);
        }
        if (i < 3) SSD_ISSUE(dir ? 2 - i : i + 1);
        u32x2 pm_[4], pz_[4];
        if (MODE == 2) {
#pragma unroll
            for (int tt2 = 0; tt2 < 4; ++tt2) {
                const int t = tokc + 16 * tt2 + l15;
                pm_[tt2] = *(const u32x2*)(A.mix + (unsigned)((row0 + t) * DM + 512 + h * 64 + 16 * pt + 4 * l4));
                pz_[tt2] = *(const u32x2*)(A.uz + (unsigned)((row0 + t) * 512 + h * 64 + 16 * pt + 4 * l4));
            }
        }
        LBAR();
        {
            const int tt = wave >> 1;
#pragma unroll
            for (int j = 0; j < 2; ++j) {
                const int st = 2 * (wave & 1) + j;
                const bool live = dir ? st >= tt : st <= tt;
                f32x4 acc = (f32x4){0.f, 0.f, 0.f, 0.f};
                if (live) {
                    const LAS bf16* pa = Ct + (16 * tt + l15) * BP + 8 * l4; const LAS bf16* pb = Bt + (16 * st + l15) * BP + 8 * l4;
                    bf16x8 fa_[4], fb_[4];
#pragma unroll
                    for (int kk = 0; kk < 4; ++kk) { fa_[kk] = frag16(pa + 32 * kk); fb_[kk] = frag16(pb + 32 * kk); }
#pragma unroll
                    for (int kk = 0; kk < 4; ++kk) acc = MFMA32(fa_[kk], fb_[kk], acc);
                }
                const int sI = 16 * st + l15;
#pragma unroll
                for (int q = 0; q < 2; ++q) {
                    const LAS float* dq = vec0 + q * 272; const float as = dq[64 + sI], ds = dq[sI];
#pragma unroll
                    for (int r = 0; r < 4; ++r) { const int tI = 16 * tt + 4 * l4 + r;
                        const bool ok = live && (dir ? sI >= tI : sI <= tI);
                        Mt0[(q * 64 + tI) * XP + sI] = (bf16)f2bf(ok ? acc[r] * __expf(dq[64 + tI] - as) * ds : 0.f); }
                }
            }
            LBAR();
            bf16x8 STf[4];
#pragma unroll
            for (int m = 0; m < 4; ++m) STf[m] = pack_acc2(ST[2 * m], ST[2 * m + 1]);
            const bf16x8 xf0 = frag16(XsT + (16 * pt + l15) * XP + 8 * l4), xf1 = frag16(XsT + (16 * pt + l15) * XP + 32 + 8 * l4);
#pragma unroll
            for (int tt2 = 0; tt2 < 4; ++tt2) {
                const int tI = 16 * tt2 + l15;
                f32x4 accS = (f32x4){0.f, 0.f, 0.f, 0.f}, accI = (f32x4){0.f, 0.f, 0.f, 0.f};
                bf16x8 cf_[4]; const bf16x8 mf0 = frag16(Mt + tI * XP + 8 * l4), mf1 = frag16(Mt + tI * XP + 32 + 8 * l4);
#pragma unroll
                for (int m = 0; m < 4; ++m) { const LAS bf16* pc = Ct + tI * BP + 32 * m + 4 * l4; cf_[m] = frag2x8(pc, pc + 16); }
#pragma unroll
                for (int m = 0; m < 4; ++m) accS = MFMA32(STf[m], cf_[m], accS);
                if (dir ? (1 >= tt2) : true) accI = MFMA32(xf0, mf0, accI);
                if (dir ? true : (2 <= tt2)) accI = MFMA32(xf1, mf1, accI);
                f32x4 yv = accI + accS * eacs[tI];
                const int t = tokc + tI;
                bf16* mp = A.mix + (unsigned)((row0 + t) * DM + 512 + h * 64 + 16 * pt + 4 * l4);
                if (MODE == 2) {
                    const LAS bf16* xp = XsT + (16 * pt + 4 * l4) * XP + tI;
                    yv[0] = (yv[0] + bflo(pm_[tt2].x) + d_h * bf2f(xp[0])) * siluf(bflo(pz_[tt2].x)); yv[1] = (yv[1] + bfhi(pm_[tt2].x) + d_h * bf2f(xp[XP])) * siluf(bfhi(pz_[tt2].x));
                    yv[2] = (yv[2] + bflo(pm_[tt2].y) + d_h * bf2f(xp[2 * XP])) * siluf(bflo(pz_[tt2].y)); yv[3] = (yv[3] + bfhi(pm_[tt2].y) + d_h * bf2f(xp[3 * XP])) * siluf(bfhi(pz_[tt2].y));
                    float qq = (yv[0] * yv[0] + yv[1] * yv[1]) + (yv[2] * yv[2] + yv[3] * yv[3]);
                    qq += __shfl_xor(qq, 16); qq += __shfl_xor(qq, 32);
                    if (l4 == 0) SQ[pt * 64 + tI] = qq;
                }
                u32x2 o; o.x = pk2(yv[0], yv[1]); o.y = pk2(yv[2], yv[3]);
                *(u32x2*)mp = o;
            }
        }
        {
            const float ea = misc[0];
            bf16x8 xw[2];
#pragma unroll
            for (int kk = 0; kk < 2; ++kk) {
                const u32x4 xu = *(const LAS u32x4*)(XsT + (16 * pt + l15) * XP + 32 * kk + 8 * l4);
                const f32x4 w0 = *(const LAS f32x4*)(wv + 32 * kk + 8 * l4), w1 = *(const LAS f32x4*)(wv + 32 * kk + 8 * l4 + 4);
                u32x4 u; u.x = pk2(bflo(xu.x) * w0.x, bfhi(xu.x) * w0.y); u.y = pk2(bflo(xu.y) * w0.z, bfhi(xu.y) * w0.w); u.z = pk2(bflo(xu.z) * w1.x, bfhi(xu.z) * w1.y); u.w = pk2(bflo(xu.w) * w1.z, bfhi(xu.w) * w1.w);
                xw[kk] = __builtin_bit_cast(bf16x8, u);
            }
            bf16x8 af_[8][2];
#pragma unroll
            for (int nt = 0; nt < 8; ++nt) { const LAS bf16* pa = BtT + (16 * nt + l15) * XP + 8 * l4; af_[nt][0] = frag16(pa); af_[nt][1] = frag16(pa + 32); }
#pragma unroll
            for (int nt = 0; nt < 8; ++nt) ST[nt] = MFMA32(af_[nt][1], xw[1], MFMA32(af_[nt][0], xw[0], ST[nt] * ea));
        }
        LBAR();
        if (MODE == 2 && tid < 128) { const int q = tid >> 6, tI = tid & 63; const LAS float* sq = SQ0 + q * 256 + tI;
            A.ssq[(size_t)(row0 + tokc + tI) * 8 + 2 * hp + q] = (sq[0] + sq[64]) + (sq[128] + sq[192]); }
    }
#undef SSD_ISSUE
    __syncthreads();
}

struct HgArgs {
    const bf16* uhg; const float* lb0; const float* lb1; const float* normg; int layer;
    float* hst; float* dth; bf16* mix;
};
constexpr int HP = 72, PP = 40, HG_LDS_BYTES = (3 * 32 * HP + 2 * 64 * PP + 32 * PP) * 2 + (256 + 64 + 128 + 32) * 4;
template <int MODE>
__device__ __forceinline__ void hg_item(LAS unsigned char* lds, const HgArgs& A, int b, int sc, int hp, int dir, int tid, int lane) {
    const int hgp = tid >> 8, tg = tid & 255, hw = (tid >> 6) & 3, h = 2 * hp + hgp;
    LAS bf16* Qt = (LAS bf16*)(lds + hgp * HG_LDS_BYTES);
    LAS bf16* Kt = Qt + 32 * HP;
    LAS bf16* Qh = Kt + 32 * HP;
    LAS bf16* KhT = Qh + 32 * HP;
    LAS bf16* VtT = KhT + 64 * PP;
    LAS bf16* Pm = VtT + 64 * PP;
    LAS float* tot = (LAS float*)(Pm + 32 * PP);
    LAS float* ebend = tot + 256;
    LAS float* SQ = ebend + 64;
    LAS float* rstd = SQ + 128;
    const int row0 = sc == 32 ? MXR + b * LC : b * LX, tok0 = sc == 32 ? 0 : sc * 256;
    const int l15 = lane & 15, l4 = lane >> 4, vt = hw;
    float* slot = A.hst + ((size_t)(((b * 2 + dir) * 33 + sc) * 4 + h)) * 4096;
    f32x4 S[4];
#pragma unroll
    for (int kt = 0; kt < 4; ++kt) {
        if (MODE == 0 || sc == 32) S[kt] = (f32x4){0.f, 0.f, 0.f, 0.f};
        else S[kt] = *(const f32x4*)(slot + (size_t)(16 * vt + l15) * 64 + 16 * kt + 4 * l4);
    }
    const int tau = tg >> 3, kg = tg & 7;
    float lbv[8], sumb[8];
#pragma unroll
    for (int j = 0; j < 8; ++j) { const int k = h * 64 + 8 * kg + j; lbv[j] = A.layer == 0 ? 0.f : sigmf(A.lb1[k] - A.lb0[k]); sumb[j] = 0.f; }
    u32x4 qv, fv, vv;
#define HG_ISSUE(ci) do { const int s_ = 32 * (ci) + tau, t_ = dir ? tok0 + 255 - s_ : tok0 + s_; \
        const bf16* up_ = A.uhg + (size_t)(row0 + t_) * 1280 + h * 64 + 8 * kg; \
        qv = *(const u32x4*)up_; fv = *(const u32x4*)(up_ + 256 + dir * 256); vv = *(const u32x4*)(up_ + 768); } while (0)
    HG_ISSUE(0);
    __syncthreads();
#pragma unroll 1
    for (int i = 0; i < 8; ++i) {
        float q[8], f[8], v[8], kk[8], bb[8];
        q[0] = bflo(qv.x); q[1] = bfhi(qv.x); q[2] = bflo(qv.y); q[3] = bfhi(qv.y); q[4] = bflo(qv.z); q[5] = bfhi(qv.z); q[6] = bflo(qv.w); q[7] = bfhi(qv.w);
        f[0] = bflo(fv.x); f[1] = bfhi(fv.x); f[2] = bflo(fv.y); f[3] = bfhi(fv.y); f[4] = bflo(fv.z); f[5] = bfhi(fv.z); f[6] = bflo(fv.w); f[7] = bfhi(fv.w);
        v[0] = bflo(vv.x); v[1] = bfhi(vv.x); v[2] = bflo(vv.y); v[3] = bfhi(vv.y); v[4] = bflo(vv.z); v[5] = bfhi(vv.z); v[6] = bflo(vv.w); v[7] = bfhi(vv.w);
        if (i < 7) HG_ISSUE(i + 1);
#pragma unroll
        for (int j = 0; j < 8; ++j) {
            const float sg = sigmf(f[j]);
            const float fj = lbv[j] + (1.0f - lbv[j]) * sg;
            kk[j] = (1.0f - lbv[j]) * (1.0f - sg);
            float x = lbv[j] == 0.f ? fminf(f[j], 0.f) - __logf(1.0f + __expf(-fabsf(f[j]))) : __logf(fj);
#pragma unroll
            for (int off = 8; off < 64; off <<= 1) { const float y = __shfl_up(x, off); if (lane >= off) x += y; }
            bb[j] = x;
        }
        if (lane >= 56) {
#pragma unroll
            for (int j = 0; j < 8; ++j) tot[hw * 64 + 8 * kg + j] = bb[j];
        }
        LBAR();
        {
            float oq[8], ok[8], oh[8];
#pragma unroll
            for (int j = 0; j < 8; ++j) {
                const int k = 8 * kg + j;
                const float t0 = tot[k], t1 = tot[64 + k], t2 = tot[128 + k], t3 = tot[192 + k];
                const float off = hw == 0 ? 0.f : (hw == 1 ? t0 : (hw == 2 ? t0 + t1 : t0 + t1 + t2));
                const float bj = bb[j] + off, bmid = t0 + t1, bend = (t0 + t1) + (t2 + t3);
                oq[j] = q[j] * 0.125f * __expf(bj - bmid); ok[j] = kk[j] * __expf(bmid - bj); oh[j] = q[j] * 0.125f * __expf(bj);
                KhT[k * PP + tau] = (bf16)f2bf(kk[j] * __expf(bend - bj)); VtT[k * PP + tau] = (bf16)f2bf(v[j]);
                if (tau == 0) { ebend[k] = __expf(bend); sumb[j] += bend; }
            }
            if (MODE != 0) { *(LAS u32x4*)(Qt + tau * HP + 8 * kg) = pack8(oq); *(LAS u32x4*)(Kt + tau * HP + 8 * kg) = pack8(ok); *(LAS u32x4*)(Qh + tau * HP + 8 * kg) = pack8(oh); }
        }
        LBAR();
        u32x2 pv_[2], gz[2];
        if (MODE == 2) {
#pragma unroll
            for (int tt = 0; tt < 2; ++tt) { const int tI = 16 * tt + l15, s2 = 32 * i + tI, t2 = dir ? tok0 + 255 - s2 : tok0 + s2;
                pv_[tt] = *(const u32x2*)(A.mix + (unsigned)((row0 + t2) * DM + h * 64 + 16 * vt + 4 * l4));
                gz[tt] = *(const u32x2*)(A.uhg + (unsigned)((row0 + t2) * 1280 + 1024 + h * 64 + 16 * vt + 4 * l4)); }
        }
        if (MODE != 0) {
            {
                const int tt = hw >> 1, st = hw & 1;
                f32x4 acc = (f32x4){0.f, 0.f, 0.f, 0.f};
                if (st <= tt) {
                    const LAS bf16* pa = Qt + (16 * tt + l15) * HP + 8 * l4; const LAS bf16* pb = Kt + (16 * st + l15) * HP + 8 * l4;
                    acc = MFMA32(frag16(pa), frag16(pb), acc); acc = MFMA32(frag16(pa + 32), frag16(pb + 32), acc);
                }
#pragma unroll
                for (int r = 0; r < 4; ++r) { const int tI = 16 * tt + 4 * l4 + r, sI = 16 * st + l15; Pm[tI * PP + sI] = (bf16)f2bf((st <= tt && sI <= tI) ? acc[r] : 0.f); }
            }
            LBAR();
            bf16x8 Sf[2];
#pragma unroll
            for (int m = 0; m < 2; ++m) Sf[m] = pack_acc2(S[2 * m], S[2 * m + 1]);
            const bf16x8 vf = frag16(VtT + (16 * vt + l15) * PP + 8 * l4);
            f32x4 oacc[2];
#pragma unroll
            for (int tt = 0; tt < 2; ++tt) {
                f32x4 acc = (f32x4){0.f, 0.f, 0.f, 0.f};
                acc = MFMA32(vf, frag16(Pm + (16 * tt + l15) * PP + 8 * l4), acc);
#pragma unroll
                for (int m = 0; m < 2; ++m) { const LAS bf16* pq = Qh + (16 * tt + l15) * HP + 32 * m + 4 * l4;
                    acc = MFMA32(Sf[m], frag2x8(pq, pq + 16), acc); }
                oacc[tt] = acc;
            }
            if (MODE == 1) {
#pragma unroll
                for (int tt = 0; tt < 2; ++tt) { const int tI = 16 * tt + l15, s2 = 32 * i + tI, t2 = dir ? tok0 + 255 - s2 : tok0 + s2;
                    u32x2 o; o.x = pk2(oacc[tt][0], oacc[tt][1]); o.y = pk2(oacc[tt][2], oacc[tt][3]);
                    *(u32x2*)(A.mix + (unsigned)((row0 + t2) * DM + h * 64 + 16 * vt + 4 * l4)) = o; }
            } else {
#pragma unroll
                for (int tt = 0; tt < 2; ++tt) { const int tI = 16 * tt + l15; const u32x2 pv = pv_[tt];
                    oacc[tt][0] += bflo(pv.x); oacc[tt][1] += bfhi(pv.x); oacc[tt][2] += bflo(pv.y); oacc[tt][3] += bfhi(pv.y);
                    float qq = (oacc[tt][0] * oacc[tt][0] + oacc[tt][1] * oacc[tt][1]) + (oacc[tt][2] * oacc[tt][2] + oacc[tt][3] * oacc[tt][3]);
                    qq += __shfl_xor(qq, 16); qq += __shfl_xor(qq, 32);
                    if (l4 == 0) SQ[vt * 32 + tI] = qq; }
                LBAR();
                const f32x4 ng = *(const f32x4*)(A.normg + h * 64 + 16 * vt + 4 * l4);
#pragma unroll
                for (int tt = 0; tt < 2; ++tt) { const int tI = 16 * tt + l15, s2 = 32 * i + tI, t2 = dir ? tok0 + 255 - s2 : tok0 + s2;
                    const float rs = 1.0f / sqrtf(((SQ[tI] + SQ[32 + tI]) + (SQ[64 + tI] + SQ[96 + tI])) * (1.0f / 64.0f) + EPS);
                    u32x2 o; o.x = pk2(oacc[tt][0] * rs * ng.x * siluf(bflo(gz[tt].x)), oacc[tt][1] * rs * ng.y * siluf(bfhi(gz[tt].x)));
                    o.y = pk2(oacc[tt][2] * rs * ng.z * siluf(bflo(gz[tt].y)), oacc[tt][3] * rs * ng.w * siluf(bfhi(gz[tt].y)));
                    *(u32x2*)(A.mix + (unsigned)((row0 + t2) * DM + h * 64 + 16 * vt + 4 * l4)) = o; }
            }
        }
        {
            const bf16x8 vf2 = frag16(VtT + (16 * vt + l15) * PP + 8 * l4);
#pragma unroll
            for (int kt = 0; kt < 4; ++kt) {
                f32x4 acc;
#pragma unroll
                for (int r = 0; r < 4; ++r) acc[r] = S[kt][r] * ebend[16 * kt + 4 * l4 + r];
                S[kt] = MFMA32(frag16(KhT + (16 * kt + l15) * PP + 8 * l4), vf2, acc);
            }
        }
        LBAR();
    }
#undef HG_ISSUE
    if (MODE == 0) {
#pragma unroll
        for (int kt = 0; kt < 4; ++kt) *(f32x4*)(slot + (size_t)(16 * vt + l15) * 64 + 16 * kt + 4 * l4) = S[kt];
        if (tau == 0) {
#pragma unroll
            for (int j = 0; j < 8; ++j) A.dth[((size_t)(((b * 2 + dir) * 33 + sc) * 4 + h)) * 64 + 8 * kg + j] = __expf(sumb[j]);
        }
    }
    __syncthreads();
}


constexpr int SP = 264;
__device__ __forceinline__ void hg_state_item(LAS unsigned char* lds, const HgArgs& A, int b, int sc, int h, int tid, int wave, int lane) {
    LAS bf16* KfT = (LAS bf16*)lds;
    LAS bf16* KbT = KfT + 64 * SP;
    LAS bf16* VtT = KbT + 64 * SP;
    const int row0 = sc == 32 ? MXR + b * LC : b * LX, tok0 = sc == 32 ? 0 : sc * 256;
    const int kg = wave, l15 = lane & 15, l4 = lane >> 4;
    u32x4 fa[4], fb[4], va[4];
#pragma unroll
    for (int e = 0; e < 4; ++e) { const bf16* up = A.uhg + (size_t)(row0 + tok0 + 4 * lane + e) * 1280 + h * 64 + 8 * kg;
        fa[e] = *(const u32x4*)(up + 256); fb[e] = *(const u32x4*)(up + 512); va[e] = *(const u32x4*)(up + 768); }
    float lbv[8];
#pragma unroll
    for (int j = 0; j < 8; ++j) { const int k = h * 64 + 8 * kg + j; lbv[j] = A.layer == 0 ? 0.f : sigmf(A.lb1[k] - A.lb0[k]); }
    __syncthreads();
#pragma unroll
    for (int dir = 0; dir < 2; ++dir) {
        float lf[4][8], kk[4][8];
#pragma unroll
        for (int e = 0; e < 4; ++e) { float f[8]; cv_unpack(dir ? fb[e] : fa[e], f);
#pragma unroll
            for (int j = 0; j < 8; ++j) { const float sg = sigmf(f[j]); kk[e][j] = (1.0f - lbv[j]) * (1.0f - sg);
                lf[e][j] = lbv[j] == 0.f ? fminf(f[j], 0.f) - __logf(1.0f + __expf(-fabsf(f[j]))) : __logf(lbv[j] + (1.0f - lbv[j]) * sg); } }
#pragma unroll
        for (int j = 0; j < 8; ++j) {
            const float tsum = (lf[0][j] + lf[1][j]) + (lf[2][j] + lf[3][j]);
            float x = tsum;
            if (!dir) {
#pragma unroll
                for (int off = 1; off < 64; off <<= 1) { const float y = __shfl_up(x, off); if (lane >= off) x += y; }
            } else {
#pragma unroll
                for (int off = 1; off < 64; off <<= 1) { const float y = __shfl_down(x, off); if (lane + off < 64) x += y; }
            }
            const float total = __shfl(x, dir ? 0 : 63);
            const float rest = total - x;
            float aft[4];
            if (!dir) { aft[3] = rest; aft[2] = aft[3] + lf[3][j]; aft[1] = aft[2] + lf[2][j]; aft[0] = aft[1] + lf[1][j]; }
            else { aft[0] = rest; aft[1] = aft[0] + lf[0][j]; aft[2] = aft[1] + lf[1][j]; aft[3] = aft[2] + lf[2][j]; }
            LAS bf16* d = (dir ? KbT : KfT) + (8 * kg + j) * SP + 4 * lane;
            u32x2 o; o.x = pk2(kk[0][j] * __expf(aft[0]), kk[1][j] * __expf(aft[1])); o.y = pk2(kk[2][j] * __expf(aft[2]), kk[3][j] * __expf(aft[3]));
            *(LAS u32x2*)d = o;
            if (lane == 0) A.dth[((size_t)(((b * 2 + dir) * 33 + sc) * 4 + h)) * 64 + 8 * kg + j] = __expf(total);
        }
    }
    {
        float v[4][8];
#pragma unroll
        for (int e = 0; e < 4; ++e) cv_unpack(va[e], v[e]);
#pragma unroll
        for (int j = 0; j < 8; ++j) { u32x2 o; o.x = pk2(v[0][j], v[1][j]); o.y = pk2(v[2][j], v[3][j]); *(LAS u32x2*)(VtT + (8 * kg + j) * SP + 4 * lane) = o; }
    }
    __syncthreads();
    const int kt = wave & 3, vt0 = 2 * (wave >> 2);
#pragma unroll
    for (int dir = 0; dir < 2; ++dir) {
        f32x4 S0 = (f32x4){0.f, 0.f, 0.f, 0.f}, S1 = S0;
        const LAS bf16* pa = (dir ? KbT : KfT) + (16 * kt + l15) * SP + 8 * l4;
        const LAS bf16* pb0 = VtT + (16 * vt0 + l15) * SP + 8 * l4; const LAS bf16* pb1 = pb0 + 16 * SP;
#pragma unroll
        for (int kk8 = 0; kk8 < 8; ++kk8) { const bf16x8 af = frag16(pa + 32 * kk8); S0 = MFMA32(af, frag16(pb0 + 32 * kk8), S0); S1 = MFMA32(af, frag16(pb1 + 32 * kk8), S1); }
        float* slot = A.hst + ((size_t)(((b * 2 + dir) * 33 + sc) * 4 + h)) * 4096;
        *(f32x4*)(slot + (size_t)(16 * vt0 + l15) * 64 + 16 * kt + 4 * l4) = S0;
        *(f32x4*)(slot + (size_t)(16 * (vt0 + 1) + l15) * 64 + 16 * kt + 4 * l4) = S1;
    }
}
__device__ __forceinline__ void state_scan(float* sst, const float* dts, float* hst, const float* dth, int gid) {
    if (gid < 65536) {
        const int bd = gid >> 14, e = gid & 16383, h = e >> 11, dir = bd & 1;
        float* base = sst + ((size_t)(bd * 33) * 8 + h) * 8192 + (size_t)(e & 2047) * 4;
        f32x4 carry = *(const f32x4*)(base + (size_t)32 * 8 * 8192);
        float* p = base + (size_t)(dir ? 31 : 0) * 8 * 8192; const long pstep = dir ? -(long)(8 * 8192) : (long)(8 * 8192);
        const float* dp = dts + (bd * 33 + (dir ? 31 : 0)) * 8 + h; const int dstep = dir ? -8 : 8;
#pragma unroll 4
        for (int jj = 0; jj < 32; ++jj) {
            const f32x4 loc = *(const f32x4*)p; *(f32x4*)p = carry;
            carry = carry * (*dp) + loc; p += pstep; dp += dstep; }
    } else if (gid < 65536 + 16384) {
        const int g2 = gid - 65536, bd = g2 >> 12, e = g2 & 4095, h = e >> 10, dir = bd & 1, k0 = (e & 15) * 4;
        float* base = hst + ((size_t)(bd * 33) * 4 + h) * 4096 + (size_t)(e & 1023) * 4;
        f32x4 carry = *(const f32x4*)(base + (size_t)32 * 4 * 4096);
        float* p = base + (size_t)(dir ? 31 : 0) * 4 * 4096; const long pstep = dir ? -(long)(4 * 4096) : (long)(4 * 4096);
        const float* dp = dth + ((size_t)((bd * 33 + (dir ? 31 : 0)) * 4 + h)) * 64 + k0; const int dstep = dir ? -256 : 256;
#pragma unroll 4
        for (int jj = 0; jj < 32; ++jj) {
            const f32x4 loc = *(const f32x4*)p; *(f32x4*)p = carry;
            const f32x4 d = *(const f32x4*)dp;
            carry = carry * d + loc; p += pstep; dp += dstep; }
    }
}

__device__ __forceinline__ void mf_hy_tile(LAS unsigned char* lds, const bf16* hyoT, bf16* mix, int tile, int tid) {
    LAS bf16* T = (LAS bf16*)lds;
    __syncthreads();
    { const int ch = tid >> 1, hf = tid & 1; const u32x4* src = (const u32x4*)(hyoT + (size_t)ch * MROWS + tile * 64 + hf * 32);
#pragma unroll
      for (int j = 0; j < 4; ++j) *(LAS u32x4*)(T + ch * 72 + hf * 32 + 8 * j) = src[j]; }
    __syncthreads();
    { const int tok = tid >> 3, cgp = tid & 7;
      bf16* dst = mix + (size_t)(tile * 64 + tok) * DM + 256 + cgp * 32;
#pragma unroll
      for (int j = 0; j < 4; ++j) { u32x4 o;
          unsigned w[4];
#pragma unroll
          for (int e = 0; e < 4; ++e) { const int c0 = cgp * 32 + 8 * j + 2 * e; w[e] = (unsigned)T[c0 * 72 + tok] | ((unsigned)T[(c0 + 1) * 72 + tok] << 16); }
          o.x = w[0]; o.y = w[1]; o.z = w[2]; o.w = w[3];
          *(u32x4*)(dst + 8 * j) = o; } }
    __syncthreads();
}
__device__ __forceinline__ void mf_ssd_rows(bf16* mix, const float* ssq, const float* ng, int row_first, int nrows, int gw, int ngw, int lane) {
    const f32x4 g0 = *(const f32x4*)(ng + 8 * lane), g1 = *(const f32x4*)(ng + 8 * lane + 4);
    const int grp = lane >> 5;
#pragma unroll 1
    for (int m = row_first + gw; m < row_first + nrows; m += ngw) {
        const f32x4 q = *(const f32x4*)(ssq + (size_t)m * 8 + 4 * grp);
        const float r = 1.0f / sqrtf(((q.x + q.y) + (q.z + q.w)) * (1.0f / 256.0f) + EPS);
        bf16* p = mix + (size_t)m * DM + 512 + 8 * lane;
        const u32x4 v = *(const u32x4*)p; u32x4 o;
        o.x = pk2(bflo(v.x) * r * g0.x, bfhi(v.x) * r * g0.y); o.y = pk2(bflo(v.y) * r * g0.z, bfhi(v.y) * r * g0.w);
        o.z = pk2(bflo(v.z) * r * g1.x, bfhi(v.z) * r * g1.y); o.w = pk2(bflo(v.w) * r * g1.z, bfhi(v.w) * r * g1.w);
        *(u32x4*)p = o;
    }
}
__device__ __forceinline__ void mf_ctx_rows(const bf16* mix, const float* ssq, const float* ng, int row_first, bf16* priv, int wave, int lane) {
    const f32x4 g0 = *(const f32x4*)(ng + 8 * lane), g1 = *(const f32x4*)(ng + 8 * lane + 4);
    const int grp = lane >> 5;
#pragma unroll 2
    for (int i = wave; i < 256; i += NWAVES) {
        const int m = row_first + i;
        const f32x4 q = *(const f32x4*)(ssq + (size_t)m * 8 + 4 * grp);
        const float r = 1.0f / sqrtf(((q.x + q.y) + (q.z + q.w)) * (1.0f / 256.0f) + EPS);
        const u32x4 lo = *(const u32x4*)(mix + (size_t)m * DM + 8 * lane);
        const u32x4 v = *(const u32x4*)(mix + (size_t)m * DM + 512 + 8 * lane); u32x4 o;
        o.x = pk2(bflo(v.x) * r * g0.x, bfhi(v.x) * r * g0.y); o.y = pk2(bflo(v.y) * r * g0.z, bfhi(v.y) * r * g0.w);
        o.z = pk2(bflo(v.z) * r * g1.x, bfhi(v.z) * r * g1.y); o.w = pk2(bflo(v.w) * r * g1.z, bfhi(v.w) * r * g1.w);
        *(u32x4*)(priv + (size_t)i * DM + 8 * lane) = lo;
        *(u32x4*)(priv + (size_t)i * DM + 512 + 8 * lane) = o;
    }
}
#ifndef MK_PER_PHASE
#define MK_PER_PHASE 0
#endif
#ifndef SPLITK_CTX
#define SPLITK_CTX 1
#endif
constexpr int PH_PER_LAYER = 13, NPHASES = 1 + 2 * PH_PER_LAYER + 1;
struct Args { const float* in[34]; float* out; unsigned char* ws; int ph_lo, ph_hi; };

__global__ void __launch_bounds__(NTHR, 2) hybrid_fwd(Args args) {
    extern __shared__ __attribute__((aligned(16))) unsigned char lds_raw[];
    LAS unsigned char* lds = (LAS unsigned char*)lds_raw;
    volatile LAS unsigned* MISC = (volatile LAS unsigned*)(lds + MISC_OFF);
    const int tid0 = threadIdx.x;
    const int G = gridDim.x, bid = blockIdx.x;
    const int ngw = G * NWAVES, ngt = G * NTHR;
    unsigned char* ws = args.ws;
    for (int u = tid0; u < 32; u += NTHR) MISC[u] = 0u;
    __syncthreads();
    XcdBarrier bar; bar.bar = (unsigned*)(ws + WS_CTL) + CW_BAR; bar.x = 0; bar.st = nullptr;
    if (!MK_PER_PHASE) bar = xcd_barrier_post((unsigned*)(ws + WS_CTL) + CW_BAR, MISC + 8);
    const int lo = args.ph_lo, hi = args.ph_hi;
#ifndef PHMASK
#define PHMASK 0xFFFF
#endif
#define ENA(b) (((PHMASK) >> (b)) & 1)
#ifndef SUBMASK
#define SUBMASK 0xFF
#endif
#define SUB(b) (((SUBMASK) >> (b)) & 1)
#define IN(k) (lo <= (k) && (k) < hi)
#ifndef TIME_MASK
#define TIME_MASK 0u
#endif
#ifndef TIME_MULT
#define TIME_MULT 8
#endif
#ifndef TIME_KIND
#define TIME_KIND 0
#endif
    unsigned long long tsum = 0ull, tbeg = 0ull;
#define SEAM(k) do { if (IN(k) && IN((k) + 1)) xcd_barrier(bar); if (TIME_MASK) { const unsigned long long tnow = __builtin_amdgcn_s_memrealtime(); if ((TIME_MASK >> (k)) & 1u) tsum += tnow - tbeg; tbeg = tnow; } } while (0)
#define NEXT_ITEM(qidx) ({ __syncthreads(); if (tid0 == 0) MISC[16] = __hip_atomic_fetch_add((unsigned*)(ws + WS_CTL) + 8192 + 64 * (qidx), 1u, __ATOMIC_RELAXED, __HIP_MEMORY_SCOPE_AGENT); __syncthreads(); (int)MISC[16]; })
#define FRESH_IDS() int tid_ = tid0; asm volatile("" : "+v"(tid_)); const int tid = tid_, lane = tid & 63, wave = __builtin_amdgcn_readfirstlane(tid >> 6); const int gw = bid * NWAVES + wave, gtid = bid * NTHR + tid; LAS float* wscr = (LAS float*)(lds + wave * 16384); (void)lane; (void)gw; (void)gtid; (void)wscr

    const float* x_in = args.in[0]; const float* c_in = args.in[1]; const float* ctx_in = args.in[2]; const float* cctx_in = args.in[3];
    const float* w_ada = args.in[4]; const float* b_ada = args.in[5]; const float* norm1_g = args.in[6]; const float* norm2_g = args.in[7];
    const float* w_in = args.in[8]; const float* w_out = args.in[9]; const float* hg_lb = args.in[10]; const float* hg_norm_g = args.in[11];
    const float* hy_conv_w = args.in[12]; const float* hy_conv_b = args.in[13]; const float* hy_w1 = args.in[14]; const float* hy_b1 = args.in[15]; const float* hy_f1 = args.in[16];
    const float* hy_w2 = args.in[17]; const float* hy_b2 = args.in[18]; const float* hy_f2 = args.in[19]; const float* hy_w3 = args.in[20]; const float* hy_bias = args.in[21];
    const float* ssd_conv_w = args.in[22]; const float* ssd_conv_b = args.in[23]; const float* ssd_dt_bias = args.in[24]; const float* ssd_a_log = args.in[25]; const float* ssd_d = args.in[26];
    const float* ssd_norm_g = args.in[27]; const float* ffn_w_gate = args.in[28]; const float* ffn_w_up = args.in[29]; const float* ffn_conv_w = args.in[30]; const float* ffn_conv_b = args.in[31];
    const float* ffn_w_down = args.in[32]; const float* final_norm_g = args.in[33];
    float* xs_out = args.out;
    float* mods = (float*)(ws + WS_MODS); float* ctxs = (float*)(ws + WS_CTXS); bf16* h2b = (bf16*)(ws + WS_H2); float* h2c = (float*)(ws + WS_H2C);
    float* ssq = (float*)(ws + WS_SSQ); float* dts = (float*)(ws + WS_DTS); float* dth = (float*)(ws + WS_DTH); float* udt = (float*)(ws + WS_UDT);
    bf16* Win = (bf16*)(ws + WS_WIN); bf16* Wout = (bf16*)(ws + WS_WOUT); bf16* hn = (bf16*)(ws + WS_HN); unsigned* Hs = (unsigned*)(ws + WS_HN);
    bf16* uhg = (bf16*)(ws + WS_UHG); bf16* uhyT = (bf16*)(ws + WS_UHY); bf16* uz = (bf16*)(ws + WS_UZ); bf16* uxs = (bf16*)(ws + WS_UXS); bf16* ubc = (bf16*)(ws + WS_UBC); bf16* axt = (bf16*)(ws + WS_AXT); bf16* abc = (bf16*)(ws + WS_ABC); bf16* abt = (bf16*)(ws + WS_ABT); float* sst = (float*)(ws + WS_SST); float* hst = (float*)(ws + WS_HST);
    float* slabO = (float*)(ws + WS_UHG); float* slabF = (float*)(ws + WS_A);
    bf16* mix = (bf16*)(ws + WS_MIX); bf16* fa = (bf16*)(ws + WS_A); bf16* fup = (bf16*)(ws + WS_UP); bf16* Wgu = (bf16*)(ws + WS_WGU); bf16* Wd = (bf16*)(ws + WS_WD);

    if (TIME_MASK) tbeg = __builtin_amdgcn_s_memrealtime();
    if (ENA(14) && IN(0)) {
        FRESH_IDS();
#pragma unroll 1
        for (int it = bid; it < 192; it += G) if (SUB(4)) p0_mods_item(c_in, cctx_in, w_ada, b_ada, mods, (LAS float*)lds, it, tid, wave, lane);
#pragma unroll 1
        for (int v = 0; v < 3; ++v) {
            const int hl = v == 1 ? 1 : 0;
            if (SUB(6)) p0_h2_rows(hy_w1 + hl * 33 * 64, hy_b1 + hl * 64, hy_f1 + hl * 64, hy_w2 + hl * 64 * 64, hy_b2 + hl * 64, hy_f2 + hl * 64, h2c, v == 2 ? (bf16*)nullptr : h2b + (size_t)hl * LX * 64, v == 2 ? LC : LX, gw, ngw, lane);
        }
        __syncthreads();
        if (SUB(7)) { convert_weight(w_in, 1024, NINP, 3600, Win, wscr, gw, ngw, lane);
        convert_weight(w_out, 1024, 1024, 1024, Wout, wscr, gw, ngw, lane); }
    }
    SEAM(0);

    for (int l = 0; l < 2; ++l) {
        const int P = 1 + l * PH_PER_LAYER;
        const float* mods_l = mods + (size_t)l * 3 * 6144;
        const int nrows = l == 0 ? MROWS : MXR;
        if (ENA(0) && IN(P + 0)) {
            FRESH_IDS();
            if (l == 1) { __syncthreads();
                convert_weight(w_in + (size_t)1024 * 3600, 1024, NINP, 3600, Win, wscr, gw, ngw, lane);
                convert_weight(w_out + (size_t)1024 * 1024, 1024, 1024, 1024, Wout, wscr, gw, ngw, lane); }
            if (SPLITK_CTX && l == 1) norm_rows(xs_out, ctxs, MROWS, norm1_g + l * DM, mods_l, 0, 1, hn, gw, ngw, lane, slabF, 11, mods + 2 * 6144 + 5 * 1024, ctxs);
            else norm_rows(l == 0 ? x_in : xs_out, l == 0 ? ctx_in : ctxs, MROWS, norm1_g + l * DM, mods_l, 0, 1, hn, gw, ngw, lane);
        }
        SEAM(P + 0);
        if (ENA(1) && IN(P + 1)) {
            FRESH_IDS();
            pg8::Gemm g{hn, Win, MROWS, NINP, DM, DM}; pg8::StaticOrder S; S.init(MROWS, NINP, G, bid);
            pg8::EpiInProj E{uhg, uhyT, uz, (long)((WS_UXS - WS_UZ) / 2), (long)((WS_UBC - WS_UZ) / 2), udt, MROWS};
            pg8::gemm_phase<pg8::EpiInProj, pg8::StaticOrder, true, true>(lds, g, S, E, tid);
        }
        SEAM(P + 1);
        SsdArgs SA{axt, abc, abt, uz, udt, ssd_dt_bias + l * 16, ssd_a_log + l * 16, ssd_d + l * 8, sst, dts, mix, ssq};
        HgArgs HA{uhg, hg_lb, hg_lb + 256, hg_norm_g + l * 256, l, hst, dth, mix};
        const float* hcw = hy_conv_w + (size_t)l * 3 * 768; const float* hcb = hy_conv_b + l * 768; const float* hbias = hy_bias + l * 512; const float* w3l = hy_w3 + (size_t)l * 64 * 1024;
        if (ENA(2) && IN(P + 2)) {
            FRESH_IDS();
            ssd_prepass(uxs, ubc, ssd_conv_w + (size_t)l * 3 * 1024, ssd_conv_b + l * 1024, axt, abc, abt, gw, ngw, lane);
        }
        SEAM(P + 2);
        if (ENA(3) && IN(P + 3)) {
            FRESH_IDS();
            const int n_spec = 256, n_hg = 2 * 33 * 4, n_hyc = l == 0 ? 256 : 0, n_ssd = 2 * 33 * 8, total = n_spec + n_hg + n_hyc + n_ssd;
#pragma unroll 1
            for (;;) {
                const int id = NEXT_ITEM(P + 3);
                if (id >= total) break;
                FRESH_IDS();
                if (id < n_spec) { if (SUB(0)) hy_spectrum_item(lds, h2b + (size_t)l * LX * 64, w3l, hbias, Hs, id, tid, wave, lane); }
                else if (id < n_spec + n_hg) { if (SUB(2)) { int r = id - n_spec; const int h = r & 3; r >>= 2; hg_state_item(lds, HA, r / 33, r % 33, h, tid, wave, lane); } }
                else if (id < n_spec + n_hg + n_hyc) { if (SUB(3)) hy_ctx_item(lds, uhyT, hcw, hcb, hbias, h2c, w3l, mix, id - n_spec - n_hg, tid, wave, lane); }
                else if (SUB(1)) { int r = id - n_spec - n_hg - n_hyc; const int h = r & 7; r >>= 3; ssd_state_item(lds, SA, r / 33, r % 33, h, tid, wave, lane); }
            }
        }
        SEAM(P + 3);
        if (ENA(4) && IN(P + 4)) {
            FRESH_IDS();
            state_scan(sst, dts, hst, dth, gtid);
            #pragma unroll 1
            for (int id = bid; id < 256; id += G) { FRESH_IDS(); hy_fft_item(lds, uhyT, hcw, hcb, Hs, uhyT, id, tid); }
        }
        SEAM(P + 4);
        const int nsc = l == 0 ? 33 : 32;
        if (ENA(5) && IN(P + 5)) {
            FRESH_IDS();
            const int n_ssd = 2 * nsc * 4, n_hg = 2 * nsc * 2;
#pragma unroll 1
            for (;;) {
                const int id = NEXT_ITEM(P + 5);
                if (id >= n_ssd + n_hg) break;
                FRESH_IDS();
                unsigned long long tk0 = 0ull; const int kind_ = id >= n_hg ? 6 : 5; if (TIME_KIND && l == 0 && kind_ == TIME_KIND) tk0 = __builtin_amdgcn_s_memrealtime();
                if (id >= n_hg) { if (SUB(1)) { int r = id - n_hg; const int hp = r & 3; r >>= 2; ssd_item<1>(lds, SA, r / nsc, r % nsc, hp, 0, tid, wave, lane); } }
                else if (SUB(2)) { int r = id; const int hp = r & 1; r >>= 1; hg_item<1>(lds, HA, r / nsc, r % nsc, hp, 0, tid, lane); }
                if (TIME_KIND && l == 0 && kind_ == TIME_KIND) tsum += __builtin_amdgcn_s_memrealtime() - tk0;
            }
        }
        SEAM(P + 5);
        if (ENA(6) && IN(P + 6)) {
            FRESH_IDS();
            const int n_ssd = 2 * nsc * 4, n_hg = 2 * nsc * 2;
#pragma unroll 1
            for (;;) {
                const int id = NEXT_ITEM(P + 6);
                if (id >= n_ssd + n_hg + 256) break;
                FRESH_IDS();
                if (id >= n_ssd + n_hg) mf_hy_tile(lds, uhyT, mix, id - n_ssd - n_hg, tid);
                else if (id >= n_hg) { if (SUB(1)) { int r = id - n_hg; const int hp = r & 3; r >>= 2; ssd_item<2>(lds, SA, r / nsc, r % nsc, hp, 1, tid, wave, lane); } }
                else if (SUB(2)) { int r = id; const int hp = r & 1; r >>= 1; hg_item<2>(lds, HA, r / nsc, r % nsc, hp, 1, tid, lane); }
            }
        }
        SEAM(P + 6);
#ifndef CTX_ASIDE
#define CTX_ASIDE 0
#endif
        const bool ctx_cu = CTX_ASIDE && (l == 0) && bid < 8;
        const int xb = (CTX_ASIDE && l == 0) ? bid - 8 : bid, xG = (CTX_ASIDE && l == 0) ? G - 8 : G;
        const int nrows3 = (CTX_ASIDE || SPLITK_CTX) ? MXR : nrows;
        const int nrows2 = CTX_ASIDE ? MXR : nrows;
        if (ENA(7) && IN(P + 7)) {
            FRESH_IDS();
            if (ctx_cu) {
                bf16* priv = hn + (size_t)bid * 256 * DM;
                mf_ctx_rows(mix, ssq, ssd_norm_g + l * 512, MXR + 256 * (bid >> 2), priv, wave, lane);
                asm volatile("s_waitcnt vmcnt(0)" ::: "memory"); __syncthreads();
                if (tid == 0) { __builtin_amdgcn_fence(__ATOMIC_ACQUIRE, "agent"); asm volatile("s_waitcnt vmcnt(0)" ::: "memory"); }
                __syncthreads();
                pg8::Gemm g{priv - (size_t)(64 + (bid >> 2)) * 256 * DM, Wout, MROWS, DM, DM, DM}; pg8::CtxOrder S{bid};
                pg8::EpiResid E{x_in, xs_out, ctxs, ctx_in, mods_l + 2 * 1024, 6144, mods_l + 2 * 6144 + 2 * 1024};
                pg8::gemm_phase<pg8::EpiResid, pg8::CtxOrder, false, true>(lds, g, S, E, tid);
            } else {
                mf_ssd_rows(mix, ssq, ssd_norm_g + l * 512, 0, nrows2, xb * NWAVES + wave, xG * NWAVES, lane);
            }
        }
        SEAM(P + 7);
        if (ENA(8) && IN(P + 8)) {
            FRESH_IDS();
            pg8::Gemm g{mix, Wout, nrows3, DM, DM, DM}; pg8::StaticOrder S; S.init(nrows3, DM, G, bid);
            pg8::EpiResid E{l == 0 ? x_in : xs_out, xs_out, ctxs, l == 0 ? ctx_in : ctxs, mods_l + 2 * 1024, 6144, mods_l + 2 * 6144 + 2 * 1024};
            pg8::gemm_phase<pg8::EpiResid, pg8::StaticOrder, true, true>(lds, g, S, E, tid);
            if (SPLITK_CTX && l == 0) {
                pg8::Gemm g2{mix, Wout, MROWS, DM, 128, DM}; pg8::SplitOrder S2{bid, 8, 128}; pg8::EpiSlab E2{slabO, 8};
                pg8::gemm_phase<pg8::EpiSlab, pg8::SplitOrder, false, true>(lds, g2, S2, E2, tid);
            }
        }
        SEAM(P + 8);
        if (ENA(9) && IN(P + 9)) {
            FRESH_IDS();
            __syncthreads();
            convert_weight(ffn_w_gate + (size_t)l * 1024 * DFF, 1024, DFF, DFF, Wgu, wscr, gw, ngw, lane);
            convert_weight(ffn_w_up + (size_t)l * 1024 * DFF, 1024, DFF, DFF, Wgu + (size_t)DFF * 1024, wscr, gw, ngw, lane);
            convert_weight(ffn_w_down + (size_t)l * DFF * 1024, DFF, 1024, 1024, Wd, wscr, gw, ngw, lane);
            if (SPLITK_CTX && l == 0) norm_rows(xs_out, ctx_in, nrows, norm2_g + l * DM, mods_l, 3, 4, hn, gw, ngw, lane, slabO, 8, mods_l + 2 * 6144 + 2 * 1024, ctxs);
            else norm_rows(xs_out, ctxs, nrows, norm2_g + l * DM, mods_l, 3, 4, hn, gw, ngw, lane);
        }
        SEAM(P + 9);
        if (ENA(10) && IN(P + 10)) {
            FRESH_IDS();
            pg8::Gemm g{hn, Wgu, nrows, 2 * DFF, DM, DM}; pg8::StaticOrder S; S.init(nrows, 2 * DFF, G, bid);
            pg8::EpiGateUp E{fa, fup};
            pg8::gemm_phase<pg8::EpiGateUp, pg8::StaticOrder, true, true>(lds, g, S, E, tid);
        }
        SEAM(P + 10);
        if (ENA(11) && IN(P + 11)) {
            FRESH_IDS();
            if (ctx_cu) {
                bf16* priv = hn + (size_t)bid * 256 * DFF;
                ffn_conv_phase(fa, fup, ffn_conv_w + (size_t)l * 9 * DFF, ffn_conv_b + l * DFF, MXR + 256 * (bid >> 2), 256, tid, NTHR, priv, -(long)(MXR + 256 * (bid >> 2)));
                asm volatile("s_waitcnt vmcnt(0)" ::: "memory"); __syncthreads();
                if (tid == 0) { __builtin_amdgcn_fence(__ATOMIC_ACQUIRE, "agent"); asm volatile("s_waitcnt vmcnt(0)" ::: "memory"); }
                __syncthreads();
                pg8::Gemm g{priv - (size_t)(64 + (bid >> 2)) * 256 * DFF, Wd, MROWS, DM, DFF, DFF}; pg8::CtxOrder S{bid};
                pg8::EpiResid E{xs_out, xs_out, ctxs, ctxs, mods_l + 5 * 1024, 6144, mods_l + 2 * 6144 + 5 * 1024};
                pg8::gemm_phase<pg8::EpiResid, pg8::CtxOrder, false, true>(lds, g, S, E, tid);
            } else ffn_conv_phase(fa, fup, ffn_conv_w + (size_t)l * 9 * DFF, ffn_conv_b + l * DFF, 0, nrows2, xb * NTHR + tid, xG * NTHR, fup, 0);
        }
        SEAM(P + 11);
        if (ENA(12) && IN(P + 12)) {
            FRESH_IDS();
            pg8::Gemm g{fup, Wd, nrows3, DM, DFF, DFF}; pg8::StaticOrder S; S.init(nrows3, DM, G, bid);
            pg8::EpiResid E{xs_out, xs_out, ctxs, ctxs, mods_l + 5 * 1024, 6144, mods_l + 2 * 6144 + 5 * 1024};
            pg8::gemm_phase<pg8::EpiResid, pg8::StaticOrder, true, true>(lds, g, S, E, tid);
            if (SPLITK_CTX && l == 0) {
                pg8::Gemm g2{fup, Wd, MROWS, DM, 256, DFF}; pg8::SplitOrder S2{bid, 11, 256}; pg8::EpiSlab E2{slabF, 11};
                pg8::gemm_phase<pg8::EpiSlab, pg8::SplitOrder, false, true>(lds, g2, S2, E2, tid);
            }
        }
        SEAM(P + 12);
    }
    if (ENA(15) && IN(NPHASES - 1)) { FRESH_IDS(); final_norm_rows(xs_out, final_norm_g, gw, ngw, lane); }
    if (TIME_MASK || TIME_KIND) { const unsigned long long tnow = __builtin_amdgcn_s_memrealtime(); if ((TIME_MASK >> (NPHASES - 1)) & 1u) tsum += tnow - tbeg;
        if (bid == 0 && tid0 == 0) { while (__builtin_amdgcn_s_memrealtime() - tnow < (unsigned long long)TIME_MULT * tsum) __builtin_amdgcn_s_sleep(32); } }
#undef IN
#undef SEAM
}

extern "C" void kernel_launch(void* const* d_in, const int* in_sizes, int n_in, void* d_out, int out_size, void* d_ws, size_t ws_size, hipStream_t stream) {
    static int grid = 0;
    if (grid == 0) {
        if (n_in != 34 || out_size != MXR * DM || ws_size < WS_END) { fprintf(stderr, "kernel_launch: unexpected shapes (n_in %d out %d ws %zu)\n", n_in, out_size, ws_size); grid = -1; return; }
        int dev = 0, cus = 0, per_cu = 0;
        if (hipGetDevice(&dev) != hipSuccess || hipDeviceGetAttribute(&cus, hipDeviceAttributeMultiprocessorCount, dev) != hipSuccess) { grid = -1; return; }
        if (hipFuncSetAttribute((const void*)hybrid_fwd, hipFuncAttributeMaxDynamicSharedMemorySize, LDS_BYTES) != hipSuccess) { fprintf(stderr, "kernel_launch: hipFuncSetAttribute failed\n"); grid = -1; return; }
        if (hipOccupancyMaxActiveBlocksPerMultiprocessor(&per_cu, (const void*)hybrid_fwd, NTHR, LDS_BYTES) != hipSuccess || per_cu < 1)
            fprintf(stderr, "kernel_launch: note: occupancy query reports %d workgroups per CU\n", per_cu);
        (void)hipGetLastError();
        grid = cus;
    }
    if (grid < 0) return;
    if (hipMemsetAsync((char*)d_ws + WS_CTL, 0, CTL_ZERO_BYTES, stream) != hipSuccess) { fprintf(stderr, "kernel_launch: memset failed\n"); return; }
    Args a{};
    for (int i = 0; i < 34; ++i) a.in[i] = (const float*)d_in[i];
    a.out = (float*)d_out; a.ws = (unsigned char*)d_ws;
#if MK_PER_PHASE
    for (int p = 0; p < NPHASES; ++p) { a.ph_lo = p; a.ph_hi = p + 1; hipLaunchKernelGGL(hybrid_fwd, dim3(grid), dim3(NTHR), LDS_BYTES, stream, a); }
#else
    a.ph_lo = 0; a.ph_hi = NPHASES;
    hipLaunchKernelGGL(hybrid_fwd, dim3(grid), dim3(NTHR), LDS_BYTES, stream, a);
#endif
    const hipError_t le = hipPeekAtLastError();
    if (le != hipSuccess) fprintf(stderr, "kernel_launch: launch failed: %s\n", hipGetErrorName(le));
}
```

```cpp
#include <hip/hip_runtime.h>
#include <cstdio>
#include <cstdint>
namespace pg8 {
#define PG8_LAS __attribute__((address_space(3)))
typedef unsigned short bf16_t;
typedef short bf16x8 __attribute__((ext_vector_type(8)));
typedef float f32x4 __attribute__((ext_vector_type(4)));
typedef unsigned u32x4 __attribute__((ext_vector_type(4)));
constexpr int BM = 256, BK = 64, HALF = 128, HTB = HALF * BK * 2  , STAGE_BYTES = 8 * HTB, NXCD = 8, WGM = 8;

__host__ __device__ __forceinline__ int lds_byte(int r, int c) { const int st = (r >> 4) * 2 + (c >> 5), rr = r & 15, cc = c & 31, ob = rr * 64 + cc * 2; return st * 1024 + (ob ^ (((ob >> 9) & 1) << 5)); }
__host__ __device__ __forceinline__ void stage_rc(int b, int& R, int& C) { const int st = b / 1024, sb = b % 1024, swz = sb ^ (((sb >> 9) & 1) << 5); R = (st >> 1) * 16 + swz / 64; C = (st & 1) * 32 + (swz % 64) / 2; }
__host__ __device__ __forceinline__ int perm32(int rho) { const int n = rho >> 4, i = rho & 15; return 8 * (i >> 2) + 4 * n + (i & 3); }

struct Unit { int pm, pn, koff, ks; };
struct Gemm { const bf16_t* A; const bf16_t* Bt; int M, N, K, ld; };

struct StaticOrder {
    int nM, nN, nwg, G, c;
    __host__ __device__ void init(int M, int N, int G_, int c_) { nM = M / BM; nN = N / BM; nwg = nM * nN; G = G_; c = c_; }
    __host__ __device__ bool next(int i, Unit& u) const {
        const long L = (long)i * G + c; if (L >= nwg) return false;
        int wgid = (int)L; { const int q = nwg / NXCD, r = nwg % NXCD, xcd = wgid % NXCD, off = wgid / NXCD; wgid = (xcd < r ? xcd * (q + 1) : r * (q + 1) + (xcd - r) * q) + off; }
        const int nig = WGM * nN, gid = wgid / nig, fm = gid * WGM, gsz = (nM - fm) < WGM ? (nM - fm) : WGM;
        u.pm = fm + ((wgid % nig) % gsz); u.pn = (wgid % nig) / gsz; u.koff = 0; u.ks = 0; return true;
    }
    __device__ __forceinline__ void a_ready(const Unit&) const {}
    __device__ __forceinline__ void done(const Unit&) const {}
};

__device__ __forceinline__ unsigned cvt_pk_bf16(float lo, float hi) { unsigned r; asm volatile("v_cvt_pk_bf16_f32 %0, %1, %2" : "=v"(r) : "v"(lo), "v"(hi)); return r; }
typedef float f32x2 __attribute__((ext_vector_type(2)));

struct EpiInProj {
    static constexpr bool PERM = true, AFTER_DRAIN = false;
    bf16_t* uhg; bf16_t* uhyT; bf16_t* uz; long off_xs, off_bc; float* udt; int mrows;
    __device__ __forceinline__ void operator()(const f32x4 (&acc)[2][2][4][2], const Unit& u, int wr, int wc, int fr, int fq) const {
        const int row0 = u.pm * BM + wr * 64 + fr;
        const int colt = u.pn * BM + wc * 32 + 8 * fq;
#pragma unroll
        for (int ai = 0; ai < 2; ++ai)
#pragma unroll
            for (int m = 0; m < 4; ++m) {
                const int r = row0 + ai * HALF + m * 16;
#pragma unroll
                for (int bj = 0; bj < 2; ++bj) {
                    const f32x4 v0 = acc[ai][bj][m][0], v1 = acc[ai][bj][m][1];
                    const int c = colt + bj * HALF;
                    if (u.pn < 5) {
                        u32x4 w; w.x = cvt_pk_bf16(v0[0], v0[1]); w.y = cvt_pk_bf16(v0[2], v0[3]); w.z = cvt_pk_bf16(v1[0], v1[1]); w.w = cvt_pk_bf16(v1[2], v1[3]);
                        *(u32x4*)(uhg + (size_t)r * 1280 + c) = w;
                    } else if (u.pn < 8) {
                        const int cc = c - 1280;
                        const unsigned w0 = cvt_pk_bf16(v0[0], v0[1]), w1 = cvt_pk_bf16(v0[2], v0[3]), w2 = cvt_pk_bf16(v1[0], v1[1]), w3 = cvt_pk_bf16(v1[2], v1[3]);
                        bf16_t* d = uhyT + (size_t)cc * mrows + r;
                        d[0] = (bf16_t)(w0 & 0xffffu); d[(size_t)mrows] = (bf16_t)(w0 >> 16); d[(size_t)2 * mrows] = (bf16_t)(w1 & 0xffffu); d[(size_t)3 * mrows] = (bf16_t)(w1 >> 16);
                        d[(size_t)4 * mrows] = (bf16_t)(w2 & 0xffffu); d[(size_t)5 * mrows] = (bf16_t)(w2 >> 16); d[(size_t)6 * mrows] = (bf16_t)(w3 & 0xffffu); d[(size_t)7 * mrows] = (bf16_t)(w3 >> 16);
                    } else {
                        const int cc = c - 2048;
                        if (cc < 1536) {
                            u32x4 w; w.x = cvt_pk_bf16(v0[0], v0[1]); w.y = cvt_pk_bf16(v0[2], v0[3]); w.z = cvt_pk_bf16(v1[0], v1[1]); w.w = cvt_pk_bf16(v1[2], v1[3]);
                            bf16_t* dst = uz + (u.pn >= 10 ? off_xs : 0) + (u.pn >= 12 ? off_bc - off_xs : 0);
                            *(u32x4*)(dst + (size_t)r * 512 + (cc & 511)) = w;
                        } else if (cc < 1552) {
                            float* d = udt + (size_t)r * 16 + (cc - 1536);
                            *(f32x4*)d = v0; *(f32x4*)(d + 4) = v1;
                        }
                    }
                }
            }
    }
};
struct EpiGateUp {
    static constexpr bool PERM = true, AFTER_DRAIN = false;
    bf16_t* a; bf16_t* up;
    __device__ __forceinline__ void operator()(const f32x4 (&acc)[2][2][4][2], const Unit& u, int wr, int wc, int fr, int fq) const {
        const int row0 = u.pm * BM + wr * 64 + fr;
        int colt = u.pn * BM; bf16_t* base = a; if (u.pn >= 11) { base = up; colt -= 2816; }
        colt += wc * 32 + 8 * fq;
#pragma unroll
        for (int ai = 0; ai < 2; ++ai)
#pragma unroll
            for (int m = 0; m < 4; ++m) { bf16_t* rowp = base + (size_t)(row0 + ai * HALF + m * 16) * 2816 + colt;
#pragma unroll
                for (int bj = 0; bj < 2; ++bj) { const f32x4 v0 = acc[ai][bj][m][0], v1 = acc[ai][bj][m][1];
                    u32x4 w; w.x = cvt_pk_bf16(v0[0], v0[1]); w.y = cvt_pk_bf16(v0[2], v0[3]); w.z = cvt_pk_bf16(v1[0], v1[1]); w.w = cvt_pk_bf16(v1[2], v1[3]);
                    *(u32x4*)(rowp + bj * HALF) = w; } }
    }
};
struct EpiResid {
    static constexpr bool PERM = false, AFTER_DRAIN = false;
    const float* xbase; float* xout; float* cstream; const float* cbase; const float* gate_x; int gate_bstride; const float* gate_c;
    __device__ __forceinline__ void operator()(const f32x4 (&acc)[2][2][4][2], const Unit& u, int wr, int wc, int fr, int fq) const {
        const int row0 = u.pm * BM + wr * 64 + fr;
        const int col0 = u.pn * BM + wc * 32 + 4 * fq;
        const bool isctx = u.pm >= 64;
#pragma unroll
        for (int bj = 0; bj < 2; ++bj)
#pragma unroll
            for (int n = 0; n < 2; ++n) {
                const int c = col0 + bj * HALF + n * 16;
#pragma unroll
                for (int ai = 0; ai < 2; ++ai)
#pragma unroll
                    for (int m = 0; m < 4; ++m) {
                        const int r = row0 + ai * HALF + m * 16;
                        if (!isctx) {
                            const f32x4 g = *(const f32x4*)(gate_x + (size_t)(r >> 13) * gate_bstride + c);
                            const f32x4 b = *(const f32x4*)(xbase + (size_t)r * 1024 + c);
                            *(f32x4*)(xout + (size_t)r * 1024 + c) = b + g * acc[ai][bj][m][n];
                        } else {
                            const f32x4 g = *(const f32x4*)(gate_c + c);
                            const f32x4 b = *(const f32x4*)(cbase + (size_t)(r - 16384) * 1024 + c);
                            *(f32x4*)(cstream + (size_t)(r - 16384) * 1024 + c) = b + g * acc[ai][bj][m][n];
                        }
                    }
            }
    }
};
struct CtxOrder {
    int c;
    __host__ __device__ bool next(int i, Unit& u) const { if (i != 0 || c >= 8) return false; u.pm = 64 + (c >> 2); u.pn = c & 3; u.koff = 0; u.ks = 0; return true; }
    __device__ __forceinline__ void a_ready(const Unit&) const {}
    __device__ __forceinline__ void done(const Unit&) const {}
};
struct SplitOrder {
    int c, nsplit, kc;
    __host__ __device__ bool next(int i, Unit& u) const { if (i != 0 || c >= 8 * nsplit) return false; const int t = c / nsplit; u.pm = 64 + (t >> 2); u.pn = t & 3; u.ks = c % nsplit; u.koff = u.ks * kc * 2; return true; }
    __device__ __forceinline__ void a_ready(const Unit&) const {}
    __device__ __forceinline__ void done(const Unit&) const {}
};
struct EpiSlab {
    static constexpr bool PERM = false, AFTER_DRAIN = false;
    float* slab; int nsplit;
    __device__ __forceinline__ void operator()(const f32x4 (&acc)[2][2][4][2], const Unit& u, int wr, int wc, int fr, int fq) const {
        float* base = slab + (size_t)((((u.pm - 64) * 4 + u.pn) * nsplit + u.ks)) * 65536;
        const int row0 = wr * 64 + fr, col0 = wc * 32 + 4 * fq;
#pragma unroll
        for (int bj = 0; bj < 2; ++bj)
#pragma unroll
            for (int n = 0; n < 2; ++n)
#pragma unroll
                for (int ai = 0; ai < 2; ++ai)
#pragma unroll
                    for (int m = 0; m < 4; ++m) *(f32x4*)(base + (size_t)(row0 + ai * HALF + m * 16) * 256 + col0 + bj * HALF + n * 16) = acc[ai][bj][m][n];
    }
};
template <class Epi, class Sched, bool ALIGN_EPI = false, bool SP2 = false>
__device__ __forceinline__ void gemm_phase(PG8_LAS unsigned char* lds, const Gemm g, const Sched& S, const Epi& E, const int tid) {
    const int wid = __builtin_amdgcn_readfirstlane(tid >> 6), lane = tid & 63, wr = wid >> 2, wc = wid & 3, fr = lane & 15, fq = lane >> 4;
    const int K = g.K, nt = K / BK, ld = g.ld;
    unsigned voffA[2], voffB[2];
#pragma unroll
    for (int i = 0; i < 2; ++i) { int R, C; stage_rc(tid * 16 + i * 8192, R, C); const int Rb = Epi::PERM ? ((R & ~31) + perm32(R & 31)) : R;
        voffA[i] = (unsigned)(R * ld + C) * 2u; voffB[i] = (unsigned)(Rb * ld + C) * 2u; }
    const size_t kstep = (size_t)(BK * 2);
    const size_t hstep = (size_t)HALF * ld * 2;
    const size_t tstep = 2 * hstep;
    const unsigned ldsw = (unsigned)wid * 1024u;
    const int aoff = lds_byte(wr * 64 + fr, fq * 8), boff = lds_byte(wc * 32 + fr, fq * 8);
#define PG8_SA(b, h) (((b) * 2 + (h)) * HTB)
#define PG8_SB(b, h) ((4 + (b) * 2 + (h)) * HTB)
#define PG8_STAGE(bufoff, gbase, voff) do { _Pragma("unroll") for (int _i = 0; _i < 2; ++_i) \
        __builtin_amdgcn_global_load_lds((const unsigned*)((const char*)(gbase) + (voff)[_i]), (PG8_LAS unsigned*)(lds + (bufoff) + ldsw + _i * 8192), 16, 0, 0); } while (0)
#define PG8_LDA(dst, b, h) do { _Pragma("unroll") for (int m = 0; m < 4; ++m) _Pragma("unroll") for (int k = 0; k < 2; ++k) dst[m][k] = *(const PG8_LAS bf16x8*)(lds + PG8_SA(b, h) + aoff + m * 2048 + k * 1024); } while (0)
#define PG8_LDB(dst, b, h) do { _Pragma("unroll") for (int n = 0; n < 2; ++n) _Pragma("unroll") for (int k = 0; k < 2; ++k) dst[n][k] = *(const PG8_LAS bf16x8*)(lds + PG8_SB(b, h) + boff + n * 2048 + k * 1024); } while (0)
#define PG8_MMA(ai, bj, At, Bt) do { __builtin_amdgcn_s_setprio(1); _Pragma("unroll") for (int m = 0; m < 4; ++m) _Pragma("unroll") for (int n = 0; n < 2; ++n) _Pragma("unroll") for (int k = 0; k < 2; ++k) \
        acc[ai][bj][m][n] = __builtin_amdgcn_mfma_f32_16x16x32_bf16(Bt[n][k], At[m][k], acc[ai][bj][m][n], 0, 0, 0); __builtin_amdgcn_s_setprio(0); } while (0)
#define PG8_WAIT_V(n) asm volatile("s_waitcnt vmcnt(" #n ")" ::: "memory")
#define PG8_WAIT_L(n) asm volatile("s_waitcnt lgkmcnt(" #n ")" ::: "memory")
#define PG8_BAR __builtin_amdgcn_s_barrier()
#define PG8_SCHED __builtin_amdgcn_sched_barrier(0)
    Unit cur, nxt; int ui = 0;
    if (!S.next(0, cur)) return;
    f32x4 acc[2][2][4][2];
#pragma unroll
    for (int a = 0; a < 2; ++a)
#pragma unroll
        for (int b = 0; b < 2; ++b)
#pragma unroll
            for (int m = 0; m < 4; ++m)
#pragma unroll
                for (int n = 0; n < 2; ++n) acc[a][b][m][n] = (f32x4){0.f, 0.f, 0.f, 0.f};
    bf16x8 At[4][2], B0[2][2], B1[2][2];
    const char* cA = (const char*)g.A + (size_t)cur.pm * tstep + cur.koff; const char* cB = (const char*)g.Bt + (size_t)cur.pn * tstep + cur.koff;
    S.a_ready(cur);
    if constexpr (SP2) {
        PG8_STAGE(PG8_SB(0, 0), cB, voffB); PG8_STAGE(PG8_SB(0, 1), cB + hstep, voffB); PG8_STAGE(PG8_SA(0, 0), cA, voffA); PG8_STAGE(PG8_SA(0, 1), cA + hstep, voffA);
        if (wr == 1) PG8_BAR;
        PG8_WAIT_V(2); PG8_BAR;
        PG8_STAGE(PG8_SB(1, 0), cB + kstep, voffB); PG8_STAGE(PG8_SA(1, 0), cA + kstep, voffA); PG8_STAGE(PG8_SB(1, 1), cB + hstep + kstep, voffB);
        PG8_WAIT_V(6); PG8_BAR;
    } else {
        PG8_STAGE(PG8_SB(0, 0), cB, voffB); PG8_STAGE(PG8_SA(0, 0), cA, voffA); PG8_STAGE(PG8_SB(0, 1), cB + hstep, voffB); PG8_STAGE(PG8_SA(0, 1), cA + hstep, voffA);
        if (wr == 1) PG8_BAR;
        PG8_WAIT_V(4); PG8_BAR;
        PG8_STAGE(PG8_SB(1, 0), cB + kstep, voffB); PG8_STAGE(PG8_SA(1, 0), cA + kstep, voffA); PG8_STAGE(PG8_SB(1, 1), cB + hstep + kstep, voffB);
        PG8_WAIT_V(6); PG8_BAR;
    }
    for (;;) {
        const bool has_next = S.next(ui + 1, nxt);
        const char* nA = has_next ? (const char*)g.A + (size_t)nxt.pm * tstep + nxt.koff : cA; const char* nB = has_next ? (const char*)g.Bt + (size_t)nxt.pn * tstep + nxt.koff : cB;
        for (int t = 0; t < nt; t += 2) {
            const bool last = (t == nt - 2);
            const char* a1 = cA + (size_t)(t + 1) * kstep;
            const char* a2 = last ? nA : cA + (size_t)(t + 2) * kstep; const char* b2 = last ? nB : cB + (size_t)(t + 2) * kstep;
            const char* a3 = a2 + kstep; const char* b3 = b2 + kstep;
            if (last && has_next) S.a_ready(nxt);
            if constexpr (SP2) {
            PG8_LDB(B0, 0, 0); PG8_LDB(B1, 0, 1); PG8_SCHED; PG8_LDA(At, 0, 0); PG8_STAGE(PG8_SA(1, 1), a1 + hstep, voffA);
            PG8_WAIT_V(8); PG8_WAIT_L(0); PG8_BAR; PG8_MMA(0, 0, At, B0); PG8_MMA(0, 1, At, B1); PG8_BAR; PG8_SCHED;
            PG8_LDA(At, 0, 1); PG8_STAGE(PG8_SB(0, 0), b2, voffB); PG8_STAGE(PG8_SB(0, 1), b2 + hstep, voffB); PG8_STAGE(PG8_SA(0, 0), a2, voffA);
            PG8_WAIT_V(8); PG8_WAIT_L(0); PG8_BAR; PG8_MMA(1, 0, At, B0); PG8_MMA(1, 1, At, B1); PG8_BAR; PG8_SCHED;
            PG8_LDB(B0, 1, 0); PG8_LDB(B1, 1, 1); PG8_SCHED; PG8_LDA(At, 1, 0); PG8_STAGE(PG8_SA(0, 1), a2 + hstep, voffA);
            PG8_WAIT_V(8); PG8_WAIT_L(0); PG8_BAR; PG8_MMA(0, 0, At, B0); PG8_MMA(0, 1, At, B1); PG8_BAR; PG8_SCHED;
            PG8_LDA(At, 1, 1); PG8_STAGE(PG8_SB(1, 0), b3, voffB); PG8_STAGE(PG8_SB(1, 1), b3 + hstep, voffB); PG8_STAGE(PG8_SA(1, 0), a3, voffA);
            PG8_WAIT_V(8); PG8_WAIT_L(0); PG8_BAR; PG8_MMA(1, 0, At, B0); PG8_MMA(1, 1, At, B1); PG8_BAR; PG8_SCHED;
            } else {
            PG8_LDB(B0, 0, 0); PG8_SCHED; PG8_LDA(At, 0, 0); PG8_STAGE(PG8_SA(1, 1), a1 + hstep, voffA);
            PG8_WAIT_L(8); PG8_BAR; PG8_WAIT_L(0); PG8_MMA(0, 0, At, B0); PG8_BAR; PG8_SCHED;
            PG8_LDB(B1, 0, 1); PG8_STAGE(PG8_SB(0, 0), b2, voffB);
            PG8_BAR; PG8_WAIT_L(0); PG8_MMA(0, 1, At, B1); PG8_BAR;
            PG8_LDA(At, 0, 1); PG8_STAGE(PG8_SA(0, 0), a2, voffA);
            PG8_BAR; PG8_WAIT_L(0); PG8_MMA(1, 0, At, B0); PG8_BAR; PG8_SCHED;
            PG8_STAGE(PG8_SB(0, 1), b2 + hstep, voffB);
            PG8_WAIT_V(6); PG8_BAR; PG8_MMA(1, 1, At, B1); PG8_BAR;
            PG8_LDB(B0, 1, 0); PG8_SCHED; PG8_LDA(At, 1, 0); PG8_STAGE(PG8_SA(0, 1), a2 + hstep, voffA);
            PG8_WAIT_L(8); PG8_BAR; PG8_WAIT_L(0); PG8_MMA(0, 0, At, B0); PG8_BAR; PG8_SCHED;
            PG8_LDB(B1, 1, 1); PG8_STAGE(PG8_SB(1, 0), b3, voffB);
            PG8_BAR; PG8_WAIT_L(0); PG8_MMA(0, 1, At, B1); PG8_BAR;
            PG8_LDA(At, 1, 1); PG8_STAGE(PG8_SA(1, 0), a3, voffA);
            PG8_BAR; PG8_WAIT_L(0); PG8_MMA(1, 0, At, B0); PG8_BAR; PG8_SCHED;
            PG8_STAGE(PG8_SB(1, 1), b3 + hstep, voffB);
            PG8_WAIT_V(6); PG8_BAR; PG8_MMA(1, 1, At, B1); PG8_BAR;
            }
        }
        if constexpr (ALIGN_EPI) { if (wr == 0) PG8_BAR; }
        if constexpr (!Epi::AFTER_DRAIN) { E(acc, cur, wr, wc, fr, fq); S.done(cur); }
        if (!has_next) break;
#pragma unroll
        for (int a = 0; a < 2; ++a)
#pragma unroll
            for (int b = 0; b < 2; ++b)
#pragma unroll
                for (int m = 0; m < 4; ++m)
#pragma unroll
                    for (int n = 0; n < 2; ++n) acc[a][b][m][n] = (f32x4){0.f, 0.f, 0.f, 0.f};
        cur = nxt; cA = nA; cB = nB; ++ui;
        if constexpr (ALIGN_EPI) { if (wr == 1) PG8_BAR; }
    }
    PG8_WAIT_V(0);
    if constexpr (!ALIGN_EPI) { if (wr == 0) PG8_BAR; }
    PG8_BAR;
    if constexpr (Epi::AFTER_DRAIN) { E.fused(acc, cur, wr, wc, fr, fq, lds, wid, lane); S.done(cur); }
#undef PG8_SA
#undef PG8_SB
#undef PG8_STAGE
#undef PG8_LDA
#undef PG8_LDB
#undef PG8_MMA
#undef PG8_WAIT_V
#undef PG8_WAIT_L
#undef PG8_BAR
#undef PG8_SCHED
}
}
#define GAS __attribute__((address_space(1)))
#define LAS __attribute__((address_space(3)))
typedef unsigned short bf16;
typedef unsigned v4u __attribute__((ext_vector_type(4)));
typedef float f32x4 __attribute__((ext_vector_type(4)));
typedef short bf16x8 __attribute__((ext_vector_type(8)));
typedef GAS unsigned gu32;
typedef GAS unsigned long long gu64;
#define RLX_AGENT __ATOMIC_RELAXED, __HIP_MEMORY_SCOPE_AGENT
#define LDS_WAIT() asm volatile("s_waitcnt lgkmcnt(0)" ::: "memory")
#define VM_WAIT() asm volatile("s_waitcnt vmcnt(0)" ::: "memory")
__device__ __forceinline__ unsigned long long rt() { return __builtin_amdgcn_s_memrealtime(); }
__device__ __forceinline__ unsigned f2bf(float f) { unsigned u = __builtin_bit_cast(unsigned, f); return (u + 0x7fffu + ((u >> 16) & 1u)) >> 16; }
__device__ __forceinline__ unsigned pk2(float lo, float hi) { return f2bf(lo) | (f2bf(hi) << 16); }

#define XB_TMO      128
#define XB_XCNT(j)  (256  + 64 * (j))
#define XB_XSUB(j)  (1280 + 64 * (j))
#define XB_XGEN(j)  (2304 + 64 * (j))
#define XB_TOP      3328
#define XB_TOPGEN   3392
#define XCD_BAR_WORDS 3456
#define XB_SPIN_CAP (1u << 18)

__device__ __forceinline__ unsigned xb_ld(unsigned* p)              { return __hip_atomic_load(p, __ATOMIC_RELAXED, __HIP_MEMORY_SCOPE_AGENT); }
__device__ __forceinline__ unsigned xb_add(unsigned* p, unsigned v) { return __hip_atomic_fetch_add(p, v, __ATOMIC_RELAXED, __HIP_MEMORY_SCOPE_AGENT); }
__device__ __forceinline__ unsigned xb_xcc_id() { return (unsigned)__builtin_amdgcn_s_getreg((3 << 11) | 20) & 0xFu; }
#define XB_SPIN(cond, bar) do { unsigned _sp = 0; while (cond) { __builtin_amdgcn_s_sleep(1); \
    if ((++_sp & 255u) == 0u) { if (xb_ld(&(bar)[XB_TMO])) break; if (_sp > XB_SPIN_CAP) { atomicAdd(&(bar)[XB_TMO], 1u); break; } } } } while (0)

struct XcdBarrier {
    unsigned* bar; unsigned x;
    volatile LAS unsigned* st;
};

__device__ __forceinline__ XcdBarrier xcd_barrier_post(unsigned* bar, volatile LAS unsigned* st) {
    XcdBarrier b; b.bar = bar; b.x = xb_xcc_id(); b.st = st;
    if (threadIdx.x == 0) (void)xb_add(&bar[XB_XCNT(b.x)], 1u);
    return b;
}
__device__ __forceinline__ void xcd_barrier_complete(unsigned* bar, unsigned x, unsigned& nloc, unsigned& nx) {
    const unsigned G = gridDim.x * gridDim.y * gridDim.z;
    unsigned sum, cnt, mine, sp = 0u;
    for (;;) {
        sum = 0u; cnt = 0u; mine = 0u;
#pragma unroll
        for (unsigned j = 0; j < 16; ++j) { const unsigned c = xb_ld(&bar[XB_XCNT(j)]); sum += c; cnt += (c > 0u) ? 1u : 0u; mine = (j == x) ? c : mine; }
        if (sum == G) break;
        __builtin_amdgcn_s_sleep(1);
        if ((++sp & 255u) == 0u) { if (xb_ld(&bar[XB_TMO])) break; if (sp > XB_SPIN_CAP) { atomicAdd(&bar[XB_TMO], 1u); break; } }
    }
    nloc = mine > 0u ? mine : 1u; nx = cnt > 0u ? cnt : 1u;
}

__device__ __forceinline__ void xcd_barrier(const XcdBarrier& b) {
    asm volatile("s_waitcnt vmcnt(0)" ::: "memory");
    __syncthreads();
    if (threadIdx.x == 0) {
        unsigned* bar = b.bar;
        __builtin_amdgcn_s_waitcnt(0);
        unsigned nloc = b.st[0], nx = b.st[1];
        if (nloc == 0u) { xcd_barrier_complete(bar, b.x, nloc, nx); b.st[0] = nloc; b.st[1] = nx; }
        const unsigned old = xb_add(&bar[XB_XSUB(b.x)], 1u);
        const unsigned gen = old / nloc;
        if (old + 1u == (gen + 1u) * nloc) {
            __builtin_amdgcn_fence(__ATOMIC_RELEASE, "agent");
            asm volatile("s_waitcnt vmcnt(0)" ::: "memory");
            const unsigned og = xb_add(&bar[XB_TOP], 1u);
            const unsigned tg = og / nx;
            if (og + 1u == (tg + 1u) * nx) xb_add(&bar[XB_TOPGEN], 1u);
            else XB_SPIN(xb_ld(&bar[XB_TOPGEN]) == tg, bar);
            __builtin_amdgcn_fence(__ATOMIC_ACQUIRE, "agent");
            xb_add(&bar[XB_XGEN(b.x)], 1u);
            asm volatile("s_waitcnt vmcnt(0)" ::: "memory");
        } else {
            XB_SPIN(xb_ld(&bar[XB_XGEN(b.x)]) == gen, bar);
            __builtin_amdgcn_fence(__ATOMIC_ACQUIRE, "agent");
            asm volatile("s_waitcnt vmcnt(0)" ::: "memory");
        }
    }
    __syncthreads();
}
constexpr int NWAVES = 8, NTHR = 512;
constexpr int LX = 8192, LC = 256, DM = 1024, MXR = 16384, MROWS = 16896, NINP = 3840, DFF = 2816;
constexpr float EPS = 1e-6f;
constexpr size_t MiB = 1u << 20, KiB = 1u << 10;
constexpr size_t WS_CTL = 0, CTL_ZERO_BYTES = 64 * KiB;
constexpr size_t WS_MODS = 1 * MiB;
constexpr size_t WS_TW = 1 * MiB + 512 * KiB;
constexpr size_t WS_CTXS = 2 * MiB;
constexpr size_t WS_H2 = 4 * MiB;
constexpr size_t WS_H2C = 8 * MiB;
constexpr size_t WS_SSQ = 8 * MiB + 64 * KiB;
constexpr size_t WS_DTS = 8 * MiB + 640 * KiB;
constexpr size_t WS_DTH = 8 * MiB + 704 * KiB;
constexpr size_t WS_UDT = 9 * MiB;
constexpr size_t WS_WIN = 11 * MiB;
constexpr size_t WS_WOUT = 18 * MiB + 512 * KiB;
constexpr size_t WS_HN = 21 * MiB;
constexpr size_t WS_UHG = 54 * MiB;
constexpr size_t WS_UHY = 96 * MiB;
constexpr size_t WS_UZ = 121 * MiB;
constexpr size_t WS_UXS = 138 * MiB;
constexpr size_t WS_UBC = 154 * MiB + 512 * KiB;
constexpr size_t WS_SST = 138 * MiB;
constexpr size_t WS_AXT = 171 * MiB;
constexpr size_t WS_ABC = 187 * MiB + 512 * KiB;
constexpr size_t WS_ABT = 204 * MiB;
constexpr size_t WS_HST = 213 * MiB;
constexpr size_t WS_MIX = 222 * MiB;
constexpr size_t WS_A = 54 * MiB;
constexpr size_t WS_UP = 145 * MiB;
constexpr size_t WS_WGU = 236 * MiB;
constexpr size_t WS_WD = 247 * MiB;
constexpr size_t WS_END = 256 * MiB;
constexpr int HSP = 8200;
constexpr int CW_BAR = 1024;
constexpr int RING_BYTES = 131072, SCR_OFF = 131072, LDS_BYTES = 147456, MISC_OFF = LDS_BYTES - 128;

typedef float f32x2 __attribute__((ext_vector_type(2)));
typedef unsigned u32x2 __attribute__((ext_vector_type(2)));
typedef unsigned u32x4 __attribute__((ext_vector_type(4)));
#define MFMA4(a, b, c) __builtin_amdgcn_mfma_f32_16x16x4f32((a), (b), (c), 0, 0, 0)

__device__ __forceinline__ float bflo(unsigned w) { return __builtin_bit_cast(float, w << 16); }
__device__ __forceinline__ float bfhi(unsigned w) { return __builtin_bit_cast(float, w & 0xffff0000u); }
__device__ __forceinline__ float bf2f(bf16 h) { return __builtin_bit_cast(float, (unsigned)h << 16); }
__device__ __forceinline__ float siluf(float x) { return x / (1.0f + __expf(-x)); }
__device__ __forceinline__ float sigmf(float x) { return 1.0f / (1.0f + __expf(-x)); }
__device__ __forceinline__ u32x4 pack8(const float (&o)[8]) { u32x4 u; u.x = pk2(o[0], o[1]); u.y = pk2(o[2], o[3]); u.z = pk2(o[4], o[5]); u.w = pk2(o[6], o[7]); return u; }
__device__ __forceinline__ float wave_sum(float v) {
#pragma unroll
    for (int o = 1; o < 64; o <<= 1) v += __shfl_xor(v, o);
    return v;
}
__device__ __forceinline__ void block_sum2(float& a, float& b, LAS float* red, int wave, int lane) {
    a = wave_sum(a); b = wave_sum(b);
    __syncthreads();
    if (lane == 0) { red[wave] = a; red[8 + wave] = b; }
    __syncthreads();
    float sa = 0.f, sb = 0.f;
#pragma unroll
    for (int w = 0; w < 8; ++w) { sa += red[w]; sb += red[8 + w]; }
    a = sa; b = sb;
    __syncthreads();
}

__device__ __forceinline__ void p0_mods_item(const float* c, const float* cctx, const float* w_ada, const float* b_ada, float* mods, LAS float* sm, int item, int tid, int wave, int lane) {
    for (int k = tid; k < 1024; k += NTHR) { sm[k] = siluf(c[k]); sm[1024 + k] = siluf(c[1024 + k]); sm[2048 + k] = siluf(cctx[k]); }
    __syncthreads();
    const int l = item / 96, n0 = (item % 96) * 64;
    const float* W = w_ada + (size_t)l * 1024 * 6144 + n0 + lane;
    float a0 = 0.f, a1 = 0.f, a2 = 0.f;
#pragma unroll 32
    for (int kk = 0; kk < 128; ++kk) { const int k = wave * 128 + kk; const float w = W[(size_t)k * 6144]; a0 += sm[k] * w; a1 += sm[1024 + k] * w; a2 += sm[2048 + k] * w; }
    LAS float* red = sm + 3072;
    red[(wave * 3 + 0) * 64 + lane] = a0; red[(wave * 3 + 1) * 64 + lane] = a1; red[(wave * 3 + 2) * 64 + lane] = a2;
    __syncthreads();
    if (tid < 192) { const int v = tid >> 6, ln = tid & 63; float s = 0.f;
#pragma unroll
        for (int w = 0; w < 8; ++w) s += red[(w * 3 + v) * 64 + ln];
        mods[(size_t)(l * 3 + v) * 6144 + n0 + ln] = s + b_ada[(size_t)l * 6144 + n0 + ln]; }
    __syncthreads();
}
__device__ __forceinline__ void p0_h2_rows(const float* w1, const float* b1, const float* f1, const float* w2, const float* b2, const float* f2, float* out, bf16* outb, int slen, int first, int step, int lane) {
    float w1c[33], w2c[64];
#pragma unroll
    for (int i = 0; i < 33; ++i) w1c[i] = w1[i * 64 + lane];
#pragma unroll
    for (int i = 0; i < 64; ++i) w2c[i] = w2[i * 64 + lane];
    const float bb1 = b1[lane], ff1 = f1[lane], bb2 = b2[lane], ff2 = f2[lane];
#pragma unroll 1
    for (int t = first; t < slen; t += step) {
        const float tl = (float)t / (float)(slen - 1);
        const float w = (6.283185307179586f * (float)t) / (float)slen;
        float z = 0.f;
        if (lane == 0) z = tl;
        else if (lane <= 16) { const float band = 1e-4f + (float)(lane - 1) * ((15.0f - 1e-4f) / 15.0f); z = __cosf(band * w); }
        else if (lane <= 32) { const float band = 1e-4f + (float)(lane - 17) * ((15.0f - 1e-4f) / 15.0f); z = -__sinf(band * w); }
        float pre = bb1;
#pragma unroll
        for (int i = 0; i < 33; ++i) pre += __builtin_bit_cast(float, __builtin_amdgcn_readlane(__builtin_bit_cast(int, z), i)) * w1c[i];
        const float h1 = __sinf(ff1 * pre);
        float pre2 = bb2;
#pragma unroll
        for (int i = 0; i < 64; ++i) pre2 += __builtin_bit_cast(float, __builtin_amdgcn_readlane(__builtin_bit_cast(int, h1), i)) * w2c[i];
        const float hv = __sinf(ff2 * pre2);
        if (outb) outb[(size_t)t * 64 + lane] = (bf16)f2bf(hv); else out[(size_t)t * 64 + lane] = hv;
    }
}
__device__ __forceinline__ void transpose_item(const float* W, int K, int N, int Nvalid, bf16* WT, LAS float* scr, int item, int lane) {
    const int nblk = N / 32, kb = item / nblk, nb = item % nblk, k0 = 64 * kb, n0 = 32 * nb;
    const int n4 = (lane & 7) * 4, nn = n0 + n4;
    f32x4 ld[8];
#pragma unroll
    for (int i = 0; i < 8; ++i) { const int kk = 8 * i + (lane >> 3); ld[i] = nn < Nvalid ? *(const f32x4*)(W + (size_t)(k0 + kk) * Nvalid + nn) : (f32x4){0.f, 0.f, 0.f, 0.f}; }
#pragma unroll
    for (int i = 0; i < 8; ++i) { const int kk = 8 * i + (lane >> 3); LAS float* d = scr + kk * 33 + n4; d[0] = ld[i].x; d[1] = ld[i].y; d[2] = ld[i].z; d[3] = ld[i].w; }
    LDS_WAIT(); asm volatile("" ::: "memory");
    const int c = lane & 7;
#pragma unroll
    for (int j = 0; j < 4; ++j) { const int n = (lane >> 3) + 8 * j; const LAS float* s = scr + (8 * c) * 33 + n;
        v4u o; o.x = pk2(s[0 * 33], s[1 * 33]); o.y = pk2(s[2 * 33], s[3 * 33]); o.z = pk2(s[4 * 33], s[5 * 33]); o.w = pk2(s[6 * 33], s[7 * 33]);
        *(GAS v4u*)(WT + (size_t)(n0 + n) * K + k0 + 8 * c) = o; }
    LDS_WAIT(); asm volatile("" ::: "memory");
}
__device__ __forceinline__ void convert_weight(const float* W, int K, int N, int Nvalid, bf16* WT, LAS float* scr, int gw, int ngw, int lane) {
    const int nitems = (K / 64) * (N / 32);
#pragma unroll 1
    for (int it = gw; it < nitems; it += ngw) transpose_item(W, K, N, Nvalid, WT, scr, it, lane);
}

__device__ __forceinline__ void norm_rows(const float* xsrc, const float* csrc, int nrows, const float* g, const float* mods_l, int kshift, int kscale, bf16* hn, int gw, int ngw, int lane,
                                          const float* pend = nullptr, int pnsplit = 0, const float* pgate = nullptr, float* cdst = nullptr) {
    f32x4 gv[4];
#pragma unroll
    for (int j = 0; j < 4; ++j) gv[j] = *(const f32x4*)(g + 4 * lane + 256 * j);
    f32x4 x[4];
    if (gw < nrows) { const float* src = gw < MXR ? xsrc + (size_t)gw * DM : csrc + (size_t)(gw - MXR) * DM;
#pragma unroll
        for (int j = 0; j < 4; ++j) x[j] = *(const f32x4*)(src + 4 * lane + 256 * j); }
#pragma unroll 1
    for (int m = gw; m < nrows; m += ngw) {
        const int v = m < MXR ? (m >> 13) : 2;
        const float* sh = mods_l + (size_t)v * 6144 + kshift * 1024; const float* sc = mods_l + (size_t)v * 6144 + kscale * 1024;
        float ss = 0.f;
        f32x4 xn[4];
        { const int mn = m + ngw; if (mn < nrows) { const float* srcn = mn < MXR ? xsrc + (size_t)mn * DM : csrc + (size_t)(mn - MXR) * DM;
#pragma unroll
            for (int j = 0; j < 4; ++j) xn[j] = *(const f32x4*)(srcn + 4 * lane + 256 * j); } }
        if (pend && m >= MXR) {
            const int rl = m - MXR;
#pragma unroll
            for (int j = 0; j < 4; ++j) {
                const float* sp = pend + (size_t)(((rl >> 8) * 4 + j) * pnsplit) * 65536 + (size_t)(rl & 255) * 256 + 4 * lane;
                f32x4 sum = (f32x4){0.f, 0.f, 0.f, 0.f};
                for (int ks = 0; ks < pnsplit; ++ks) sum += *(const f32x4*)(sp + (size_t)ks * 65536);
                x[j] += *(const f32x4*)(pgate + 4 * lane + 256 * j) * sum;
                *(f32x4*)(cdst + (size_t)rl * DM + 4 * lane + 256 * j) = x[j];
            }
        }
#pragma unroll
        for (int j = 0; j < 4; ++j) ss += (x[j].x * x[j].x + x[j].y * x[j].y) + (x[j].z * x[j].z + x[j].w * x[j].w);
        const float rstd = 1.0f / sqrtf(wave_sum(ss) * (1.0f / DM) + EPS);
#pragma unroll
        for (int j = 0; j < 4; ++j) {
            const f32x4 s4 = *(const f32x4*)(sc + 4 * lane + 256 * j), h4 = *(const f32x4*)(sh + 4 * lane + 256 * j);
            const f32x4 y = x[j] * rstd * gv[j] * (s4 + 1.0f) + h4;
            u32x2 o; o.x = pk2(y.x, y.y); o.y = pk2(y.z, y.w);
            *(u32x2*)(hn + (size_t)m * DM + 4 * lane + 256 * j) = o;
        }
#pragma unroll
        for (int j = 0; j < 4; ++j) x[j] = xn[j];
    }
}
__device__ __forceinline__ void final_norm_rows(float* x, const float* g, int gw, int ngw, int lane) {
    f32x4 gv[4];
#pragma unroll
    for (int j = 0; j < 4; ++j) gv[j] = *(const f32x4*)(g + 4 * lane + 256 * j);
    f32x4 v[4];
    if (gw < MXR) {
#pragma unroll
        for (int j = 0; j < 4; ++j) v[j] = *(const f32x4*)(x + (size_t)gw * DM + 4 * lane + 256 * j); }
#pragma unroll 1
    for (int m = gw; m < MXR; m += ngw) {
        float* src = x + (size_t)m * DM;
        float ss = 0.f;
        f32x4 vn[4];
        if (m + ngw < MXR) {
#pragma unroll
            for (int j = 0; j < 4; ++j) vn[j] = *(const f32x4*)(x + (size_t)(m + ngw) * DM + 4 * lane + 256 * j); }
#pragma unroll
        for (int j = 0; j < 4; ++j) ss += (v[j].x * v[j].x + v[j].y * v[j].y) + (v[j].z * v[j].z + v[j].w * v[j].w);
        const float rstd = 1.0f / sqrtf(wave_sum(ss) * (1.0f / DM) + EPS);
#pragma unroll
        for (int j = 0; j < 4; ++j) *(f32x4*)(src + 4 * lane + 256 * j) = v[j] * rstd * gv[j];
#pragma unroll
        for (int j = 0; j < 4; ++j) v[j] = vn[j];
    }
}

__device__ __forceinline__ void cv_unpack(const u32x4 v, float (&o)[8]) { o[0] = bflo(v.x); o[1] = bfhi(v.x); o[2] = bflo(v.y); o[3] = bfhi(v.y); o[4] = bflo(v.z); o[5] = bfhi(v.z); o[6] = bflo(v.w); o[7] = bfhi(v.w); }
__device__ __forceinline__ void ffn_conv_phase(const bf16* a, bf16* up, const float* cw  , const float* cb, int row_first, int nrows, int gtid, int ngt, bf16* outp, long out_row_delta) {
    constexpr int ncg = DFF / 8, SEG = 16;
    const int nseg = nrows / SEG, tpc = ngt / ncg;
    if (gtid >= tpc * ncg) return;
    const int cgi = gtid % ncg, c = cgi * 8;
    float w[9][8], bias[8];
#pragma unroll
    for (int k = 0; k < 9; ++k) { const f32x4 w0 = *(const f32x4*)(cw + (size_t)k * DFF + c), w1 = *(const f32x4*)(cw + (size_t)k * DFF + c + 4);
        w[k][0] = w0.x; w[k][1] = w0.y; w[k][2] = w0.z; w[k][3] = w0.w; w[k][4] = w1.x; w[k][5] = w1.y; w[k][6] = w1.z; w[k][7] = w1.w; }
    { const f32x4 b0 = *(const f32x4*)(cb + c), b1 = *(const f32x4*)(cb + c + 4); bias[0] = b0.x; bias[1] = b0.y; bias[2] = b0.z; bias[3] = b0.w; bias[4] = b1.x; bias[5] = b1.y; bias[6] = b1.z; bias[7] = b1.w; }
#pragma unroll 1
    for (int seg = gtid / ncg; seg < nseg; seg += tpc) {
        const int row0 = row_first + seg * SEG;
        int rr, ww0, nr, nw;
        if (row0 < MXR) { const int t = row0 & 8191; rr = t >> 6; ww0 = t & 63; nr = 128; nw = 64; } else { const int t = (row0 - MXR) & 255; rr = 0; ww0 = t; nr = 1; nw = 256; }
        const bool has_up = rr > 0, has_dn = rr < nr - 1;
        const u32x4 zero = (u32x4){0u, 0u, 0u, 0u};
        u32x4 win[3][3];
        const bf16* pm = a + (size_t)row0 * DFF + c;
#pragma unroll
        for (int ky = 0; ky < 3; ++ky) {
            const bool okr = ky == 0 ? has_up : (ky == 2 ? has_dn : true);
            const bf16* pr = pm + (ptrdiff_t)(ky - 1) * nw * DFF;
            win[ky][0] = (okr && ww0 > 0) ? *(const u32x4*)(pr - DFF) : zero;
            win[ky][1] = okr ? *(const u32x4*)pr : zero;
        }
#pragma unroll 4
        for (int i = 0; i < SEG; ++i) {
            const int wcur = ww0 + i;
            const bool okn = wcur + 1 < nw;
#pragma unroll
            for (int ky = 0; ky < 3; ++ky) {
                const bool okr = ky == 0 ? has_up : (ky == 2 ? has_dn : true);
                win[ky][2] = (okr && okn) ? *(const u32x4*)(pm + (ptrdiff_t)((ky - 1) * nw + i + 1) * DFF) : zero;
            }
            const u32x4 uv = *(const u32x4*)(up + (size_t)(row0 + i) * DFF + c);
            float acc[8];
#pragma unroll
            for (int j = 0; j < 8; ++j) acc[j] = bias[j];
#pragma unroll
            for (int ky = 0; ky < 3; ++ky)
#pragma unroll
                for (int kx = 0; kx < 3; ++kx) { float v[8]; cv_unpack(win[ky][kx], v);
#pragma unroll
                    for (int j = 0; j < 8; ++j) acc[j] += w[ky * 3 + kx][j] * v[j]; }
            float u[8]; cv_unpack(uv, u);
            u32x4 o;
            o.x = pk2(siluf(acc[0]) * u[0], siluf(acc[1]) * u[1]); o.y = pk2(siluf(acc[2]) * u[2], siluf(acc[3]) * u[3]);
            o.z = pk2(siluf(acc[4]) * u[4], siluf(acc[5]) * u[5]); o.w = pk2(siluf(acc[6]) * u[6], siluf(acc[7]) * u[7]);
            *(u32x4*)(outp + (size_t)(row0 + i + out_row_delta) * DFF + c) = o;
#pragma unroll
            for (int ky = 0; ky < 3; ++ky) { win[ky][0] = win[ky][1]; win[ky][1] = win[ky][2]; }
        }
    }
}
constexpr int FN = 16384, FNP = FN + (FN >> 6) * 4;
constexpr int FFT_SCR = FNP * 8;
__device__ __forceinline__ int DI(int i) { return i + ((i >> 6) << 2); }
__device__ __forceinline__ f32x2 cmul(f32x2 a, f32x2 b) { return (f32x2){a.x * b.x - a.y * b.y, a.x * b.y + a.y * b.x}; }
__device__ __forceinline__ f32x2 cmulc(f32x2 a, f32x2 b) { return (f32x2){a.x * b.x + a.y * b.y, a.y * b.x - a.x * b.y}; }
__device__ __forceinline__ int rev4(int p) {
    unsigned r = __brev((unsigned)p) >> 18;
    return (int)(((r & 0x1555u) << 1) | ((r >> 1) & 0x1555u));
}
#define BF4F(x0, x1, x2, x3) do { const f32x2 a_ = x0 + x2, b_ = x0 - x2, c_ = x1 + x3, d_ = x1 - x3; x0 = a_ + c_; x2 = a_ - c_; x1 = (f32x2){b_.x + d_.y, b_.y - d_.x}; x3 = (f32x2){b_.x - d_.y, b_.y + d_.x}; } while (0)
#define BF4I(x0, x1, x2, x3) do { const f32x2 a_ = x0 + x2, b_ = x0 - x2, c_ = x1 + x3, d_ = x1 - x3; x0 = a_ + c_; x2 = a_ - c_; x1 = (f32x2){b_.x - d_.y, b_.y + d_.x}; x3 = (f32x2){b_.x + d_.y, b_.y - d_.x}; } while (0)
#define W16_C1 0.92387953251128674f
#define W16_S1 0.38268343236508977f
#define W16_H 0.70710678118654752f
__device__ __forceinline__ f32x2 w16(int e) {
    switch (e) { case 1: return (f32x2){W16_C1, -W16_S1}; case 2: return (f32x2){W16_H, -W16_H}; case 3: return (f32x2){W16_S1, -W16_C1}; case 4: return (f32x2){0.f, -1.f};
                 case 6: return (f32x2){-W16_H, -W16_H}; default: return (f32x2){-W16_C1, W16_S1}; }
}
template <bool INV> __device__ __forceinline__ void fft_pass16(LAS f32x2* D, int lgm, int tid) {
    const int m = 1 << lgm; const float rn = 1.0f / (float)(16 << lgm);
#pragma unroll 1
    for (int it = 0; it < 2; ++it) {
        const int bf = tid + NTHR * it, j0 = bf & (m - 1), base = ((bf >> lgm) << (lgm + 4)) + j0;
        f32x2 v[16];
#pragma unroll
        for (int r = 0; r < 16; ++r) v[r] = D[DI(base + r * m)];
        const float rev = (float)j0 * rn;
        const f32x2 w1 = (f32x2){__builtin_amdgcn_cosf(rev), -__builtin_amdgcn_sinf(rev)}, w2 = cmul(w1, w1), w3 = cmul(w2, w1);
        const f32x2 u1 = cmul(w2, w2), u2 = cmul(u1, u1), u3 = cmul(u2, u1);
        if (!INV) {
#pragma unroll
            for (int a = 0; a < 4; ++a) {
                BF4F(v[a], v[a + 4], v[a + 8], v[a + 12]);
                if (a > 0) { v[a + 4] = cmul(v[a + 4], w16(a)); v[a + 8] = cmul(v[a + 8], w16(2 * a)); v[a + 12] = cmul(v[a + 12], w16(3 * a)); }
                v[a + 4] = cmul(v[a + 4], w1); v[a + 8] = cmul(v[a + 8], w2); v[a + 12] = cmul(v[a + 12], w3);
            }
#pragma unroll
            for (int q = 0; q < 4; ++q) {
                BF4F(v[4 * q], v[4 * q + 1], v[4 * q + 2], v[4 * q + 3]);
                v[4 * q + 1] = cmul(v[4 * q + 1], u1); v[4 * q + 2] = cmul(v[4 * q + 2], u2); v[4 * q + 3] = cmul(v[4 * q + 3], u3);
            }
        } else {
#pragma unroll
            for (int q = 0; q < 4; ++q) {
                v[4 * q + 1] = cmulc(v[4 * q + 1], u1); v[4 * q + 2] = cmulc(v[4 * q + 2], u2); v[4 * q + 3] = cmulc(v[4 * q + 3], u3);
                BF4I(v[4 * q], v[4 * q + 1], v[4 * q + 2], v[4 * q + 3]);
            }
#pragma unroll
            for (int a = 0; a < 4; ++a) {
                v[a + 4] = cmulc(v[a + 4], w1); v[a + 8] = cmulc(v[a + 8], w2); v[a + 12] = cmulc(v[a + 12], w3);
                if (a > 0) { v[a + 4] = cmulc(v[a + 4], w16(a)); v[a + 8] = cmulc(v[a + 8], w16(2 * a)); v[a + 12] = cmulc(v[a + 12], w16(3 * a)); }
                BF4I(v[a], v[a + 4], v[a + 8], v[a + 12]);
            }
        }
#pragma unroll
        for (int r = 0; r < 16; ++r) D[DI(base + r * m)] = v[r];
    }
    __syncthreads();
}
template <bool INV> __device__ __forceinline__ void fft_pass4(LAS f32x2* D, int tid) {
#pragma unroll 2
    for (int it = 0; it < 8; ++it) {
        const int i0 = DI(4 * (tid + NTHR * it));
        f32x4 p01 = *(LAS f32x4*)(D + i0), p23 = *(LAS f32x4*)(D + i0 + 2);
        f32x2 x0 = (f32x2){p01.x, p01.y}, x1 = (f32x2){p01.z, p01.w}, x2 = (f32x2){p23.x, p23.y}, x3 = (f32x2){p23.z, p23.w};
        if (!INV) BF4F(x0, x1, x2, x3); else BF4I(x0, x1, x2, x3);
        *(LAS f32x4*)(D + i0) = (f32x4){x0.x, x0.y, x1.x, x1.y}; *(LAS f32x4*)(D + i0 + 2) = (f32x4){x2.x, x2.y, x3.x, x3.y};
    }
    __syncthreads();
}
__device__ __forceinline__ void fft_fwd(LAS f32x2* D, int tid) { fft_pass16<false>(D, 10, tid); fft_pass16<false>(D, 6, tid); fft_pass16<false>(D, 2, tid); fft_pass4<false>(D, tid); }
__device__ __forceinline__ void fft_inv(LAS f32x2* D, int tid) { fft_pass4<true>(D, tid); fft_pass16<true>(D, 2, tid); fft_pass16<true>(D, 6, tid); fft_pass16<true>(D, 10, tid); }
__device__ __forceinline__ void spec_mul(LAS f32x2* D, const f32x2* H, int tid) {
#pragma unroll 8
    for (int i = 0; i < 32; ++i) {
        const int p = tid + NTHR * i, k = rev4(p);
        f32x2 h;
        if (k <= 8192) h = H[k]; else { h = H[FN - k]; h.y = -h.y; }
        D[DI(p)] = cmul(D[DI(p)], h);
    }
    __syncthreads();
}

__device__ __forceinline__ void fft_mid(LAS f32x2* D, const unsigned* T, int tid) {
#pragma unroll 4
    for (int it = 0; it < 8; ++it) {
        const int bf = tid + NTHR * it, i0 = DI(4 * bf);
        const u32x4 hq = *(const u32x4*)(T + 4 * bf);
        f32x4 p01 = *(LAS f32x4*)(D + i0), p23 = *(LAS f32x4*)(D + i0 + 2);
        f32x2 x0 = (f32x2){p01.x, p01.y}, x1 = (f32x2){p01.z, p01.w}, x2 = (f32x2){p23.x, p23.y}, x3 = (f32x2){p23.z, p23.w};
        BF4F(x0, x1, x2, x3);
        x0 = cmul(x0, (f32x2){bflo(hq.x), bfhi(hq.x)}); x1 = cmul(x1, (f32x2){bflo(hq.y), bfhi(hq.y)}); x2 = cmul(x2, (f32x2){bflo(hq.z), bfhi(hq.z)}); x3 = cmul(x3, (f32x2){bflo(hq.w), bfhi(hq.w)});
        BF4I(x0, x1, x2, x3);
        *(LAS f32x4*)(D + i0) = (f32x4){x0.x, x0.y, x1.x, x1.y}; *(LAS f32x4*)(D + i0 + 2) = (f32x4){x2.x, x2.y, x3.x, x3.y};
    }
    __syncthreads();
}
__device__ __forceinline__ void fft_conv(LAS f32x2* D, const unsigned* H, int tid) {
    fft_pass16<false>(D, 10, tid); fft_pass16<false>(D, 6, tid); fft_pass16<false>(D, 2, tid);
    fft_mid(D, H, tid);
    fft_pass16<true>(D, 2, tid); fft_pass16<true>(D, 6, tid); fft_pass16<true>(D, 10, tid);
}

__device__ __forceinline__ void hy_spectrum_item(LAS unsigned char* lds, const bf16* h2l  , const float* w3l  , const float* hbias  , unsigned* Hs, int c, int tid, int wave, int lane) {
    LAS f32x2* D = (LAS f32x2*)lds;
    LAS float* red = (LAS float*)(lds + FFT_SCR + 4096);
    LAS float* stg = (LAS float*)(lds + FFT_SCR) + wave * 128;
    const float delta = fabsf(-3.0701134573253946f + (float)c * ((-15.350567286626973f + 3.0701134573253946f) / 255.0f));
    const int l15 = lane & 15, l4 = lane >> 4;
    bf16x8 bw[2];
#pragma unroll
    for (int kk = 0; kk < 2; ++kk) { float w8[8];
#pragma unroll
        for (int e = 0; e < 8; ++e) w8[e] = l15 < 4 ? w3l[(size_t)(32 * kk + 8 * l4 + e) * 1024 + l15 * 256 + c] : 0.f;
        bw[kk] = __builtin_bit_cast(bf16x8, pack8(w8)); }
    float s0 = 0.f, s1 = 0.f;
    __syncthreads();
    if (tid == 0) D[DI(8192)] = (f32x2){0.f, 0.f};
#pragma unroll 4
    for (int bt = 0; bt < 32; ++bt) {
        const int R0 = 1024 * wave + 32 * ((bt + c) & 31);
        bf16x8 a0[2], a1[2];
#pragma unroll
        for (int q = 0; q < 2; ++q) { const bf16* hr = h2l + (size_t)(R0 + 16 * q + l15) * 64 + 8 * l4; a0[q] = *(const bf16x8*)hr; a1[q] = *(const bf16x8*)(hr + 32); }
#pragma unroll
        for (int q = 0; q < 2; ++q) {
            f32x4 acc = (f32x4){0.f, 0.f, 0.f, 0.f};
            acc = __builtin_amdgcn_mfma_f32_16x16x32_bf16(a0[q], bw[0], acc, 0, 0, 0);
            acc = __builtin_amdgcn_mfma_f32_16x16x32_bf16(a1[q], bw[1], acc, 0, 0, 0);
            if (l15 < 4) {
#pragma unroll
                for (int r = 0; r < 4; ++r) stg[(16 * q + 4 * l4 + r) * 4 + l15] = acc[r]; }
        }
        asm volatile("s_waitcnt lgkmcnt(0)" ::: "memory");
        if (lane < 32) {
            const int t = R0 + lane;
            const f32x4 a = *(const LAS f32x4*)(stg + 4 * lane) * __expf(-((float)t / 8191.0f) * delta);
            D[DI(t)] = (f32x2){a.x, a.y};
            s0 += fabsf(a.x); s1 += fabsf(a.y);
            if (t >= 1) { D[DI(FN - t)] = (f32x2){a.z, a.w}; s0 += fabsf(a.z); s1 += fabsf(a.w); }
        }
        asm volatile("s_waitcnt lgkmcnt(0)" ::: "memory");
    }
    block_sum2(s0, s1, red, wave, lane);
    fft_fwd(D, tid);
    const float i0 = 0.5f / s0, i1 = 0.5f / s1, bias0 = hbias[c], bias1 = hbias[256 + c];
    unsigned* T0 = Hs + (size_t)(c * 2 + 0) * FN; unsigned* T1 = Hs + (size_t)(c * 2 + 1) * FN;
#pragma unroll 4
    for (int i = 0; i < 32; ++i) {
        const int p = tid + NTHR * i, k = rev4(p);
        const f32x2 zk = D[DI(p)], zn = D[DI(rev4((FN - k) & (FN - 1)))];
        T0[p] = pk2((zk.x + zn.x) * i0 + bias0, (zk.y - zn.y) * i0);
        T1[p] = pk2((zk.y + zn.y) * i1 + bias1, -(zk.x - zn.x) * i1);
    }
    __syncthreads();
}

__device__ __forceinline__ float hy_conv3(const bf16* row, int t, int len, float w0, float w1, float w2, float bias) {
    const float um = t > 0 ? bf2f(row[t - 1]) : 0.f, u0 = bf2f(row[t]), up = t < len - 1 ? bf2f(row[t + 1]) : 0.f;
    return w0 * um + w1 * u0 + w2 * up + bias;
}
__device__ __forceinline__ void hy_conv8(const bf16* row, int t0, int len, float w0, float w1, float w2, float bias, float (&o)[8]) {
    const u32x4 v = *(const u32x4*)(row + t0);
    const float um = t0 > 0 ? bf2f(row[t0 - 1]) : 0.f, un = t0 + 8 < len ? bf2f(row[t0 + 8]) : 0.f;
    float x[10]; x[0] = um; x[1] = bflo(v.x); x[2] = bfhi(v.x); x[3] = bflo(v.y); x[4] = bfhi(v.y); x[5] = bflo(v.z); x[6] = bfhi(v.z); x[7] = bflo(v.w); x[8] = bfhi(v.w); x[9] = un;
#pragma unroll
    for (int e = 0; e < 8; ++e) o[e] = w0 * x[e] + w1 * x[e + 1] + w2 * x[e + 2] + bias;
}
__device__ __forceinline__ void hy_fft_item(LAS unsigned char* lds, const bf16* uhyT, const float* cw  , const float* cb  , const unsigned* Hs, bf16* hyoT, int c, int tid) {
    LAS f32x2* D = (LAS f32x2*)lds;
    const bf16* rv = uhyT + (size_t)c * MROWS; const bf16* r1 = uhyT + (size_t)(256 + c) * MROWS; const bf16* r2 = uhyT + (size_t)(512 + c) * MROWS;
    const float vw0 = cw[c], vw1 = cw[768 + c], vw2 = cw[1536 + c], vb = cb[c];
    const float aw0 = cw[256 + c], aw1 = cw[768 + 256 + c], aw2 = cw[1536 + 256 + c], ab = cb[256 + c];
    const float bw0 = cw[512 + c], bw1 = cw[768 + 512 + c], bw2 = cw[1536 + 512 + c], bb = cb[512 + c];
    const float inv = 1.0f / (float)FN;
    __syncthreads();
#pragma unroll
    for (int i = 0; i < 2; ++i) { const int t0 = 8 * (tid + NTHR * i);
        float a[8], b[8]; hy_conv8(rv, t0, LX, vw0, vw1, vw2, vb, a); hy_conv8(rv + LX, t0, LX, vw0, vw1, vw2, vb, b);
#pragma unroll
        for (int e = 0; e < 8; ++e) { D[DI(t0 + e)] = (f32x2){a[e], b[e]}; D[DI(t0 + e + LX)] = (f32x2){0.f, 0.f}; } }
    __syncthreads();
    fft_conv(D, Hs + (size_t)(c * 2 + 0) * FN, tid);
#pragma unroll
    for (int i = 0; i < 2; ++i) { const int t0 = 8 * (tid + NTHR * i);
        float a[8], b[8]; hy_conv8(r1, t0, LX, aw0, aw1, aw2, ab, a); hy_conv8(r1 + LX, t0, LX, aw0, aw1, aw2, ab, b);
#pragma unroll
        for (int e = 0; e < 8; ++e) { const f32x2 cv = D[DI(t0 + e)]; D[DI(t0 + e)] = (f32x2){a[e] * cv.x * inv, b[e] * cv.y * inv}; D[DI(t0 + e + LX)] = (f32x2){0.f, 0.f}; } }
    __syncthreads();
    fft_conv(D, Hs + (size_t)(c * 2 + 1) * FN, tid);
#pragma unroll
    for (int i = 0; i < 2; ++i) { const int t0 = 8 * (tid + NTHR * i);
        float a[8], b[8], oa[8], ob[8]; hy_conv8(r2, t0, LX, bw0, bw1, bw2, bb, a); hy_conv8(r2 + LX, t0, LX, bw0, bw1, bw2, bb, b);
#pragma unroll
        for (int e = 0; e < 8; ++e) { const f32x2 cv = D[DI(t0 + e)]; oa[e] = a[e] * cv.x * inv; ob[e] = b[e] * cv.y * inv; }
        *(u32x4*)(hyoT + (size_t)c * MROWS + t0) = pack8(oa);
        *(u32x4*)(hyoT + (size_t)c * MROWS + LX + t0) = pack8(ob); }
    __syncthreads();
}

__device__ __forceinline__ void hy_ctx_conv(const LAS float* Gn, const LAS float* Yb, LAS float* Rb, int t0) {
    const LAS float* Gp = Gn + 255 + t0;
    float a0 = 0.f, a1 = 0.f, a2 = 0.f, a3 = 0.f, g0 = Gp[0], g1 = Gp[1], g2 = Gp[2], g3 = Gp[3];
#pragma unroll 4
    for (int s = 0; s < 256; ++s) {
        const float y = Yb[s];
        a0 += y * g0; a1 += y * g1; a2 += y * g2; a3 += y * g3;
        g3 = g2; g2 = g1; g1 = g0; g0 = Gp[-(s + 1)];
    }
    Rb[t0] = a0; Rb[t0 + 1] = a1; Rb[t0 + 2] = a2; Rb[t0 + 3] = a3;
}
__device__ __forceinline__ void hy_ctx_item(LAS unsigned char* lds, const bf16* uhyT, const float* cw, const float* cb, const float* hbias, const float* h2c  , const float* w3l, bf16* mix, int c, int tid, int wave, int lane) {
    LAS float* G = (LAS float*)lds + 4;
    LAS float* Y = G + 1024;
    LAS float* R = Y + 512;
    LAS f32x4* W3 = (LAS f32x4*)((LAS float*)lds + 2064);
    LAS float* red = (LAS float*)lds + 2064 + 256;
    __syncthreads();
    if (tid < 64) { const float* wr = w3l + (size_t)tid * 1024 + c; W3[tid] = (f32x4){wr[0], wr[256], wr[512], wr[768]}; }
    if (tid < 2) G[tid * 512 + 511] = 0.f;
    __syncthreads();
    const float delta = fabsf(-3.0701134573253946f + (float)c * ((-15.350567286626973f + 3.0701134573253946f) / 255.0f));
    float s0 = 0.f, s1 = 0.f;
    if (tid < 256) {
        const f32x4* hr = (const f32x4*)(h2c + (size_t)tid * 64);
        f32x4 acc = (f32x4){0.f, 0.f, 0.f, 0.f};
#pragma unroll
        for (int j4 = 0; j4 < 16; ++j4) { const f32x4 hv = hr[j4];
            acc += W3[4 * j4 + 0] * hv.x; acc += W3[4 * j4 + 1] * hv.y; acc += W3[4 * j4 + 2] * hv.z; acc += W3[4 * j4 + 3] * hv.w; }
        acc *= __expf(-((float)tid / 255.0f) * delta);
        G[255 + tid] = acc.x; G[512 + 255 + tid] = acc.y;
        if (tid >= 1) { G[255 - tid] = acc.z; G[512 + 255 - tid] = acc.w; }
        s0 = fabsf(acc.x) + (tid >= 1 ? fabsf(acc.z) : 0.f); s1 = fabsf(acc.y) + (tid >= 1 ? fabsf(acc.w) : 0.f);
    }
    block_sum2(s0, s1, red, wave, lane);
    const float n0 = 1.0f / s0, n1 = 1.0f / s1;
    const int b = tid >> 8, t = tid & 255;
    const bf16* rv = uhyT + (size_t)c * MROWS + MXR + b * LC; const bf16* r1 = uhyT + (size_t)(256 + c) * MROWS + MXR + b * LC; const bf16* r2 = uhyT + (size_t)(512 + c) * MROWS + MXR + b * LC;
    const float v = hy_conv3(rv, t, LC, cw[c], cw[768 + c], cw[1536 + c], cb[c]);
    const float g1 = hy_conv3(r1, t, LC, cw[256 + c], cw[768 + 256 + c], cw[1536 + 256 + c], cb[256 + c]);
    const float g2 = hy_conv3(r2, t, LC, cw[512 + c], cw[768 + 512 + c], cw[1536 + 512 + c], cb[512 + c]);
    Y[b * 256 + t] = v;
    __syncthreads();
    if (tid < 128) hy_ctx_conv(G, Y + (tid >> 6) * 256, R + (tid >> 6) * 256, 4 * (tid & 63));
    __syncthreads();
    const float y1 = g1 * (R[b * 256 + t] * n0 + v * hbias[c]);
    Y[b * 256 + t] = y1;
    __syncthreads();
    if (tid < 128) hy_ctx_conv(G + 512, Y + (tid >> 6) * 256, R + (tid >> 6) * 256, 4 * (tid & 63));
    __syncthreads();
    const float o = g2 * (R[b * 256 + t] * n1 + y1 * hbias[256 + c]);
    mix[(size_t)(MXR + b * LC + t) * DM + 256 + c] = (bf16)f2bf(o);
    __syncthreads();
}
typedef short s16x4 __attribute__((ext_vector_type(4)));
#define LBAR() do { asm volatile("s_waitcnt lgkmcnt(0)" ::: "memory"); __builtin_amdgcn_s_barrier(); asm volatile("" ::: "memory"); } while (0)
#define MFMA32(a, b, c) __builtin_amdgcn_mfma_f32_16x16x32_bf16((a), (b), (c), 0, 0, 0)
__device__ __forceinline__ bf16x8 frag16(const LAS bf16* p) { return *(const LAS bf16x8*)p; }
__device__ __forceinline__ bf16x8 frag2x8(const LAS bf16* p0, const LAS bf16* p1) { const s16x4 a = *(const LAS s16x4*)p0, b = *(const LAS s16x4*)p1; return __builtin_shufflevector(a, b, 0, 1, 2, 3, 4, 5, 6, 7); }
__device__ __forceinline__ bf16x8 pack_acc2(const f32x4 a, const f32x4 b) { u32x4 u; u.x = pk2(a[0], a[1]); u.y = pk2(a[2], a[3]); u.z = pk2(b[0], b[1]); u.w = pk2(b[2], b[3]); return __builtin_bit_cast(bf16x8, u); }

__device__ __forceinline__ void ssd_prepass(const bf16* uxs, const bf16* ubc, const float* cw  , const float* cb  , bf16* axt, bf16* abc, bf16* abt, int gw, int ngw, int lane) {
    const int wpc = ngw / 96;
    if (gw < wpc * 96) {
    const int cg = gw % 96, xcol = cg < 64 ? 8 * cg : 512 + 8 * (cg - 64);
    float tw0[8], tw1[8], tw2[8], tb[8];
#pragma unroll
    for (int j = 0; j < 8; ++j) { tw0[j] = cw[xcol + j]; tw1[j] = cw[1024 + xcol + j]; tw2[j] = cw[2048 + xcol + j]; tb[j] = cb[xcol + j]; }
#pragma unroll 2
    for (int C = gw / 96; C < 264; C += wpc) {
        const int row = 64 * C + lane;
        const int t = row < MXR ? (row & 8191) : ((row - MXR) & 255), len = row < MXR ? LX : LC;
        const bf16* src = cg < 64 ? uxs + (size_t)row * 512 + 8 * cg : ubc + (size_t)row * 512 + 8 * (cg - 64);
        const u32x4 u0 = *(const u32x4*)src;
        const u32x4 um = t > 0 ? *(const u32x4*)(src - 512) : (u32x4){0u, 0u, 0u, 0u};
        const u32x4 un = t < len - 1 ? *(const u32x4*)(src + 512) : (u32x4){0u, 0u, 0u, 0u};
        float a[8], c0[8], c2[8], o[8];
        cv_unpack(um, a); cv_unpack(u0, c0); cv_unpack(un, c2);
#pragma unroll
        for (int j = 0; j < 8; ++j) o[j] = siluf(tw0[j] * a[j] + tw1[j] * c0[j] + tw2[j] * c2[j] + tb[j]);
        bf16* dst = cg < 64 ? axt + ((size_t)(C * 8 + (cg >> 3)) * 64 + 8 * (cg & 7)) * 64 + lane : abt + ((size_t)(C * 2 + ((cg - 64) >> 4)) * 128 + 8 * ((cg - 64) & 15)) * 64 + lane;
#pragma unroll
        for (int j = 0; j < 8; ++j) dst[j * 64] = (bf16)f2bf(o[j]);
    }
    }
    {
        float w0[8], w1[8], w2[8], bi[8];
#pragma unroll
        for (int j = 0; j < 8; ++j) { const int xcol = 512 + 8 * lane + j; w0[j] = cw[xcol]; w1[j] = cw[1024 + xcol]; w2[j] = cw[2048 + xcol]; bi[j] = cb[xcol]; }
#pragma unroll 1
        for (int it = gw; it < MROWS / 16; it += ngw) {
            const int r0 = 16 * it;
            const int t0 = r0 < MXR ? (r0 & 8191) : ((r0 - MXR) & 255), len = r0 < MXR ? LX : LC;
            const bf16* src = ubc + (size_t)r0 * 512 + 8 * lane;
            u32x4 pm = t0 > 0 ? *(const u32x4*)(src - 512) : (u32x4){0u, 0u, 0u, 0u};
            u32x4 pc = *(const u32x4*)src;
#pragma unroll 4
            for (int i = 0; i < 16; ++i) {
                const u32x4 pn = (t0 + i < len - 1) ? *(const u32x4*)(src + (size_t)(i + 1) * 512) : (u32x4){0u, 0u, 0u, 0u};
                float a[8], c0[8], c2[8], o[8];
                cv_unpack(pm, a); cv_unpack(pc, c0); cv_unpack(pn, c2);
#pragma unroll
                for (int j = 0; j < 8; ++j) o[j] = siluf(w0[j] * a[j] + w1[j] * c0[j] + w2[j] * c2[j] + bi[j]);
                *(u32x4*)(abc + (size_t)(r0 + i) * 512 + 8 * lane) = pack8(o);
                pm = pc; pc = pn;
            }
        }
    }
}

struct SsdArgs {
    const bf16* axt; const bf16* abc; const bf16* abt; const bf16* uz; const float* udt; const float* dtb; const float* alog; const float* dvec;
    float* sst; float* dts; bf16* mix; float* ssq;
};
constexpr int XP = 72, BP = 136;

__device__ __forceinline__ void ssd_state_item(LAS unsigned char* lds, const SsdArgs& A, int b, int sc, int h, int tid, int wave, int lane) {
    LAS bf16* XsT = (LAS bf16*)lds;
    LAS bf16* BtT = XsT + 4 * 64 * XP;
    LAS float* wv = (LAS float*)(BtT + 4 * 128 * XP);
    LAS float* aend = wv + 512;
    const int g = h >> 2;
    const int row0 = sc == 32 ? MXR + b * LC : b * LX, tok0 = sc == 32 ? 0 : sc * 256;
    const int pt = wave & 3, half = wave >> 2, l15 = lane & 15, l4 = lane >> 4;
    const int Cg0 = (row0 + tok0) >> 6;
    u32x4 raw[4][3];
#pragma unroll
    for (int ci = 0; ci < 4; ++ci) {
        raw[ci][0] = *(const u32x4*)(A.axt + ((size_t)((Cg0 + ci) * 8 + h) * 64 + (tid >> 3)) * 64 + 8 * (tid & 7));
#pragma unroll
        for (int k = 0; k < 2; ++k) { const int e = tid + NTHR * k; raw[ci][1 + k] = *(const u32x4*)(A.abt + ((size_t)((Cg0 + ci) * 2 + g) * 128 + (e >> 3)) * 64 + 8 * (e & 7)); }
    }
    {
        const int dir = wave >> 2, ci = wave & 3, tok = dir ? 63 - lane : lane;
        const float rawv = A.udt[(size_t)(row0 + tok0 + 64 * ci + tok) * 16 + dir * 8 + h] + A.dtb[dir * 8 + h];
        const float dt = rawv > 20.f ? rawv : log1pf(__expf(rawv));
        float x = dt * (-__expf(A.alog[dir * 8 + h]));
#pragma unroll
        for (int off = 1; off < 64; off <<= 1) { const float y = __shfl_up(x, off); if (lane >= off) x += y; }
        const float ae = __shfl(x, 63);
        __syncthreads();
        wv[(dir * 4 + ci) * 64 + tok] = dt * __expf(ae - x);
        if (lane == 0) aend[dir * 4 + ci] = ae;
    }
#pragma unroll
    for (int ci = 0; ci < 4; ++ci) {
        *(LAS u32x4*)(XsT + (ci * 64 + (tid >> 3)) * XP + 8 * (tid & 7)) = raw[ci][0];
#pragma unroll
        for (int k = 0; k < 2; ++k) { const int e = tid + NTHR * k; *(LAS u32x4*)(BtT + (ci * 128 + (e >> 3)) * XP + 8 * (e & 7)) = raw[ci][1 + k]; }
    }
    __syncthreads();
#pragma unroll 1
    for (int dir = 0; dir < 2; ++dir) {
        f32x4 ST[4];
#pragma unroll
        for (int nt = 0; nt < 4; ++nt) ST[nt] = (f32x4){0.f, 0.f, 0.f, 0.f};
#pragma unroll 1
        for (int step = 0; step < 4; ++step) {
            const int ci = dir ? 3 - step : step;
            const float ea = __expf(aend[dir * 4 + ci]);
            bf16x8 xw[2];
#pragma unroll
            for (int kk = 0; kk < 2; ++kk) {
                const u32x4 xu = *(const LAS u32x4*)(XsT + (ci * 64 + 16 * pt + l15) * XP + 32 * kk + 8 * l4);
                const LAS float* wp = wv + (dir * 4 + ci) * 64 + 32 * kk + 8 * l4;
                const f32x4 w0 = *(const LAS f32x4*)wp, w1 = *(const LAS f32x4*)(wp + 4);
                u32x4 u; u.x = pk2(bflo(xu.x) * w0.x, bfhi(xu.x) * w0.y); u.y = pk2(bflo(xu.y) * w0.z, bfhi(xu.y) * w0.w); u.z = pk2(bflo(xu.z) * w1.x, bfhi(xu.z) * w1.y); u.w = pk2(bflo(xu.w) * w1.z, bfhi(xu.w) * w1.w);
                xw[kk] = __builtin_bit_cast(bf16x8, u);
            }
#pragma unroll
            for (int nt = 0; nt < 4; ++nt) {
                f32x4 acc = ST[nt] * ea;
                const LAS bf16* pa = BtT + (ci * 128 + 16 * (4 * half + nt) + l15) * XP + 8 * l4;
#pragma unroll
                for (int kk = 0; kk < 2; ++kk) acc = MFMA32(frag16(pa + 32 * kk), xw[kk], acc);
                ST[nt] = acc;
            }
        }
        float* slot = A.sst + ((size_t)(((b * 2 + dir) * 33 + sc) * 8 + h)) * 8192;
#pragma unroll
        for (int nt = 0; nt < 4; ++nt) *(f32x4*)(slot + (size_t)(16 * pt + l15) * 128 + 16 * (4 * half + nt) + 4 * l4) = ST[nt];
    }
    if (tid < 2) A.dts[((b * 2 + tid) * 33 + sc) * 8 + h] = __expf((aend[tid * 4] + aend[tid * 4 + 1]) + (aend[tid * 4 + 2] + aend[tid * 4 + 3]));
}

template <int MODE>
__device__ __forceinline__ void ssd_item(LAS unsigned char* lds, const SsdArgs& A, int b, int sc, int hp, int dir, int tid, int wave, int lane) {
    LAS bf16* Bt = (LAS bf16*)lds;
    LAS bf16* BtT = Bt + 64 * BP;
    LAS bf16* Ct = BtT + 128 * XP;
    LAS bf16* XsT0 = Ct + 64 * BP;
    LAS bf16* Mt0 = XsT0 + 2 * 64 * XP;
    LAS float* vec0 = (LAS float*)(Mt0 + 2 * 64 * XP);
    LAS float* SQ0 = vec0 + 2 * 272;
    const int hh = wave >> 2, pt = wave & 3, h = 2 * hp + hh, g = hp >> 1, l15 = lane & 15, l4 = lane >> 4;
    LAS bf16* XsT = XsT0 + hh * 64 * XP; LAS bf16* Mt = Mt0 + hh * 64 * XP;
    LAS float* dtv = vec0 + hh * 272, *acs = dtv + 64, *wv = dtv + 128, *eacs = dtv + 192, *misc = dtv + 256;
    LAS float* SQ = SQ0 + hh * 256;
    const int row0 = sc == 32 ? MXR + b * LC : b * LX, tok0 = sc == 32 ? 0 : sc * 256;
    const int Cg0 = (row0 + tok0) >> 6;
    const float* slot = A.sst + ((size_t)(((b * 2 + dir) * 33 + sc) * 8 + h)) * 8192;
    f32x4 ST[8];
#pragma unroll
    for (int nt = 0; nt < 8; ++nt) {
        if (sc == 32) ST[nt] = (f32x4){0.f, 0.f, 0.f, 0.f};
        else ST[nt] = *(const f32x4*)(slot + (size_t)(16 * pt + l15) * 128 + 16 * nt + 4 * l4);
    }
    const float a_h = -__expf(A.alog[dir * 8 + h]), dtb_h = A.dtb[dir * 8 + h], d_h = A.dvec[h];
    u32x4 raw[8]; float dtraw = 0.f;
#define SSD_ISSUE(ci) do { const int Cg = Cg0 + (ci); const size_t rb = (size_t)(row0 + tok0 + 64 * (ci)); \
        _Pragma("unroll") for (int k = 0; k < 2; ++k) { const int e = tid + NTHR * k; \
            raw[k] = *(const u32x4*)(A.axt + ((size_t)(Cg * 8 + 2 * hp + k) * 64 + (tid >> 3)) * 64 + 8 * (tid & 7)); \
            raw[2 + k] = *(const u32x4*)(A.abt + ((size_t)(Cg * 2 + g) * 128 + (e >> 3)) * 64 + 8 * (e & 7)); \
            raw[4 + k] = *(const u32x4*)(A.abc + (rb + (e >> 4)) * 512 + g * 128 + 8 * (e & 15)); \
            raw[6 + k] = *(const u32x4*)(A.abc + (rb + (e >> 4)) * 512 + 256 + g * 128 + 8 * (e & 15)); } \
        if (pt == 0) dtraw = A.udt[(rb + (dir ? 63 - lane : lane)) * 16 + dir * 8 + h]; } while (0)
    SSD_ISSUE(dir ? 3 : 0);
    __syncthreads();
#pragma unroll 1
    for (int i = 0; i < 4; ++i) {
        const int ci = dir ? 3 - i : i, tokc = tok0 + 64 * ci;
#pragma unroll
        for (int k = 0; k < 2; ++k) { const int e = tid + NTHR * k;
            *(LAS u32x4*)(XsT0 + (k * 64 + (tid >> 3)) * XP + 8 * (tid & 7)) = raw[k];
            *(LAS u32x4*)(BtT + (e >> 3) * XP + 8 * (e & 7)) = raw[2 + k];
            *(LAS u32x4*)(Bt + (e >> 4) * BP + 8 * (e & 15)) = raw[4 + k];
            *(LAS u32x4*)(Ct + (e >> 4) * BP + 8 * (e & 15)) = raw[6 + k]; }
        if (pt == 0) {
            const int tok = dir ? 63 - lane : lane;
            const float rawv = dtraw + dtb_h;
            const float dt = rawv > 20.f ? rawv : log1pf(__expf(rawv));
            float x = dt * a_h;
#pragma unroll
            for (int off = 1; off < 64; off <<= 1) { const float y = __shfl_up(x, off); if (lane >= off) x += y; }
            const float aend = __shfl(x, 63);
            dtv[tok] = dt; acs[tok] = x; wv[tok] = dt * __expf(aend - x); eacs[tok] = __expf(x);
            if (lane == 0) misc[0] = __expf(aend);
        }
        if (i < 3) SSD_ISSUE(dir ? 2 - i : i + 1);
        u32x2 pm_[4], pz_[4];
        if (MODE == 2) {
#pragma unroll
            for (int tt2 = 0; tt2 < 4; ++tt2) {
                const int t = tokc + 16 * tt2 + l15;
                pm_[tt2] = *(const u32x2*)(A.mix + (unsigned)((row0 + t) * DM + 512 + h * 64 + 16 * pt + 4 * l4));
                pz_[tt2] = *(const u32x2*)(A.uz + (unsigned)((row0 + t) * 512 + h * 64 + 16 * pt + 4 * l4));
            }
        }
        LBAR();
        {
            const int tt = wave >> 1;
#pragma unroll
            for (int j = 0; j < 2; ++j) {
                const int st = 2 * (wave & 1) + j;
                const bool live = dir ? st >= tt : st <= tt;
                f32x4 acc = (f32x4){0.f, 0.f, 0.f, 0.f};
                if (live) {
                    const LAS bf16* pa = Ct + (16 * tt + l15) * BP + 8 * l4; const LAS bf16* pb = Bt + (16 * st + l15) * BP + 8 * l4;
                    bf16x8 fa_[4], fb_[4];
#pragma unroll
                    for (int kk = 0; kk < 4; ++kk) { fa_[kk] = frag16(pa + 32 * kk); fb_[kk] = frag16(pb + 32 * kk); }
#pragma unroll
                    for (int kk = 0; kk < 4; ++kk) acc = MFMA32(fa_[kk], fb_[kk], acc);
                }
                const int sI = 16 * st + l15;
#pragma unroll
                for (int q = 0; q < 2; ++q) {
                    const LAS float* dq = vec0 + q * 272; const float as = dq[64 + sI], ds = dq[sI];
#pragma unroll
                    for (int r = 0; r < 4; ++r) { const int tI = 16 * tt + 4 * l4 + r;
                        const bool ok = live && (dir ? sI >= tI : sI <= tI);
                        Mt0[(q * 64 + tI) * XP + sI] = (bf16)f2bf(ok ? acc[r] * __expf(dq[64 + tI] - as) * ds : 0.f); }
                }
            }
            LBAR();
            bf16x8 STf[4];
#pragma unroll
            for (int m = 0; m < 4; ++m) STf[m] = pack_acc2(ST[2 * m], ST[2 * m + 1]);
            const bf16x8 xf0 = frag16(XsT + (16 * pt + l15) * XP + 8 * l4), xf1 = frag16(XsT + (16 * pt + l15) * XP + 32 + 8 * l4);
#pragma unroll
            for (int tt2 = 0; tt2 < 4; ++tt2) {
                const int tI = 16 * tt2 + l15;
                f32x4 accS = (f32x4){0.f, 0.f, 0.f, 0.f}, accI = (f32x4){0.f, 0.f, 0.f, 0.f};
                bf16x8 cf_[4]; const bf16x8 mf0 = frag16(Mt + tI * XP + 8 * l4), mf1 = frag16(Mt + tI * XP + 32 + 8 * l4);
#pragma unroll
                for (int m = 0; m < 4; ++m) { const LAS bf16* pc = Ct + tI * BP + 32 * m + 4 * l4; cf_[m] = frag2x8(pc, pc + 16); }
#pragma unroll
                for (int m = 0; m < 4; ++m) accS = MFMA32(STf[m], cf_[m], accS);
                if (dir ? (1 >= tt2) : true) accI = MFMA32(xf0, mf0, accI);
                if (dir ? true : (2 <= tt2)) accI = MFMA32(xf1, mf1, accI);
                f32x4 yv = accI + accS * eacs[tI];
                const int t = tokc + tI;
                bf16* mp = A.mix + (unsigned)((row0 + t) * DM + 512 + h * 64 + 16 * pt + 4 * l4);
                if (MODE == 2) {
                    const LAS bf16* xp = XsT + (16 * pt + 4 * l4) * XP + tI;
                    yv[0] = (yv[0] + bflo(pm_[tt2].x) + d_h * bf2f(xp[0])) * siluf(bflo(pz_[tt2].x)); yv[1] = (yv[1] + bfhi(pm_[tt2].x) + d_h * bf2f(xp[XP])) * siluf(bfhi(pz_[tt2].x));
                    yv[2] = (yv[2] + bflo(pm_[tt2].y) + d_h * bf2f(xp[2 * XP])) * siluf(bflo(pz_[tt2].y)); yv[3] = (yv[3] + bfhi(pm_[tt2].y) + d_h * bf2f(xp[3 * XP])) * siluf(bfhi(pz_[tt2].y));
                    float qq = (yv[0] * yv[0] + yv[1] * yv[1]) + (yv[2] * yv[2] + yv[3] * yv[3]);
                    qq += __shfl_xor(qq, 16); qq += __shfl_xor(qq, 32);
                    if (l4 == 0) SQ[pt * 64 + tI] = qq;
                }
                u32x2 o; o.x = pk2(yv[0], yv[1]); o.y = pk2(yv[2], yv[3]);
                *(u32x2*)mp = o;
            }
        }
        {
            const float ea = misc[0];
            bf16x8 xw[2];
#pragma unroll
            for (int kk = 0; kk < 2; ++kk) {
                const u32x4 xu = *(const LAS u32x4*)(XsT + (16 * pt + l15) * XP + 32 * kk + 8 * l4);
                const f32x4 w0 = *(const LAS f32x4*)(wv + 32 * kk + 8 * l4), w1 = *(const LAS f32x4*)(wv + 32 * kk + 8 * l4 + 4);
                u32x4 u; u.x = pk2(bflo(xu.x) * w0.x, bfhi(xu.x) * w0.y); u.y = pk2(bflo(xu.y) * w0.z, bfhi(xu.y) * w0.w); u.z = pk2(bflo(xu.z) * w1.x, bfhi(xu.z) * w1.y); u.w = pk2(bflo(xu.w) * w1.z, bfhi(xu.w) * w1.w);
                xw[kk] = __builtin_bit_cast(bf16x8, u);
            }
            bf16x8 af_[8][2];
#pragma unroll
            for (int nt = 0; nt < 8; ++nt) { const LAS bf16* pa = BtT + (16 * nt + l15) * XP + 8 * l4; af_[nt][0] = frag16(pa); af_[nt][1] = frag16(pa + 32); }
#pragma unroll
            for (int nt = 0; nt < 8; ++nt) ST[nt] = MFMA32(af_[nt][1], xw[1], MFMA32(af_[nt][0], xw[0], ST[nt] * ea));
        }
        LBAR();
        if (MODE == 2 && tid < 128) { const int q = tid >> 6, tI = tid & 63; const LAS float* sq = SQ0 + q * 256 + tI;
            A.ssq[(size_t)(row0 + tokc + tI) * 8 + 2 * hp + q] = (sq[0] + sq[64]) + (sq[128] + sq[192]); }
    }
#undef SSD_ISSUE
    __syncthreads();
}

struct HgArgs {
    const bf16* uhg; const float* lb0; const float* lb1; const float* normg; int layer;
    float* hst; float* dth; bf16* mix;
};
constexpr int HP = 72, PP = 40, HG_LDS_BYTES = (3 * 32 * HP + 2 * 64 * PP + 32 * PP) * 2 + (256 + 64 + 128 + 32) * 4;
template <int MODE>
__device__ __forceinline__ void hg_item(LAS unsigned char* lds, const HgArgs& A, int b, int sc, int hp, int dir, int tid, int lane) {
    const int hgp = tid >> 8, tg = tid & 255, hw = (tid >> 6) & 3, h = 2 * hp + hgp;
    LAS bf16* Qt = (LAS bf16*)(lds + hgp * HG_LDS_BYTES);
    LAS bf16* Kt = Qt + 32 * HP;
    LAS bf16* Qh = Kt + 32 * HP;
    LAS bf16* KhT = Qh + 32 * HP;
    LAS bf16* VtT = KhT + 64 * PP;
    LAS bf16* Pm = VtT + 64 * PP;
    LAS float* tot = (LAS float*)(Pm + 32 * PP);
    LAS float* ebend = tot + 256;
    LAS float* SQ = ebend + 64;
    LAS float* rstd = SQ + 128;
    const int row0 = sc == 32 ? MXR + b * LC : b * LX, tok0 = sc == 32 ? 0 : sc * 256;
    const int l15 = lane & 15, l4 = lane >> 4, vt = hw;
    float* slot = A.hst + ((size_t)(((b * 2 + dir) * 33 + sc) * 4 + h)) * 4096;
    f32x4 S[4];
#pragma unroll
    for (int kt = 0; kt < 4; ++kt) {
        if (MODE == 0 || sc == 32) S[kt] = (f32x4){0.f, 0.f, 0.f, 0.f};
        else S[kt] = *(const f32x4*)(slot + (size_t)(16 * vt + l15) * 64 + 16 * kt + 4 * l4);
    }
    const int tau = tg >> 3, kg = tg & 7;
    float lbv[8], sumb[8];
#pragma unroll
    for (int j = 0; j < 8; ++j) { const int k = h * 64 + 8 * kg + j; lbv[j] = A.layer == 0 ? 0.f : sigmf(A.lb1[k] - A.lb0[k]); sumb[j] = 0.f; }
    u32x4 qv, fv, vv;
#define HG_ISSUE(ci) do { const int s_ = 32 * (ci) + tau, t_ = dir ? tok0 + 255 - s_ : tok0 + s_; \
        const bf16* up_ = A.uhg + (size_t)(row0 + t_) * 1280 + h * 64 + 8 * kg; \
        qv = *(const u32x4*)up_; fv = *(const u32x4*)(up_ + 256 + dir * 256); vv = *(const u32x4*)(up_ + 768); } while (0)
    HG_ISSUE(0);
    __syncthreads();
#pragma unroll 1
    for (int i = 0; i < 8; ++i) {
        float q[8], f[8], v[8], kk[8], bb[8];
        q[0] = bflo(qv.x); q[1] = bfhi(qv.x); q[2] = bflo(qv.y); q[3] = bfhi(qv.y); q[4] = bflo(qv.z); q[5] = bfhi(qv.z); q[6] = bflo(qv.w); q[7] = bfhi(qv.w);
        f[0] = bflo(fv.x); f[1] = bfhi(fv.x); f[2] = bflo(fv.y); f[3] = bfhi(fv.y); f[4] = bflo(fv.z); f[5] = bfhi(fv.z); f[6] = bflo(fv.w); f[7] = bfhi(fv.w);
        v[0] = bflo(vv.x); v[1] = bfhi(vv.x); v[2] = bflo(vv.y); v[3] = bfhi(vv.y); v[4] = bflo(vv.z); v[5] = bfhi(vv.z); v[6] = bflo(vv.w); v[7] = bfhi(vv.w);
        if (i < 7) HG_ISSUE(i + 1);
#pragma unroll
        for (int j = 0; j < 8; ++j) {
            const float sg = sigmf(f[j]);
            const float fj = lbv[j] + (1.0f - lbv[j]) * sg;
            kk[j] = (1.0f - lbv[j]) * (1.0f - sg);
            float x = lbv[j] == 0.f ? fminf(f[j], 0.f) - __logf(1.0f + __expf(-fabsf(f[j]))) : __logf(fj);
#pragma unroll
            for (int off = 8; off < 64; off <<= 1) { const float y = __shfl_up(x, off); if (lane >= off) x += y; }
            bb[j] = x;
        }
        if (lane >= 56) {
#pragma unroll
            for (int j = 0; j < 8; ++j) tot[hw * 64 + 8 * kg + j] = bb[j];
        }
        LBAR();
        {
            float oq[8], ok[8], oh[8];
#pragma unroll
            for (int j = 0; j < 8; ++j) {
                const int k = 8 * kg + j;
                const float t0 = tot[k], t1 = tot[64 + k], t2 = tot[128 + k], t3 = tot[192 + k];
                const float off = hw == 0 ? 0.f : (hw == 1 ? t0 : (hw == 2 ? t0 + t1 : t0 + t1 + t2));
                const float bj = bb[j] + off, bmid = t0 + t1, bend = (t0 + t1) + (t2 + t3);
                oq[j] = q[j] * 0.125f * __expf(bj - bmid); ok[j] = kk[j] * __expf(bmid - bj); oh[j] = q[j] * 0.125f * __expf(bj);
                KhT[k * PP + tau] = (bf16)f2bf(kk[j] * __expf(bend - bj)); VtT[k * PP + tau] = (bf16)f2bf(v[j]);
                if (tau == 0) { ebend[k] = __expf(bend); sumb[j] += bend; }
            }
            if (MODE != 0) { *(LAS u32x4*)(Qt + tau * HP + 8 * kg) = pack8(oq); *(LAS u32x4*)(Kt + tau * HP + 8 * kg) = pack8(ok); *(LAS u32x4*)(Qh + tau * HP + 8 * kg) = pack8(oh); }
        }
        LBAR();
        u32x2 pv_[2], gz[2];
        if (MODE == 2) {
#pragma unroll
            for (int tt = 0; tt < 2; ++tt) { const int tI = 16 * tt + l15, s2 = 32 * i + tI, t2 = dir ? tok0 + 255 - s2 : tok0 + s2;
                pv_[tt] = *(const u32x2*)(A.mix + (unsigned)((row0 + t2) * DM + h * 64 + 16 * vt + 4 * l4));
                gz[tt] = *(const u32x2*)(A.uhg + (unsigned)((row0 + t2) * 1280 + 1024 + h * 64 + 16 * vt + 4 * l4)); }
        }
        if (MODE != 0) {
            {
                const int tt = hw >> 1, st = hw & 1;
                f32x4 acc = (f32x4){0.f, 0.f, 0.f, 0.f};
                if (st <= tt) {
                    const LAS bf16* pa = Qt + (16 * tt + l15) * HP + 8 * l4; const LAS bf16* pb = Kt + (16 * st + l15) * HP + 8 * l4;
                    acc = MFMA32(frag16(pa), frag16(pb), acc); acc = MFMA32(frag16(pa + 32), frag16(pb + 32), acc);
                }
#pragma unroll
                for (int r = 0; r < 4; ++r) { const int tI = 16 * tt + 4 * l4 + r, sI = 16 * st + l15; Pm[tI * PP + sI] = (bf16)f2bf((st <= tt && sI <= tI) ? acc[r] : 0.f); }
            }
            LBAR();
            bf16x8 Sf[2];
#pragma unroll
            for (int m = 0; m < 2; ++m) Sf[m] = pack_acc2(S[2 * m], S[2 * m + 1]);
            const bf16x8 vf = frag16(VtT + (16 * vt + l15) * PP + 8 * l4);
            f32x4 oacc[2];
#pragma unroll
            for (int tt = 0; tt < 2; ++tt) {
                f32x4 acc = (f32x4){0.f, 0.f, 0.f, 0.f};
                acc = MFMA32(vf, frag16(Pm + (16 * tt + l15) * PP + 8 * l4), acc);
#pragma unroll
                for (int m = 0; m < 2; ++m) { const LAS bf16* pq = Qh + (16 * tt + l15) * HP + 32 * m + 4 * l4;
                    acc = MFMA32(Sf[m], frag2x8(pq, pq + 16), acc); }
                oacc[tt] = acc;
            }
            if (MODE == 1) {
#pragma unroll
                for (int tt = 0; tt < 2; ++tt) { const int tI = 16 * tt + l15, s2 = 32 * i + tI, t2 = dir ? tok0 + 255 - s2 : tok0 + s2;
                    u32x2 o; o.x = pk2(oacc[tt][0], oacc[tt][1]); o.y = pk2(oacc[tt][2], oacc[tt][3]);
                    *(u32x2*)(A.mix + (unsigned)((row0 + t2) * DM + h * 64 + 16 * vt + 4 * l4)) = o; }
            } else {
#pragma unroll
                for (int tt = 0; tt < 2; ++tt) { const int tI = 16 * tt + l15; const u32x2 pv = pv_[tt];
                    oacc[tt][0] += bflo(pv.x); oacc[tt][1] += bfhi(pv.x); oacc[tt][2] += bflo(pv.y); oacc[tt][3] += bfhi(pv.y);
                    float qq = (oacc[tt][0] * oacc[tt][0] + oacc[tt][1] * oacc[tt][1]) + (oacc[tt][2] * oacc[tt][2] + oacc[tt][3] * oacc[tt][3]);
                    qq += __shfl_xor(qq, 16); qq += __shfl_xor(qq, 32);
                    if (l4 == 0) SQ[vt * 32 + tI] = qq; }
                LBAR();
                const f32x4 ng = *(const f32x4*)(A.normg + h * 64 + 16 * vt + 4 * l4);
#pragma unroll
                for (int tt = 0; tt < 2; ++tt) { const int tI = 16 * tt + l15, s2 = 32 * i + tI, t2 = dir ? tok0 + 255 - s2 : tok0 + s2;
                    const float rs = 1.0f / sqrtf(((SQ[tI] + SQ[32 + tI]) + (SQ[64 + tI] + SQ[96 + tI])) * (1.0f / 64.0f) + EPS);
                    u32x2 o; o.x = pk2(oacc[tt][0] * rs * ng.x * siluf(bflo(gz[tt].x)), oacc[tt][1] * rs * ng.y * siluf(bfhi(gz[tt].x)));
                    o.y = pk2(oacc[tt][2] * rs * ng.z * siluf(bflo(gz[tt].y)), oacc[tt][3] * rs * ng.w * siluf(bfhi(gz[tt].y)));
                    *(u32x2*)(A.mix + (unsigned)((row0 + t2) * DM + h * 64 + 16 * vt + 4 * l4)) = o; }
            }
        }
        {
            const bf16x8 vf2 = frag16(VtT + (16 * vt + l15) * PP + 8 * l4);
#pragma unroll
            for (int kt = 0; kt < 4; ++kt) {
                f32x4 acc;
#pragma unroll
                for (int r = 0; r < 4; ++r) acc[r] = S[kt][r] * ebend[16 * kt + 4 * l4 + r];
                S[kt] = MFMA32(frag16(KhT + (16 * kt + l15) * PP + 8 * l4), vf2, acc);
            }
        }
        LBAR();
    }
#undef HG_ISSUE
    if (MODE == 0) {
#pragma unroll
        for (int kt = 0; kt < 4; ++kt) *(f32x4*)(slot + (size_t)(16 * vt + l15) * 64 + 16 * kt + 4 * l4) = S[kt];
        if (tau == 0) {
#pragma unroll
            for (int j = 0; j < 8; ++j) A.dth[((size_t)(((b * 2 + dir) * 33 + sc) * 4 + h)) * 64 + 8 * kg + j] = __expf(sumb[j]);
        }
    }
    __syncthreads();
}


constexpr int SP = 264;
__device__ __forceinline__ void hg_state_item(LAS unsigned char* lds, const HgArgs& A, int b, int sc, int h, int tid, int wave, int lane) {
    LAS bf16* KfT = (LAS bf16*)lds;
    LAS bf16* KbT = KfT + 64 * SP;
    LAS bf16* VtT = KbT + 64 * SP;
    const int row0 = sc == 32 ? MXR + b * LC : b * LX, tok0 = sc == 32 ? 0 : sc * 256;
    const int kg = wave, l15 = lane & 15, l4 = lane >> 4;
    u32x4 fa[4], fb[4], va[4];
#pragma unroll
    for (int e = 0; e < 4; ++e) { const bf16* up = A.uhg + (size_t)(row0 + tok0 + 4 * lane + e) * 1280 + h * 64 + 8 * kg;
        fa[e] = *(const u32x4*)(up + 256); fb[e] = *(const u32x4*)(up + 512); va[e] = *(const u32x4*)(up + 768); }
    float lbv[8];
#pragma unroll
    for (int j = 0; j < 8; ++j) { const int k = h * 64 + 8 * kg + j; lbv[j] = A.layer == 0 ? 0.f : sigmf(A.lb1[k] - A.lb0[k]); }
    __syncthreads();
#pragma unroll
    for (int dir = 0; dir < 2; ++dir) {
        float lf[4][8], kk[4][8];
#pragma unroll
        for (int e = 0; e < 4; ++e) { float f[8]; cv_unpack(dir ? fb[e] : fa[e], f);
#pragma unroll
            for (int j = 0; j < 8; ++j) { const float sg = sigmf(f[j]); kk[e][j] = (1.0f - lbv[j]) * (1.0f - sg);
                lf[e][j] = lbv[j] == 0.f ? fminf(f[j], 0.f) - __logf(1.0f + __expf(-fabsf(f[j]))) : __logf(lbv[j] + (1.0f - lbv[j]) * sg); } }
#pragma unroll
        for (int j = 0; j < 8; ++j) {
            const float tsum = (lf[0][j] + lf[1][j]) + (lf[2][j] + lf[3][j]);
            float x = tsum;
            if (!dir) {
#pragma unroll
                for (int off = 1; off < 64; off <<= 1) { const float y = __shfl_up(x, off); if (lane >= off) x += y; }
            } else {
#pragma unroll
                for (int off = 1; off < 64; off <<= 1) { const float y = __shfl_down(x, off); if (lane + off < 64) x += y; }
            }
            const float total = __shfl(x, dir ? 0 : 63);
            const float rest = total - x;
            float aft[4];
            if (!dir) { aft[3] = rest; aft[2] = aft[3] + lf[3][j]; aft[1] = aft[2] + lf[2][j]; aft[0] = aft[1] + lf[1][j]; }
            else { aft[0] = rest; aft[1] = aft[0] + lf[0][j]; aft[2] = aft[1] + lf[1][j]; aft[3] = aft[2] + lf[2][j]; }
            LAS bf16* d = (dir ? KbT : KfT) + (8 * kg + j) * SP + 4 * lane;
            u32x2 o; o.x = pk2(kk[0][j] * __expf(aft[0]), kk[1][j] * __expf(aft[1])); o.y = pk2(kk[2][j] * __expf(aft[2]), kk[3][j] * __expf(aft[3]));
            *(LAS u32x2*)d = o;
            if (lane == 0) A.dth[((size_t)(((b * 2 + dir) * 33 + sc) * 4 + h)) * 64 + 8 * kg + j] = __expf(total);
        }
    }
    {
        float v[4][8];
#pragma unroll
        for (int e = 0; e < 4; ++e) cv_unpack(va[e], v[e]);
#pragma unroll
        for (int j = 0; j < 8; ++j) { u32x2 o; o.x = pk2(v[0][j], v[1][j]); o.y = pk2(v[2][j], v[3][j]); *(LAS u32x2*)(VtT + (8 * kg + j) * SP + 4 * lane) = o; }
    }
    __syncthreads();
    const int kt = wave & 3, vt0 = 2 * (wave >> 2);
#pragma unroll
    for (int dir = 0; dir < 2; ++dir) {
        f32x4 S0 = (f32x4){0.f, 0.f, 0.f, 0.f}, S1 = S0;
        const LAS bf16* pa = (dir ? KbT : KfT) + (16 * kt + l15) * SP + 8 * l4;
        const LAS bf16* pb0 = VtT + (16 * vt0 + l15) * SP + 8 * l4; const LAS bf16* pb1 = pb0 + 16 * SP;
#pragma unroll
        for (int kk8 = 0; kk8 < 8; ++kk8) { const bf16x8 af = frag16(pa + 32 * kk8); S0 = MFMA32(af, frag16(pb0 + 32 * kk8), S0); S1 = MFMA32(af, frag16(pb1 + 32 * kk8), S1); }
        float* slot = A.hst + ((size_t)(((b * 2 + dir) * 33 + sc) * 4 + h)) * 4096;
        *(f32x4*)(slot + (size_t)(16 * vt0 + l15) * 64 + 16 * kt + 4 * l4) = S0;
        *(f32x4*)(slot + (size_t)(16 * (vt0 + 1) + l15) * 64 + 16 * kt + 4 * l4) = S1;
    }
}
__device__ __forceinline__ void state_scan(float* sst, const float* dts, float* hst, const float* dth, int gid) {
    if (gid < 65536) {
        const int bd = gid >> 14, e = gid & 16383, h = e >> 11, dir = bd & 1;
        float* base = sst + ((size_t)(bd * 33) * 8 + h) * 8192 + (size_t)(e & 2047) * 4;
        f32x4 carry = *(const f32x4*)(base + (size_t)32 * 8 * 8192);
        float* p = base + (size_t)(dir ? 31 : 0) * 8 * 8192; const long pstep = dir ? -(long)(8 * 8192) : (long)(8 * 8192);
        const float* dp = dts + (bd * 33 + (dir ? 31 : 0)) * 8 + h; const int dstep = dir ? -8 : 8;
#pragma unroll 4
        for (int jj = 0; jj < 32; ++jj) {
            const f32x4 loc = *(const f32x4*)p; *(f32x4*)p = carry;
            carry = carry * (*dp) + loc; p += pstep; dp += dstep; }
    } else if (gid < 65536 + 16384) {
        const int g2 = gid - 65536, bd = g2 >> 12, e = g2 & 4095, h = e >> 10, dir = bd & 1, k0 = (e & 15) * 4;
        float* base = hst + ((size_t)(bd * 33) * 4 + h) * 4096 + (size_t)(e & 1023) * 4;
        f32x4 carry = *(const f32x4*)(base + (size_t)32 * 4 * 4096);
        float* p = base + (size_t)(dir ? 31 : 0) * 4 * 4096; const long pstep = dir ? -(long)(4 * 4096) : (long)(4 * 4096);
        const float* dp = dth + ((size_t)((bd * 33 + (dir ? 31 : 0)) * 4 + h)) * 64 + k0; const int dstep = dir ? -256 : 256;
#pragma unroll 4
        for (int jj = 0; jj < 32; ++jj) {
            const f32x4 loc = *(const f32x4*)p; *(f32x4*)p = carry;
            const f32x4 d = *(const f32x4*)dp;
            carry = carry * d + loc; p += pstep; dp += dstep; }
    }
}

__device__ __forceinline__ void mf_hy_tile(LAS unsigned char* lds, const bf16* hyoT, bf16* mix, int tile, int tid) {
    LAS bf16* T = (LAS bf16*)lds;
    __syncthreads();
    { const int ch = tid >> 1, hf = tid & 1; const u32x4* src = (const u32x4*)(hyoT + (size_t)ch * MROWS + tile * 64 + hf * 32);
#pragma unroll
      for (int j = 0; j < 4; ++j) *(LAS u32x4*)(T + ch * 72 + hf * 32 + 8 * j) = src[j]; }
    __syncthreads();
    { const int tok = tid >> 3, cgp = tid & 7;
      bf16* dst = mix + (size_t)(tile * 64 + tok) * DM + 256 + cgp * 32;
#pragma unroll
      for (int j = 0; j < 4; ++j) { u32x4 o;
          unsigned w[4];
#pragma unroll
          for (int e = 0; e < 4; ++e) { const int c0 = cgp * 32 + 8 * j + 2 * e; w[e] = (unsigned)T[c0 * 72 + tok] | ((unsigned)T[(c0 + 1) * 72 + tok] << 16); }
          o.x = w[0]; o.y = w[1]; o.z = w[2]; o.w = w[3];
          *(u32x4*)(dst + 8 * j) = o; } }
    __syncthreads();
}
__device__ __forceinline__ void mf_ssd_rows(bf16* mix, const float* ssq, const float* ng, int row_first, int nrows, int gw, int ngw, int lane) {
    const f32x4 g0 = *(const f32x4*)(ng + 8 * lane), g1 = *(const f32x4*)(ng + 8 * lane + 4);
    const int grp = lane >> 5;
#pragma unroll 1
    for (int m = row_first + gw; m < row_first + nrows; m += ngw) {
        const f32x4 q = *(const f32x4*)(ssq + (size_t)m * 8 + 4 * grp);
        const float r = 1.0f / sqrtf(((q.x + q.y) + (q.z + q.w)) * (1.0f / 256.0f) + EPS);
        bf16* p = mix + (size_t)m * DM + 512 + 8 * lane;
        const u32x4 v = *(const u32x4*)p; u32x4 o;
        o.x = pk2(bflo(v.x) * r * g0.x, bfhi(v.x) * r * g0.y); o.y = pk2(bflo(v.y) * r * g0.z, bfhi(v.y) * r * g0.w);
        o.z = pk2(bflo(v.z) * r * g1.x, bfhi(v.z) * r * g1.y); o.w = pk2(bflo(v.w) * r * g1.z, bfhi(v.w) * r * g1.w);
        *(u32x4*)p = o;
    }
}
__device__ __forceinline__ void mf_ctx_rows(const bf16* mix, const float* ssq, const float* ng, int row_first, bf16* priv, int wave, int lane) {
    const f32x4 g0 = *(const f32x4*)(ng + 8 * lane), g1 = *(const f32x4*)(ng + 8 * lane + 4);
    const int grp = lane >> 5;
#pragma unroll 2
    for (int i = wave; i < 256; i += NWAVES) {
        const int m = row_first + i;
        const f32x4 q = *(const f32x4*)(ssq + (size_t)m * 8 + 4 * grp);
        const float r = 1.0f / sqrtf(((q.x + q.y) + (q.z + q.w)) * (1.0f / 256.0f) + EPS);
        const u32x4 lo = *(const u32x4*)(mix + (size_t)m * DM + 8 * lane);
        const u32x4 v = *(const u32x4*)(mix + (size_t)m * DM + 512 + 8 * lane); u32x4 o;
        o.x = pk2(bflo(v.x) * r * g0.x, bfhi(v.x) * r * g0.y); o.y = pk2(bflo(v.y) * r * g0.z, bfhi(v.y) * r * g0.w);
        o.z = pk2(bflo(v.z) * r * g1.x, bfhi(v.z) * r * g1.y); o.w = pk2(bflo(v.w) * r * g1.z, bfhi(v.w) * r * g1.w);
        *(u32x4*)(priv + (size_t)i * DM + 8 * lane) = lo;
        *(u32x4*)(priv + (size_t)i * DM + 512 + 8 * lane) = o;
    }
}
#ifndef MK_PER_PHASE
#define MK_PER_PHASE 0
#endif
#ifndef SPLITK_CTX
#define SPLITK_CTX 1
#endif
constexpr int PH_PER_LAYER = 13, NPHASES = 1 + 2 * PH_PER_LAYER + 1;
struct Args { const float* in[34]; float* out; unsigned char* ws; int ph_lo, ph_hi; };

__global__ void __launch_bounds__(NTHR, 2) hybrid_fwd(Args args) {
    extern __shared__ __attribute__((aligned(16))) unsigned char lds_raw[];
    LAS unsigned char* lds = (LAS unsigned char*)lds_raw;
    volatile LAS unsigned* MISC = (volatile LAS unsigned*)(lds + MISC_OFF);
    const int tid0 = threadIdx.x;
    const int G = gridDim.x, bid = blockIdx.x;
    const int ngw = G * NWAVES, ngt = G * NTHR;
    unsigned char* ws = args.ws;
    for (int u = tid0; u < 32; u += NTHR) MISC[u] = 0u;
    __syncthreads();
    XcdBarrier bar; bar.bar = (unsigned*)(ws + WS_CTL) + CW_BAR; bar.x = 0; bar.st = nullptr;
    if (!MK_PER_PHASE) bar = xcd_barrier_post((unsigned*)(ws + WS_CTL) + CW_BAR, MISC + 8);
    const int lo = args.ph_lo, hi = args.ph_hi;
#ifndef PHMASK
#define PHMASK 0xFFFF
#endif
#define ENA(b) (((PHMASK) >> (b)) & 1)
#ifndef SUBMASK
#define SUBMASK 0xFF
#endif
#define SUB(b) (((SUBMASK) >> (b)) & 1)
#define IN(k) (lo <= (k) && (k) < hi)
#ifndef TIME_MASK
#define TIME_MASK 0u
#endif
#ifndef TIME_MULT
#define TIME_MULT 8
#endif
#ifndef TIME_KIND
#define TIME_KIND 0
#endif
    unsigned long long tsum = 0ull, tbeg = 0ull;
#define SEAM(k) do { if (IN(k) && IN((k) + 1)) xcd_barrier(bar); if (TIME_MASK) { const unsigned long long tnow = __builtin_amdgcn_s_memrealtime(); if ((TIME_MASK >> (k)) & 1u) tsum += tnow - tbeg; tbeg = tnow; } } while (0)
#define NEXT_ITEM(qidx) ({ __syncthreads(); if (tid0 == 0) MISC[16] = __hip_atomic_fetch_add((unsigned*)(ws + WS_CTL) + 8192 + 64 * (qidx), 1u, __ATOMIC_RELAXED, __HIP_MEMORY_SCOPE_AGENT); __syncthreads(); (int)MISC[16]; })
#define FRESH_IDS() int tid_ = tid0; asm volatile("" : "+v"(tid_)); const int tid = tid_, lane = tid & 63, wave = __builtin_amdgcn_readfirstlane(tid >> 6); const int gw = bid * NWAVES + wave, gtid = bid * NTHR + tid; LAS float* wscr = (LAS float*)(lds + wave * 16384); (void)lane; (void)gw; (void)gtid; (void)wscr

    const float* x_in = args.in[0]; const float* c_in = args.in[1]; const float* ctx_in = args.in[2]; const float* cctx_in = args.in[3];
    const float* w_ada = args.in[4]; const float* b_ada = args.in[5]; const float* norm1_g = args.in[6]; const float* norm2_g = args.in[7];
    const float* w_in = args.in[8]; const float* w_out = args.in[9]; const float* hg_lb = args.in[10]; const float* hg_norm_g = args.in[11];
    const float* hy_conv_w = args.in[12]; const float* hy_conv_b = args.in[13]; const float* hy_w1 = args.in[14]; const float* hy_b1 = args.in[15]; const float* hy_f1 = args.in[16];
    const float* hy_w2 = args.in[17]; const float* hy_b2 = args.in[18]; const float* hy_f2 = args.in[19]; const float* hy_w3 = args.in[20]; const float* hy_bias = args.in[21];
    const float* ssd_conv_w = args.in[22]; const float* ssd_conv_b = args.in[23]; const float* ssd_dt_bias = args.in[24]; const float* ssd_a_log = args.in[25]; const float* ssd_d = args.in[26];
    const float* ssd_norm_g = args.in[27]; const float* ffn_w_gate = args.in[28]; const float* ffn_w_up = args.in[29]; const float* ffn_conv_w = args.in[30]; const float* ffn_conv_b = args.in[31];
    const float* ffn_w_down = args.in[32]; const float* final_norm_g = args.in[33];
    float* xs_out = args.out;
    float* mods = (float*)(ws + WS_MODS); float* ctxs = (float*)(ws + WS_CTXS); bf16* h2b = (bf16*)(ws + WS_H2); float* h2c = (float*)(ws + WS_H2C);
    float* ssq = (float*)(ws + WS_SSQ); float* dts = (float*)(ws + WS_DTS); float* dth = (float*)(ws + WS_DTH); float* udt = (float*)(ws + WS_UDT);
    bf16* Win = (bf16*)(ws + WS_WIN); bf16* Wout = (bf16*)(ws + WS_WOUT); bf16* hn = (bf16*)(ws + WS_HN); unsigned* Hs = (unsigned*)(ws + WS_HN);
    bf16* uhg = (bf16*)(ws + WS_UHG); bf16* uhyT = (bf16*)(ws + WS_UHY); bf16* uz = (bf16*)(ws + WS_UZ); bf16* uxs = (bf16*)(ws + WS_UXS); bf16* ubc = (bf16*)(ws + WS_UBC); bf16* axt = (bf16*)(ws + WS_AXT); bf16* abc = (bf16*)(ws + WS_ABC); bf16* abt = (bf16*)(ws + WS_ABT); float* sst = (float*)(ws + WS_SST); float* hst = (float*)(ws + WS_HST);
    float* slabO = (float*)(ws + WS_UHG); float* slabF = (float*)(ws + WS_A);
    bf16* mix = (bf16*)(ws + WS_MIX); bf16* fa = (bf16*)(ws + WS_A); bf16* fup = (bf16*)(ws + WS_UP); bf16* Wgu = (bf16*)(ws + WS_WGU); bf16* Wd = (bf16*)(ws + WS_WD);

    if (TIME_MASK) tbeg = __builtin_amdgcn_s_memrealtime();
    if (ENA(14) && IN(0)) {
        FRESH_IDS();
#pragma unroll 1
        for (int it = bid; it < 192; it += G) if (SUB(4)) p0_mods_item(c_in, cctx_in, w_ada, b_ada, mods, (LAS float*)lds, it, tid, wave, lane);
#pragma unroll 1
        for (int v = 0; v < 3; ++v) {
            const int hl = v == 1 ? 1 : 0;
            if (SUB(6)) p0_h2_rows(hy_w1 + hl * 33 * 64, hy_b1 + hl * 64, hy_f1 + hl * 64, hy_w2 + hl * 64 * 64, hy_b2 + hl * 64, hy_f2 + hl * 64, h2c, v == 2 ? (bf16*)nullptr : h2b + (size_t)hl * LX * 64, v == 2 ? LC : LX, gw, ngw, lane);
        }
        __syncthreads();
        if (SUB(7)) { convert_weight(w_in, 1024, NINP, 3600, Win, wscr, gw, ngw, lane);
        convert_weight(w_out, 1024, 1024, 1024, Wout, wscr, gw, ngw, lane); }
    }
    SEAM(0);

    for (int l = 0; l < 2; ++l) {
        const int P = 1 + l * PH_PER_LAYER;
        const float* mods_l = mods + (size_t)l * 3 * 6144;
        const int nrows = l == 0 ? MROWS : MXR;
        if (ENA(0) && IN(P + 0)) {
            FRESH_IDS();
            if (l == 1) { __syncthreads();
                convert_weight(w_in + (size_t)1024 * 3600, 1024, NINP, 3600, Win, wscr, gw, ngw, lane);
                convert_weight(w_out + (size_t)1024 * 1024, 1024, 1024, 1024, Wout, wscr, gw, ngw, lane); }
            if (SPLITK_CTX && l == 1) norm_rows(xs_out, ctxs, MROWS, norm1_g + l * DM, mods_l, 0, 1, hn, gw, ngw, lane, slabF, 11, mods + 2 * 6144 + 5 * 1024, ctxs);
            else norm_rows(l == 0 ? x_in : xs_out, l == 0 ? ctx_in : ctxs, MROWS, norm1_g + l * DM, mods_l, 0, 1, hn, gw, ngw, lane);
        }
        SEAM(P + 0);
        if (ENA(1) && IN(P + 1)) {
            FRESH_IDS();
            pg8::Gemm g{hn, Win, MROWS, NINP, DM, DM}; pg8::StaticOrder S; S.init(MROWS, NINP, G, bid);
            pg8::EpiInProj E{uhg, uhyT, uz, (long)((WS_UXS - WS_UZ) / 2), (long)((WS_UBC - WS_UZ) / 2), udt, MROWS};
            pg8::gemm_phase<pg8::EpiInProj, pg8::StaticOrder, true, true>(lds, g, S, E, tid);
        }
        SEAM(P + 1);
        SsdArgs SA{axt, abc, abt, uz, udt, ssd_dt_bias + l * 16, ssd_a_log + l * 16, ssd_d + l * 8, sst, dts, mix, ssq};
        HgArgs HA{uhg, hg_lb, hg_lb + 256, hg_norm_g + l * 256, l, hst, dth, mix};
        const float* hcw = hy_conv_w + (size_t)l * 3 * 768; const float* hcb = hy_conv_b + l * 768; const float* hbias = hy_bias + l * 512; const float* w3l = hy_w3 + (size_t)l * 64 * 1024;
        if (ENA(2) && IN(P + 2)) {
            FRESH_IDS();
            ssd_prepass(uxs, ubc, ssd_conv_w + (size_t)l * 3 * 1024, ssd_conv_b + l * 1024, axt, abc, abt, gw, ngw, lane);
        }
        SEAM(P + 2);
        if (ENA(3) && IN(P + 3)) {
            FRESH_IDS();
            const int n_spec = 256, n_hg = 2 * 33 * 4, n_hyc = l == 0 ? 256 : 0, n_ssd = 2 * 33 * 8, total = n_spec + n_hg + n_hyc + n_ssd;
#pragma unroll 1
            for (;;) {
                const int id = NEXT_ITEM(P + 3);
                if (id >= total) break;
                FRESH_IDS();
                const int kind_ = id < n_spec ? 1 : (id < n_spec + n_hg ? 3 : (id < n_spec + n_hg + n_hyc ? 4 : 2));
                const bool timed_ = TIME_KIND && l == 0 && kind_ == TIME_KIND && tsum == 0ull;
                unsigned long long tk0 = 0ull; if (timed_) tk0 = __builtin_amdgcn_s_memrealtime();
                if (id < n_spec) { if (SUB(0)) hy_spectrum_item(lds, h2b + (size_t)l * LX * 64, w3l, hbias, Hs, id, tid, wave, lane); }
                else if (id < n_spec + n_hg) { if (SUB(2)) { int r = id - n_spec; const int h = r & 3; r >>= 2; hg_state_item(lds, HA, r / 33, r % 33, h, tid, wave, lane); } }
                else if (id < n_spec + n_hg + n_hyc) { if (SUB(3)) hy_ctx_item(lds, uhyT, hcw, hcb, hbias, h2c, w3l, mix, id - n_spec - n_hg, tid, wave, lane); }
                else if (SUB(1)) { int r = id - n_spec - n_hg - n_hyc; const int h = r & 7; r >>= 3; ssd_state_item(lds, SA, r / 33, r % 33, h, tid, wave, lane); }
                if (timed_) tsum += __builtin_amdgcn_s_memrealtime() - tk0;
            }
        }
        SEAM(P + 3);
        if (ENA(4) && IN(P + 4)) {
            FRESH_IDS();
            state_scan(sst, dts, hst, dth, gtid);
            #pragma unroll 1
            for (int id = bid; id < 256; id += G) { FRESH_IDS(); hy_fft_item(lds, uhyT, hcw, hcb, Hs, uhyT, id, tid); }
        }
        SEAM(P + 4);
        const int nsc = l == 0 ? 33 : 32;
        if (ENA(5) && IN(P + 5)) {
            FRESH_IDS();
            const int n_ssd = 2 * nsc * 4, n_hg = 2 * nsc * 2;
#pragma unroll 1
            for (;;) {
                const int id = NEXT_ITEM(P + 5);
                if (id >= n_ssd + n_hg) break;
                FRESH_IDS();
                unsigned long long tk0 = 0ull; const int kind_ = id >= n_hg ? 6 : 5; if (TIME_KIND && l == 0 && kind_ == TIME_KIND) tk0 = __builtin_amdgcn_s_memrealtime();
                if (id >= n_hg) { if (SUB(1)) { int r = id - n_hg; const int hp = r & 3; r >>= 2; ssd_item<1>(lds, SA, r / nsc, r % nsc, hp, 0, tid, wave, lane); } }
                else if (SUB(2)) { int r = id; const int hp = r & 1; r >>= 1; hg_item<1>(lds, HA, r / nsc, r % nsc, hp, 0, tid, lane); }
                if (TIME_KIND && l == 0 && kind_ == TIME_KIND) tsum += __builtin_amdgcn_s_memrealtime() - tk0;
            }
        }
        SEAM(P + 5);
        if (ENA(6) && IN(P + 6)) {
            FRESH_IDS();
            const int n_ssd = 2 * nsc * 4, n_hg = 2 * nsc * 2;
#pragma unroll 1
            for (;;) {
                const int id = NEXT_ITEM(P + 6);
                if (id >= n_ssd + n_hg + 256) break;
                FRESH_IDS();
                if (id >= n_ssd + n_hg) mf_hy_tile(lds, uhyT, mix, id - n_ssd - n_hg, tid);
                else if (id >= n_hg) { if (SUB(1)) { int r = id - n_hg; const int hp = r & 3; r >>= 2; ssd_item<2>(lds, SA, r / nsc, r % nsc, hp, 1, tid, wave, lane); } }
                else if (SUB(2)) { int r = id; const int hp = r & 1; r >>= 1; hg_item<2>(lds, HA, r / nsc, r % nsc, hp, 1, tid, lane); }
            }
        }
        SEAM(P + 6);
#ifndef CTX_ASIDE
#define CTX_ASIDE 0
#endif
        const bool ctx_cu = CTX_ASIDE && (l == 0) && bid < 8;
        const int xb = (CTX_ASIDE && l == 0) ? bid - 8 : bid, xG = (CTX_ASIDE && l == 0) ? G - 8 : G;
        const int nrows3 = (CTX_ASIDE || SPLITK_CTX) ? MXR : nrows;
        const int nrows2 = CTX_ASIDE ? MXR : nrows;
        if (ENA(7) && IN(P + 7)) {
            FRESH_IDS();
            if (ctx_cu) {
                bf16* priv = hn + (size_t)bid * 256 * DM;
                mf_ctx_rows(mix, ssq, ssd_norm_g + l * 512, MXR + 256 * (bid >> 2), priv, wave, lane);
                asm volatile("s_waitcnt vmcnt(0)" ::: "memory"); __syncthreads();
                if (tid == 0) { __builtin_amdgcn_fence(__ATOMIC_ACQUIRE, "agent"); asm volatile("s_waitcnt vmcnt(0)" ::: "memory"); }
                __syncthreads();
                pg8::Gemm g{priv - (size_t)(64 + (bid >> 2)) * 256 * DM, Wout, MROWS, DM, DM, DM}; pg8::CtxOrder S{bid};
                pg8::EpiResid E{x_in, xs_out, ctxs, ctx_in, mods_l + 2 * 1024, 6144, mods_l + 2 * 6144 + 2 * 1024};
                pg8::gemm_phase<pg8::EpiResid, pg8::CtxOrder, false, true>(lds, g, S, E, tid);
            } else {
                mf_ssd_rows(mix, ssq, ssd_norm_g + l * 512, 0, nrows2, xb * NWAVES + wave, xG * NWAVES, lane);
            }
        }
        SEAM(P + 7);
        if (ENA(8) && IN(P + 8)) {
            FRESH_IDS();
            pg8::Gemm g{mix, Wout, nrows3, DM, DM, DM}; pg8::StaticOrder S; S.init(nrows3, DM, G, bid);
            pg8::EpiResid E{l == 0 ? x_in : xs_out, xs_out, ctxs, l == 0 ? ctx_in : ctxs, mods_l + 2 * 1024, 6144, mods_l + 2 * 6144 + 2 * 1024};
            pg8::gemm_phase<pg8::EpiResid, pg8::StaticOrder, true, true>(lds, g, S, E, tid);
            if (SPLITK_CTX && l == 0) {
                pg8::Gemm g2{mix, Wout, MROWS, DM, 128, DM}; pg8::SplitOrder S2{bid, 8, 128}; pg8::EpiSlab E2{slabO, 8};
                pg8::gemm_phase<pg8::EpiSlab, pg8::SplitOrder, false, true>(lds, g2, S2, E2, tid);
            }
        }
        SEAM(P + 8);
        if (ENA(9) && IN(P + 9)) {
            FRESH_IDS();
            __syncthreads();
            convert_weight(ffn_w_gate + (size_t)l * 1024 * DFF, 1024, DFF, DFF, Wgu, wscr, gw, ngw, lane);
            convert_weight(ffn_w_up + (size_t)l * 1024 * DFF, 1024, DFF, DFF, Wgu + (size_t)DFF * 1024, wscr, gw, ngw, lane);
            convert_weight(ffn_w_down + (size_t)l * DFF * 1024, DFF, 1024, 1024, Wd, wscr, gw, ngw, lane);
            if (SPLITK_CTX && l == 0) norm_rows(xs_out, ctx_in, nrows, norm2_g + l * DM, mods_l, 3, 4, hn, gw, ngw, lane, slabO, 8, mods_l + 2 * 6144 + 2 * 1024, ctxs);
            else norm_rows(xs_out, ctxs, nrows, norm2_g + l * DM, mods_l, 3, 4, hn, gw, ngw, lane);
        }
        SEAM(P + 9);
        if (ENA(10) && IN(P + 10)) {
            FRESH_IDS();
            pg8::Gemm g{hn, Wgu, nrows, 2 * DFF, DM, DM}; pg8::StaticOrder S; S.init(nrows, 2 * DFF, G, bid);
            pg8::EpiGateUp E{fa, fup};
            pg8::gemm_phase<pg8::EpiGateUp, pg8::StaticOrder, true, true>(lds, g, S, E, tid);
        }
        SEAM(P + 10);
        if (ENA(11) && IN(P + 11)) {
            FRESH_IDS();
            if (ctx_cu) {
                bf16* priv = hn + (size_t)bid * 256 * DFF;
                ffn_conv_phase(fa, fup, ffn_conv_w + (size_t)l * 9 * DFF, ffn_conv_b + l * DFF, MXR + 256 * (bid >> 2), 256, tid, NTHR, priv, -(long)(MXR + 256 * (bid >> 2)));
                asm volatile("s_waitcnt vmcnt(0)" ::: "memory"); __syncthreads();
                if (tid == 0) { __builtin_amdgcn_fence(__ATOMIC_ACQUIRE, "agent"); asm volatile("s_waitcnt vmcnt(0)" ::: "memory"); }
                __syncthreads();
                pg8::Gemm g{priv - (size_t)(64 + (bid >> 2)) * 256 * DFF, Wd, MROWS, DM, DFF, DFF}; pg8::CtxOrder S{bid};
                pg8::EpiResid E{xs_out, xs_out, ctxs, ctxs, mods_l + 5 * 1024, 6144, mods_l + 2 * 6144 + 5 * 1024};
                pg8::gemm_phase<pg8::EpiResid, pg8::CtxOrder, false, true>(lds, g, S, E, tid);
            } else ffn_conv_phase(fa, fup, ffn_conv_w + (size_t)l * 9 * DFF, ffn_conv_b + l * DFF, 0, nrows2, xb * NTHR + tid, xG * NTHR, fup, 0);
        }
        SEAM(P + 11);
        if (ENA(12) && IN(P + 12)) {
            FRESH_IDS();
            pg8::Gemm g{fup, Wd, nrows3, DM, DFF, DFF}; pg8::StaticOrder S; S.init(nrows3, DM, G, bid);
            pg8::EpiResid E{xs_out, xs_out, ctxs, ctxs, mods_l + 5 * 1024, 6144, mods_l + 2 * 6144 + 5 * 1024};
            pg8::gemm_phase<pg8::EpiResid, pg8::StaticOrder, true, true>(lds, g, S, E, tid);
            if (SPLITK_CTX && l == 0) {
                pg8::Gemm g2{fup, Wd, MROWS, DM, 256, DFF}; pg8::SplitOrder S2{bid, 11, 256}; pg8::EpiSlab E2{slabF, 11};
                pg8::gemm_phase<pg8::EpiSlab, pg8::SplitOrder, false, true>(lds, g2, S2, E2, tid);
            }
        }
        SEAM(P + 12);
    }
    if (ENA(15) && IN(NPHASES - 1)) { FRESH_IDS(); final_norm_rows(xs_out, final_norm_g, gw, ngw, lane); }
    if (TIME_MASK || TIME_KIND) { const unsigned long long tnow = __builtin_amdgcn_s_memrealtime(); if ((TIME_MASK >> (NPHASES - 1)) & 1u) tsum += tnow - tbeg;
        if (bid == 0 && tid0 == 0) { while (__builtin_amdgcn_s_memrealtime() - tnow < (unsigned long long)TIME_MULT * tsum) __builtin_amdgcn_s_sleep(32); } }
#undef IN
#undef SEAM
}

extern "C" void kernel_launch(void* const* d_in, const int* in_sizes, int n_in, void* d_out, int out_size, void* d_ws, size_t ws_size, hipStream_t stream) {
    static int grid = 0;
    if (grid == 0) {
        if (n_in != 34 || out_size != MXR * DM || ws_size < WS_END) { fprintf(stderr, "kernel_launch: unexpected shapes (n_in %d out %d ws %zu)\n", n_in, out_size, ws_size); grid = -1; return; }
        int dev = 0, cus = 0, per_cu = 0;
        if (hipGetDevice(&dev) != hipSuccess || hipDeviceGetAttribute(&cus, hipDeviceAttributeMultiprocessorCount, dev) != hipSuccess) { grid = -1; return; }
        if (hipFuncSetAttribute((const void*)hybrid_fwd, hipFuncAttributeMaxDynamicSharedMemorySize, LDS_BYTES) != hipSuccess) { fprintf(stderr, "kernel_launch: hipFuncSetAttribute failed\n"); grid = -1; return; }
        if (hipOccupancyMaxActiveBlocksPerMultiprocessor(&per_cu, (const void*)hybrid_fwd, NTHR, LDS_BYTES) != hipSuccess || per_cu < 1)
            fprintf(stderr, "kernel_launch: note: occupancy query reports %d workgroups per CU\n", per_cu);
        (void)hipGetLastError();
        grid = cus;
    }
    if (grid < 0) return;
    if (hipMemsetAsync((char*)d_ws + WS_CTL, 0, CTL_ZERO_BYTES, stream) != hipSuccess) { fprintf(stderr, "kernel_launch: memset failed\n"); return; }
    Args a{};
    for (int i = 0; i < 34; ++i) a.in[i] = (const float*)d_in[i];
    a.out = (float*)d_out; a.ws = (unsigned char*)d_ws;
#if MK_PER_PHASE
    for (int p = 0; p < NPHASES; ++p) { a.ph_lo = p; a.ph_hi = p + 1; hipLaunchKernelGGL(hybrid_fwd, dim3(grid), dim3(NTHR), LDS_BYTES, stream, a); }
#else
    a.ph_lo = 0; a.ph_hi = NPHASES;
    hipLaunchKernelGGL(hybrid_fwd, dim3(grid), dim3(NTHR), LDS_BYTES, stream, a);
#endif
    const hipError_t le = hipPeekAtLastError();
    if (le != hipSuccess) fprintf(stderr, "kernel_launch: launch failed: %s\n", hipGetErrorName(le));
}
```
